# Optimizing an MI355X kernel written in HIP

```python
import math
import jax, jax.numpy as jnp
from jax import lax
import numpy as np

D_MODEL = 1024
BATCH = 8
SEQ = 2048
DEPTH = 1

MIX_WIDTH = D_MODEL
POOL_WIDTH = MIX_WIDTH // 2
POOL_WINDOWS = (2, 4, 8, 16)
POOL_GROUPS = len(POOL_WINDOWS)
POOL_GROUP_DIM = POOL_WIDTH // POOL_GROUPS
RET_WIDTH = MIX_WIDTH - POOL_WIDTH
RET_HEADS = 4
RET_HEAD_DIM = RET_WIDTH // RET_HEADS
RET_CHUNK = 128
ROPE_BASE = 10000.0
IN_COLS = POOL_WIDTH + 4 * RET_WIDTH
N_EXPERTS = 32
TOP_K = 4
D_FF = D_MODEL
SWIGLU_ALPHA = 1.702
SWIGLU_LIMIT = 7.0
MOE_BLOCK = 128
N_MOD = 6
EPS = 1e-6

kernel_name = "hybrid_pool_retention_moe_adaln"


def rmsnorm(x, g):
    xf = x.astype(jnp.float32)
    r = lax.rsqrt(jnp.mean(xf * xf, axis=-1, keepdims=True) + EPS)
    return (xf * r).astype(x.dtype) * g


def modulate(h, shift, scale):
    return h * (1.0 + scale[:, None, :]) + shift[:, None, :]


def pool_mixer(u, pool_w, pool_b, pool_scale):
    B, S, _ = u.shape
    t = jnp.arange(S)
    outs = []
    for gi, w in enumerate(POOL_WINDOWS):
        ug = u[..., gi * POOL_GROUP_DIM:(gi + 1) * POOL_GROUP_DIM].astype(jnp.float32)
        cs = jnp.cumsum(ug, axis=1)
        csp = jnp.concatenate([jnp.zeros((B, w, POOL_GROUP_DIM), jnp.float32), cs], axis=1)
        win = csp[:, w:] - csp[:, :S]
        cnt = jnp.minimum(t + 1, w).astype(jnp.float32)[None, :, None]
        outs.append(win / cnt - ug)
    p = jnp.stack(outs, axis=2)
    p = jnp.einsum('bsgc,gcd->bsgd', p, pool_w.astype(jnp.float32)) + pool_b.astype(jnp.float32)
    return p.reshape(B, S, POOL_WIDTH).astype(u.dtype) * pool_scale


def rotary(x):
    S, Dh = x.shape[1], x.shape[-1]
    half = Dh // 2
    inv = ROPE_BASE ** (-jnp.arange(half, dtype=jnp.float32) / half)
    ang = jnp.arange(S, dtype=jnp.float32)[:, None] * inv[None, :]
    cos = jnp.cos(ang)[None, :, None, :]
    sin = jnp.sin(ang)[None, :, None, :]
    x1, x2 = x[..., :half], x[..., half:]
    return jnp.concatenate([x1 * cos - x2 * sin, x2 * cos + x1 * sin], axis=-1)


def retention(q, k, v, g, gn):
    B, S, _ = q.shape
    H, Dh, C = RET_HEADS, RET_HEAD_DIM, RET_CHUNK
    NC = S // C
    qf = rotary(q.astype(jnp.float32).reshape(B, S, H, Dh))
    kf = rotary(k.astype(jnp.float32).reshape(B, S, H, Dh)) * (Dh ** -0.5)
    vf = v.astype(jnp.float32).reshape(B, S, H, Dh)

    def chunks(a):
        return a.reshape(B, NC, C, H, Dh).transpose(1, 0, 3, 2, 4)

    log_g = jnp.log1p(-jnp.exp2(-5.0 - jnp.arange(H, dtype=jnp.float32)))
    i = jnp.arange(C, dtype=jnp.float32)
    diff = i[:, None] - i[None, :]
    dmask = jnp.where(diff >= 0, jnp.exp(log_g[:, None, None] * jnp.maximum(diff, 0.0)), 0.0)
    q_dec = jnp.exp(log_g[:, None] * (i[None, :] + 1.0))
    k_dec = jnp.exp(log_g[:, None] * (C - 1.0 - i[None, :]))
    chunk_dec = jnp.exp(log_g * C)

    def step(R, qkv):
        qc, kc, vc = qkv
        s = jnp.einsum('bhid,bhjd->bhij', qc, kc) * dmask[None]
        o = jnp.einsum('bhij,bhje->bhie', s, vc) \
            + jnp.einsum('bhid,bhde->bhie', qc, R) * q_dec[None, :, :, None]
        R = R * chunk_dec[None, :, None, None] \
            + jnp.einsum('bhjd,bhje->bhde', kc * k_dec[None, :, :, None], vc)
        return R, o

    R0 = jnp.zeros((B, H, Dh, Dh), jnp.float32)
    _, o = lax.scan(step, R0, (chunks(qf), chunks(kf), chunks(vf)))
    o = o.transpose(1, 0, 3, 2, 4).reshape(B, S, H, Dh)
    mu = jnp.mean(o, axis=-1, keepdims=True)
    var = jnp.mean(jnp.square(o - mu), axis=-1, keepdims=True)
    o = ((o - mu) * lax.rsqrt(var + EPS)).reshape(B, S, RET_WIDTH) * gn.astype(jnp.float32)
    return (jax.nn.silu(g.astype(jnp.float32)) * o).astype(q.dtype)


def moe_ffn(h, w_router, b_router, w_gate_up, b_gate_up, w_down, b_down):
    B, S, D = h.shape
    T = B * S
    TK = T * TOP_K
    hf = h.reshape(T, D)
    logits = (hf @ w_router + b_router).astype(jnp.float32)
    top_val, top_idx = lax.top_k(logits, TOP_K)
    top_w = jax.nn.softmax(top_val, axis=-1)

    e_flat = top_idx.reshape(TK)
    w_flat = top_w.reshape(TK)
    tok_flat = jnp.arange(TK) // TOP_K
    order = jnp.argsort(e_flat, stable=True)
    sorted_e = e_flat[order]
    tok_sorted = tok_flat[order]
    w_sorted = w_flat[order]

    counts = jnp.bincount(e_flat, length=N_EXPERTS)
    padded = ((counts + MOE_BLOCK - 1) // MOE_BLOCK) * MOE_BLOCK
    starts = jnp.cumsum(counts) - counts
    padded_ends = jnp.cumsum(padded)
    padded_starts = padded_ends - padded
    rank = jnp.arange(TK) - starts[sorted_e]
    dest = padded_starts[sorted_e] + rank

    n_pad = TK + N_EXPERTS * MOE_BLOCK
    n_blocks = n_pad // MOE_BLOCK
    x_pad = jnp.zeros((n_pad, D), h.dtype).at[dest].set(hf[tok_sorted])
    block_start = jnp.arange(n_blocks) * MOE_BLOCK
    block_expert = jnp.minimum(jnp.searchsorted(padded_ends, block_start, side='right'), N_EXPERTS - 1)

    def expert_block(args):
        xb, e = args
        gu = xb @ w_gate_up[e] + b_gate_up[e]
        gate = jnp.minimum(gu[:, 0::2], SWIGLU_LIMIT)
        lin = jnp.clip(gu[:, 1::2], -SWIGLU_LIMIT, SWIGLU_LIMIT)
        glu = gate * jax.nn.sigmoid(SWIGLU_ALPHA * gate)
        return ((lin + 1.0) * glu) @ w_down[e] + b_down[e]

    y_pad = lax.map(expert_block, (x_pad.reshape(n_blocks, MOE_BLOCK, D), block_expert))
    y_sorted = y_pad.reshape(n_pad, D)[dest]
    out = jnp.zeros((T, D), jnp.float32).at[tok_sorted].add(
        y_sorted.astype(jnp.float32) * w_sorted[:, None])
    return out.reshape(B, S, D).astype(h.dtype)


def setup_inputs(seed: int = 0) -> dict:
    key = jax.random.key(seed)
    ks = jax.random.split(key, 20)
    L, D = DEPTH, D_MODEL
    f32 = jnp.float32
    nrm = lambda k, shape, s: jax.random.normal(k, shape, f32) * s
    return {
        "x": nrm(ks[0], (BATCH, SEQ, D), 1.0),
        "c": nrm(ks[1], (BATCH, D), 1.0),
        "w_ada": nrm(ks[2], (L, D, N_MOD * D), 0.5 * D ** -0.5),
        "b_ada": nrm(ks[3], (L, N_MOD * D), 0.02),
        "g_attn": 1.0 + nrm(ks[4], (L, D), 0.01),
        "w_in": nrm(ks[5], (L, D, IN_COLS), D ** -0.5),
        "pool_w": nrm(ks[6], (L, POOL_GROUPS, POOL_GROUP_DIM, POOL_GROUP_DIM), POOL_GROUP_DIM ** -0.5),
        "pool_b": nrm(ks[7], (L, POOL_GROUPS, POOL_GROUP_DIM), 0.01),
        "pool_scale": 1.0 + nrm(ks[8], (L, POOL_WIDTH), 0.01),
        "ret_gn": 1.0 + nrm(ks[9], (L, RET_WIDTH), 0.01),
        "w_out": nrm(ks[10], (L, MIX_WIDTH, D), MIX_WIDTH ** -0.5),
        "g_ffn": 1.0 + nrm(ks[11], (L, D), 0.01),
        "w_router": nrm(ks[12], (L, D, N_EXPERTS), D ** -0.5),
        "b_router": nrm(ks[13], (L, N_EXPERTS), 0.01),
        "w_gate_up": nrm(ks[14], (L, N_EXPERTS, D, 2 * D_FF), D ** -0.5),
        "b_gate_up": nrm(ks[15], (L, N_EXPERTS, 2 * D_FF), 0.01),
        "w_down": nrm(ks[16], (L, N_EXPERTS, D_FF, D), D_FF ** -0.5),
        "b_down": nrm(ks[17], (L, N_EXPERTS, D), 0.01),
        "g_final": 1.0 + nrm(ks[18], (D,), 0.01),
    }


def reference(x, c, w_ada, b_ada, g_attn, w_in, pool_w, pool_b, pool_scale, ret_gn, w_out,
              g_ffn, w_router, b_router, w_gate_up, b_gate_up, w_down, b_down, g_final):
    c_act = jax.nn.silu(c)
    for l in range(DEPTH):
        mod = c_act @ w_ada[l] + b_ada[l]
        sh1, sc1, gt1, sh2, sc2, gt2 = jnp.split(mod, N_MOD, axis=-1)
        h = modulate(rmsnorm(x, g_attn[l]), sh1, sc1)
        proj = h @ w_in[l]
        p0 = POOL_WIDTH
        u = proj[..., :p0]
        q = proj[..., p0:p0 + RET_WIDTH]
        k = proj[..., p0 + RET_WIDTH:p0 + 2 * RET_WIDTH]
        v = proj[..., p0 + 2 * RET_WIDTH:p0 + 3 * RET_WIDTH]
        g = proj[..., p0 + 3 * RET_WIDTH:]
        a_out = pool_mixer(u, pool_w[l], pool_b[l], pool_scale[l])
        r_out = retention(q, k, v, g, ret_gn[l])
        mix = jnp.concatenate([a_out, r_out], axis=-1) @ w_out[l]
        x = x + gt1[:, None, :] * mix
        h2 = modulate(rmsnorm(x, g_ffn[l]), sh2, sc2)
        f = moe_ffn(h2, w_router[l], b_router[l], w_gate_up[l], b_gate_up[l], w_down[l], b_down[l])
        x = x + gt2[:, None, :] * f
    return rmsnorm(x, g_final)
```

```cpp
#include <hip/hip_runtime.h>
#include <cstdint>
#include <cstdio>

typedef unsigned short bf16_t;
typedef short bf16x8 __attribute__((ext_vector_type(8)));
typedef float f32x4 __attribute__((ext_vector_type(4)));
typedef unsigned u32x4 __attribute__((ext_vector_type(4)));
typedef unsigned u32x2 __attribute__((ext_vector_type(2)));
#define LAS __attribute__((address_space(3)))

constexpr int T_ = 16384, D_ = 1024, NB = 8, SEQ = 2048, INC = 2560, NE = 32, FF = 1024, TK = 65536, NMOD = 6144;
constexpr int CAP = 16384;
constexpr int ACT_ROWS = TK + NE * 256;
constexpr float EPS = 1e-6f;

constexpr size_t MiB = 1u << 20;
constexpr size_t WS_CTL = 0, CTL_ZERO_BYTES = 1 * MiB;
constexpr size_t WS_MODP = 1 * MiB;
constexpr size_t WS_MOD = 3 * MiB;
constexpr size_t WS_ROPE = 4 * MiB;
constexpr size_t WS_POOLWT = 5 * MiB;
constexpr size_t WS_WINT = 6 * MiB;
constexpr size_t WS_WOUTT = 11 * MiB;
constexpr size_t WS_TOKSLOT = 13 * MiB;
constexpr size_t WS_WSLOT = 15 * MiB;
constexpr size_t WS_WGUT = 16 * MiB;
constexpr size_t WS_WDT = 144 * MiB;
constexpr size_t WS_XN = 208 * MiB;
constexpr size_t WS_PROJ = 240 * MiB;
constexpr size_t WS_KVT = 320 * MiB;
constexpr size_t WS_RT = 352 * MiB;
constexpr size_t WS_MIXIN = 368 * MiB;
constexpr size_t WS_X1 = 400 * MiB;
constexpr size_t WS_HN = 464 * MiB;
constexpr size_t WS_ACT = 496 * MiB;
constexpr size_t WS_Y = 640 * MiB;
constexpr size_t WS_QR = 768 * MiB;
constexpr size_t WS_KR = 784 * MiB;
constexpr size_t WS_SG = 800 * MiB;
constexpr size_t WS_OG = 832 * MiB;
constexpr size_t WS_H2F = 864 * MiB;
constexpr size_t WS_LOGITS = 928 * MiB;
constexpr size_t WS_PP = 930 * MiB;
constexpr size_t WS_END = 946 * MiB;
constexpr int CW_CNT = 64;
constexpr int CW_PSTART = 128;

__device__ __forceinline__ unsigned f2bf(float f) { unsigned u = __float_as_uint(f); return (u + 0x7fffu + ((u >> 16) & 1u)) >> 16; }
__device__ __forceinline__ unsigned pk2(float lo, float hi) { return f2bf(lo) | (f2bf(hi) << 16); }
__device__ __forceinline__ float bf2f(unsigned h) { return __uint_as_float(h << 16); }
__device__ __forceinline__ float wave_sum(float v) {
#pragma unroll
    for (int o = 1; o < 64; o <<= 1) v += __shfl_xor(v, o);
    return v;
}
__device__ __forceinline__ float silu_f(float v) { return v / (1.f + __expf(-v)); }
__device__ __forceinline__ float log2_gamma(int h) { return log2f(1.f - exp2f(-5.f - (float)h)); }

constexpr int NWAVES = 8;
constexpr int LDS_BYTES = 147456;

template <int MAPMODE>
__device__ __forceinline__ void transpose_item(const float* W, int K, int N, bf16_t* WT, LAS float* scr, int item, int lane) {
    const int nblk = N / 32, kb = item / nblk, nb = item % nblk, k0 = 64 * kb, n0 = 32 * nb;
#pragma unroll 8
    for (int i = 0; i < 32; ++i) { const int kk = 2 * i + (lane >> 5); scr[kk * 33 + (lane & 31)] = W[(size_t)(k0 + kk) * N + n0 + (lane & 31)]; }
    asm volatile("s_waitcnt lgkmcnt(0)" ::: "memory");
    const int c = lane & 7;
#pragma unroll
    for (int j = 0; j < 4; ++j) {
        const int nl = (lane >> 3) + 8 * j; const LAS float* s = scr + (8 * c) * 33 + nl;
        u32x4 o; o.x = pk2(s[0 * 33], s[1 * 33]); o.y = pk2(s[2 * 33], s[3 * 33]); o.z = pk2(s[4 * 33], s[5 * 33]); o.w = pk2(s[6 * 33], s[7 * 33]);
        const int n = n0 + nl; int row = n;
        if (MAPMODE == 1) { const int a = n >> 1, bj = n & 1; row = 256 * (a >> 7) + 128 * bj + (a & 127); }
        *(u32x4*)(WT + (size_t)row * K + k0 + 8 * c) = o;
    }
    asm volatile("s_waitcnt lgkmcnt(0)" ::: "memory");
}

struct Args {
    const float* in[19]; float* out; unsigned char* ws; int ph_lo, ph_hi;
};

__device__ __forceinline__ void phase_p0(const Args& a, LAS unsigned char* lds, int vb, int G) {
    const int tid = threadIdx.x, lane = tid & 63, wave = tid >> 6;
    unsigned char* ws = a.ws;
    if (vb < 256) {
        LAS float* cact = (LAS float*)lds;
        LAS float* part = (LAS float*)(lds + 4096);
        const int kc = vb & 7, cc = vb >> 3;
        const float* c = a.in[1];
        for (int i = tid; i < 8 * 128; i += 512) { const int b = i >> 7, k = i & 127; cact[i] = silu_f(c[b * D_ + kc * 128 + k]); }
        __syncthreads();
        const int cg = tid % 48, ks = tid / 48;
        if (ks < 10) {
            f32x4 acc[8];
#pragma unroll
            for (int b = 0; b < 8; ++b) acc[b] = (f32x4){0.f, 0.f, 0.f, 0.f};
            const float* w = a.in[2] + (size_t)(kc * 128) * NMOD + cc * 192 + cg * 4;
            for (int k = ks; k < 128; k += 10) {
                const f32x4 wv = *(const f32x4*)(w + (size_t)k * NMOD);
#pragma unroll
                for (int b = 0; b < 8; ++b) acc[b] += wv * cact[b * 128 + k];
            }
#pragma unroll
            for (int b = 0; b < 8; ++b) *(LAS f32x4*)(part + (ks * 8 + b) * 192 + cg * 4) = acc[b];
        }
        __syncthreads();
        float* modp = (float*)(ws + WS_MODP);
        for (int i = tid; i < 8 * 192; i += 512) {
            const int b = i / 192, col = i % 192; float s = 0.f;
#pragma unroll
            for (int q = 0; q < 10; ++q) s += part[(q * 8 + b) * 192 + col];
            modp[((size_t)kc * 8 + b) * NMOD + cc * 192 + col] = s;
        }
        __syncthreads();
    }
    {
        float* cosT = (float*)(ws + WS_ROPE); float* sinT = cosT + SEQ * 64;
        for (int i = vb * 512 + tid; i < SEQ * 64; i += G * 512) {
            const int pos = i >> 6, j = i & 63;
            const double inv = (double)(float)exp(-(double)j * (9.210340371976184 / 64.0));
            const double ang = (double)((float)pos * (float)inv);
            const double q = rint(ang * 0.6366197723675814);
            double r = fma(-q, 1.5707963267948966, ang); r = fma(-q, 6.123233995736766e-17, r);
            const double r2 = r * r;
            double s = -1.0 / 39916800.0; s = s * r2 + 1.0 / 362880.0; s = s * r2 - 1.0 / 5040.0; s = s * r2 + 1.0 / 120.0; s = s * r2 - 1.0 / 6.0; s = s * r2 + 1.0; s *= r;
            double co = 1.0 / 479001600.0; co = co * r2 - 1.0 / 3628800.0; co = co * r2 + 1.0 / 40320.0; co = co * r2 - 1.0 / 720.0; co = co * r2 + 1.0 / 24.0; co = co * r2 - 0.5; co = co * r2 + 1.0;
            const int n = ((int)q) & 3;
            const double sv = (n == 0) ? s : (n == 1) ? co : (n == 2) ? -s : -co;
            const double cv = (n == 0) ? co : (n == 1) ? -s : (n == 2) ? -co : s;
            cosT[i] = (float)cv; sinT[i] = (float)sv;
        }
    }
    {
        LAS float* scr = (LAS float*)(lds + wave * 16384);
        const int gw = vb * NWAVES + wave, NGW = G * NWAVES;
        constexpr int I_IN = (D_ / 64) * (INC / 32), I_OUT = (D_ / 64) * (D_ / 32), I_POOL = 4 * 2 * 4, I_GU = (D_ / 64) * (2 * FF / 32), I_DN = (FF / 64) * (D_ / 32);
        constexpr int NITEMS = I_IN + I_OUT + I_POOL + NE * I_GU + NE * I_DN;
        for (int it = gw; it < NITEMS; it += NGW) {
            int r = it;
            if (r < I_IN) { transpose_item<0>(a.in[5], D_, INC, (bf16_t*)(ws + WS_WINT), scr, r, lane); continue; } r -= I_IN;
            if (r < I_OUT) { transpose_item<0>(a.in[10], D_, D_, (bf16_t*)(ws + WS_WOUTT), scr, r, lane); continue; } r -= I_OUT;
            if (r < I_POOL) { const int g = r / 8; transpose_item<0>(a.in[6] + g * 128 * 128, 128, 128, (bf16_t*)(ws + WS_POOLWT) + g * 128 * 128, scr, r % 8, lane); continue; } r -= I_POOL;
            if (r < NE * I_GU) { const int e = r / I_GU; transpose_item<1>(a.in[14] + (size_t)e * D_ * 2 * FF, D_, 2 * FF, (bf16_t*)(ws + WS_WGUT) + (size_t)e * 2 * FF * D_, scr, r % I_GU, lane); continue; } r -= NE * I_GU;
            { const int e = r / I_DN; transpose_item<0>(a.in[16] + (size_t)e * FF * D_, FF, D_, (bf16_t*)(ws + WS_WDT) + (size_t)e * D_ * FF, scr, r % I_DN, lane); }
        }
    }
}

__device__ __forceinline__ void phase_p1(const Args& a, LAS unsigned char* lds, int vb, int G) {
    const int tid = threadIdx.x, lane = tid & 63, wave = tid >> 6;
    unsigned char* ws = a.ws;
    const float* modp = (const float*)(ws + WS_MODP); float* mod = (float*)(ws + WS_MOD);
    for (int i = vb * 512 + tid; i < NB * NMOD; i += G * 512) {
        const int col = i % NMOD; float s = a.in[3][col];
#pragma unroll
        for (int q = 0; q < 8; ++q) s += modp[(size_t)q * NB * NMOD + i];
        mod[i] = s;
    }
    const int RPB = T_ / G;
    const int row0 = vb * RPB, b = row0 / SEQ;
    LAS float* shs = (LAS float*)lds;
    LAS float* scs = shs + 1024;
    for (int i = tid; i < 2048; i += 512) {
        float s = a.in[3][i];
#pragma unroll
        for (int q = 0; q < 8; ++q) s += modp[(size_t)q * NB * NMOD + (size_t)b * NMOD + i];
        if (i < 1024) shs[i] = s; else scs[i - 1024] = (1.f + s) * a.in[4][i - 1024];
    }
    __syncthreads();
    bf16_t* XN = (bf16_t*)(ws + WS_XN);
    for (int r = row0 + wave; r < row0 + RPB; r += NWAVES) {
        const f32x4* xr = (const f32x4*)(a.in[0] + (size_t)r * D_) + lane;
        f32x4 v[4]; float ss = 0.f;
#pragma unroll
        for (int j = 0; j < 4; ++j) { v[j] = xr[64 * j]; ss += (v[j].x * v[j].x + v[j].y * v[j].y) + (v[j].z * v[j].z + v[j].w * v[j].w); }
        const float rs = 1.f / sqrtf(wave_sum(ss) * (1.f / D_) + EPS);
        unsigned long long* o8 = (unsigned long long*)(XN + (size_t)r * D_) + lane;
#pragma unroll
        for (int j = 0; j < 4; ++j) {
            const int c0 = 4 * lane + 256 * j;
            const float h0 = v[j].x * rs * scs[c0] + shs[c0], h1 = v[j].y * rs * scs[c0 + 1] + shs[c0 + 1], h2 = v[j].z * rs * scs[c0 + 2] + shs[c0 + 2], h3 = v[j].w * rs * scs[c0 + 3] + shs[c0 + 3];
            o8[64 * j] = (unsigned long long)pk2(h0, h1) | ((unsigned long long)pk2(h2, h3) << 32);
        }
    }
    __syncthreads();
}

__global__ void __launch_bounds__(512, 2) mega(Args a) {
    extern __shared__ __attribute__((aligned(16))) unsigned char lds_raw[];
    LAS unsigned char* lds = (LAS unsigned char*)lds_raw;
    const int G = gridDim.x, bx = blockIdx.x;
    const int vb = (G % 8 == 0) ? (bx % 8) * (G / 8) + bx / 8 : bx;
    if (a.ph_lo <= 0 && 0 < a.ph_hi) phase_p0(a, lds, vb, G);
    if (a.ph_lo <= 1 && 1 < a.ph_hi) phase_p1(a, lds, vb, G);
}

#define MFMA16(a, b, c) __builtin_amdgcn_mfma_f32_16x16x32_bf16(a, b, c, 0, 0, 0)

template <class Epi>
__global__ void __launch_bounds__(256) k_sgemm(const bf16_t* A, const bf16_t* Bt, Epi epi) {
    const int K = epi.K;
    const int wave = threadIdx.x >> 6, lane = threadIdx.x & 63, fr = lane & 15, fq = lane >> 4;
    const int row0 = blockIdx.y * 64 + wave * 16, col0 = blockIdx.x * 64;
    f32x4 acc[4];
#pragma unroll
    for (int n = 0; n < 4; ++n) acc[n] = (f32x4){0.f, 0.f, 0.f, 0.f};
    const bf16_t* ap = A + (size_t)(row0 + fr) * K + fq * 8;
    const bf16_t* bp = Bt + (size_t)(col0 + fr) * K + fq * 8;
    for (int k0 = 0; k0 < K; k0 += 32) {
        const bf16x8 av = *(const bf16x8*)(ap + k0);
#pragma unroll
        for (int n = 0; n < 4; ++n) { const bf16x8 bv = *(const bf16x8*)(bp + (size_t)n * 16 * K + k0); acc[n] = MFMA16(bv, av, acc[n]); }
    }
#pragma unroll
    for (int n = 0; n < 4; ++n)
#pragma unroll
        for (int j = 0; j < 4; ++j) epi(row0 + fr, col0 + n * 16 + 4 * fq + j, acc[n][j]);
}
struct EpiStoreBf16 { bf16_t* O; int ldc; int K; __device__ void operator()(int r, int c, float v) const { O[(size_t)r * ldc + c] = (bf16_t)f2bf(v); } };
struct EpiOutProj { const float* x; const float* mod; float* X1; int K; int pad; __device__ void operator()(int r, int c, float v) const { const int b = r / SEQ; X1[(size_t)r * D_ + c] = x[(size_t)r * D_ + c] + mod[b * NMOD + 2 * D_ + c] * v; } };

__global__ void k_pool_p(const bf16_t* PROJ, bf16_t* PP) {
    const int i = blockIdx.x * blockDim.x + threadIdx.x; if (i >= T_ * 512) return;
    const int t = i >> 9, ch = i & 511, g = ch >> 7, w = 2 << g, pos = t % SEQ;
    float s = 0.f;
    for (int q = 0; q < w; ++q) if (pos - q >= 0) s += bf2f(PROJ[(size_t)(t - q) * INC + ch]);
    const float cnt = (float)((pos + 1 < w) ? pos + 1 : w);
    PP[i] = (bf16_t)f2bf(s / cnt - bf2f(PROJ[(size_t)t * INC + ch]));
}
__global__ void k_pool_mm(const bf16_t* PP, const bf16_t* PWT, const float* pool_b, const float* pool_scale, bf16_t* MIXIN) {
    const int i = blockIdx.x * blockDim.x + threadIdx.x; if (i >= T_ * 512) return;
    const int t = i >> 9, ch = i & 511, g = ch >> 7, d = ch & 127;
    float s = 0.f;
    for (int c = 0; c < 128; ++c) s += bf2f(PP[(size_t)t * 512 + g * 128 + c]) * bf2f(PWT[(g * 128 + d) * 128 + c]);
    MIXIN[(size_t)t * D_ + ch] = (bf16_t)f2bf((s + pool_b[ch]) * pool_scale[ch]);
}
__global__ void k_rot(const bf16_t* PROJ, const float* rope, bf16_t* QR, bf16_t* KR) {
    const int i = blockIdx.x * blockDim.x + threadIdx.x; if (i >= T_ * 256) return;
    const int t = i >> 8, h = (i >> 6) & 3, d = i & 63, pos = t % SEQ;
    const float c = rope[pos * 64 + d], s = rope[SEQ * 64 + pos * 64 + d];
    const bf16_t* p = PROJ + (size_t)t * INC;
    const float q1 = bf2f(p[512 + h * 128 + d]), q2 = bf2f(p[512 + h * 128 + 64 + d]);
    const float k1 = bf2f(p[1024 + h * 128 + d]), k2 = bf2f(p[1024 + h * 128 + 64 + d]);
    const float sc = 0.08838834764831845f;
    QR[(size_t)t * 512 + h * 128 + d] = (bf16_t)f2bf(q1 * c - q2 * s); QR[(size_t)t * 512 + h * 128 + 64 + d] = (bf16_t)f2bf(q2 * c + q1 * s);
    KR[(size_t)t * 512 + h * 128 + d] = (bf16_t)f2bf((k1 * c - k2 * s) * sc); KR[(size_t)t * 512 + h * 128 + 64 + d] = (bf16_t)f2bf((k2 * c + k1 * s) * sc);
}
__global__ void k_kv(const bf16_t* PROJ, const bf16_t* KR, float* KVT) {
    const int bh = blockIdx.x / 15, n = blockIdx.x % 15, b = bh >> 2, h = bh & 3, t0 = b * SEQ + n * 128;
    const float l2g = log2_gamma(h);
    for (int idx = threadIdx.x; idx < 16384; idx += blockDim.x) {
        const int e = idx >> 7, d = idx & 127; float s = 0.f;
        for (int j = 0; j < 128; ++j) s += exp2f((float)(127 - j) * l2g) * bf2f(KR[(size_t)(t0 + j) * 512 + h * 128 + d]) * bf2f(PROJ[(size_t)(t0 + j) * INC + 1536 + h * 128 + e]);
        KVT[((size_t)(bh * 15 + n) * 128 + e) * 128 + d] = s;
    }
}
__global__ void k_scan(const float* KVT, bf16_t* RT) {
    const int i = blockIdx.x * blockDim.x + threadIdx.x; if (i >= 32 * 16384) return;
    const int bh = i >> 14, ed = i & 16383, h = bh & 3;
    const float cd = exp2f(128.f * log2_gamma(h)); float R = 0.f;
    for (int n = 0; n < 16; ++n) { RT[((size_t)(bh * 16 + n) << 14) + ed] = (bf16_t)f2bf(R); if (n < 15) R = R * cd + KVT[((size_t)(bh * 15 + n) << 14) + ed]; }
}
__global__ void k_S(const bf16_t* QR, const bf16_t* KR, float* SG) {
    const int u = blockIdx.x, bh = u >> 4, n = u & 15, b = bh >> 2, h = bh & 3, t0 = b * SEQ + n * 128;
    const float l2g = log2_gamma(h);
    for (int idx = threadIdx.x; idx < 16384; idx += blockDim.x) {
        const int i = idx >> 7, j = idx & 127; float s = 0.f;
        if (i >= j) { for (int d = 0; d < 128; ++d) s += bf2f(QR[(size_t)(t0 + i) * 512 + h * 128 + d]) * bf2f(KR[(size_t)(t0 + j) * 512 + h * 128 + d]); s *= exp2f((float)(i - j) * l2g); }
        SG[((size_t)u << 14) + idx] = s;
    }
}
__global__ void k_o(const bf16_t* PROJ, const bf16_t* QR, const float* SG, const bf16_t* RT, float* OG) {
    const int u = blockIdx.x, bh = u >> 4, n = u & 15, b = bh >> 2, h = bh & 3, t0 = b * SEQ + n * 128;
    const float l2g = log2_gamma(h);
    for (int idx = threadIdx.x; idx < 16384; idx += blockDim.x) {
        const int i = idx >> 7, e = idx & 127; float s = 0.f, r = 0.f;
        for (int j = 0; j <= i; ++j) s += SG[((size_t)u << 14) + i * 128 + j] * bf2f(PROJ[(size_t)(t0 + j) * INC + 1536 + h * 128 + e]);
        for (int d = 0; d < 128; ++d) r += bf2f(QR[(size_t)(t0 + i) * 512 + h * 128 + d]) * bf2f(RT[((size_t)(bh * 16 + n) << 14) + e * 128 + d]);
        OG[(size_t)(t0 + i) * 512 + h * 128 + e] = s + r * exp2f((float)(i + 1) * l2g);
    }
}
__global__ void k_gn(const bf16_t* PROJ, const float* OG, const float* gn, bf16_t* MIXIN) {
    const int gw = (blockIdx.x * blockDim.x + threadIdx.x) >> 6, lane = threadIdx.x & 63; if (gw >= T_ * 4) return;
    const int t = gw >> 2, h = gw & 3;
    const float o0 = OG[(size_t)t * 512 + h * 128 + 2 * lane], o1 = OG[(size_t)t * 512 + h * 128 + 2 * lane + 1];
    const float mu = wave_sum(o0 + o1) * (1.f / 128.f);
    const float d0 = o0 - mu, d1 = o1 - mu;
    const float var = wave_sum(d0 * d0 + d1 * d1) * (1.f / 128.f);
    const float rs = 1.f / sqrtf(var + EPS);
    const int c = h * 128 + 2 * lane;
    const float g0 = bf2f(PROJ[(size_t)t * INC + 2048 + c]), g1 = bf2f(PROJ[(size_t)t * INC + 2048 + c + 1]);
    *(unsigned*)(MIXIN + (size_t)t * D_ + 512 + c) = pk2(silu_f(g0) * d0 * rs * gn[c], silu_f(g1) * d1 * rs * gn[c + 1]);
}
__global__ void k_h2(const float* X1, const float* mod, const float* g_ffn, bf16_t* HN, float* H2F) {
    const int gw = (blockIdx.x * blockDim.x + threadIdx.x) >> 6, lane = threadIdx.x & 63; if (gw >= T_) return;
    const int r = gw, b = r / SEQ;
    const f32x4* xr = (const f32x4*)(X1 + (size_t)r * D_) + lane;
    f32x4 v[4]; float ss = 0.f;
#pragma unroll
    for (int j = 0; j < 4; ++j) { v[j] = xr[64 * j]; ss += (v[j].x * v[j].x + v[j].y * v[j].y) + (v[j].z * v[j].z + v[j].w * v[j].w); }
    const float rs = 1.f / sqrtf(wave_sum(ss) * (1.f / D_) + EPS);
    const float* sh = mod + b * NMOD + 3 * D_; const float* sc = mod + b * NMOD + 4 * D_;
#pragma unroll
    for (int j = 0; j < 4; ++j) {
        const int c0 = 4 * lane + 256 * j; float hv[4];
#pragma unroll
        for (int q = 0; q < 4; ++q) hv[q] = v[j][q] * rs * g_ffn[c0 + q] * (1.f + sc[c0 + q]) + sh[c0 + q];
        *(f32x4*)(H2F + (size_t)r * D_ + c0) = (f32x4){hv[0], hv[1], hv[2], hv[3]};
        *(unsigned long long*)(HN + (size_t)r * D_ + c0) = (unsigned long long)pk2(hv[0], hv[1]) | ((unsigned long long)pk2(hv[2], hv[3]) << 32);
    }
}
__global__ void k_logits(const float* H2F, const float* wr, const float* br, float* LG) {
    const int i = blockIdx.x * blockDim.x + threadIdx.x; if (i >= T_ * NE) return;
    const int t = i >> 5, e = i & 31; float s = 0.f;
    for (int k = 0; k < D_; ++k) s += H2F[(size_t)t * D_ + k] * wr[k * NE + e];
    LG[i] = s + br[e];
}
__global__ void k_topk(const float* LG, int* cnt, int* tokslot, float* wslot) {
    const int t = blockIdx.x * blockDim.x + threadIdx.x; if (t >= T_) return;
    float v[NE];
#pragma unroll
    for (int e = 0; e < NE; ++e) v[e] = LG[t * NE + e];
    float tv[4]; int ti[4];
#pragma unroll
    for (int k = 0; k < 4; ++k) {
        float best = -INFINITY; int bi = 0;
#pragma unroll
        for (int e = 0; e < NE; ++e) if (v[e] > best) { best = v[e]; bi = e; }
        tv[k] = best; ti[k] = bi;
#pragma unroll
        for (int e = 0; e < NE; ++e) if (e == bi) v[e] = -INFINITY;
    }
    float ex[4], se = 0.f;
#pragma unroll
    for (int k = 0; k < 4; ++k) { ex[k] = __expf(tv[k] - tv[0]); se += ex[k]; }
#pragma unroll
    for (int k = 0; k < 4; ++k) { const int rank = atomicAdd(&cnt[ti[k]], 1); tokslot[ti[k] * CAP + rank] = t * 4 + k; wslot[t * 4 + k] = ex[k] / se; }
}
__global__ void k_offsets(const int* cnt, int* pstart) {
    if (threadIdx.x == 0 && blockIdx.x == 0) { int s = 0; for (int e = 0; e < NE; ++e) { pstart[e] = s; s += ((cnt[e] + 255) / 256) * 256; } pstart[NE] = s; }
}
__global__ void __launch_bounds__(256) k_gateup(const bf16_t* HN, const bf16_t* WGUT, const float* bgu, const int* cnt, const int* pstart, const int* tokslot, bf16_t* ACT) {
    const int wave = threadIdx.x >> 6, lane = threadIdx.x & 63, fr = lane & 15, fq = lane >> 4, e = blockIdx.z, ne = cnt[e];
    const int a0 = blockIdx.x * 16;
    const int pn = a0 >> 7, i0 = a0 & 127;
    const bf16_t* Bg = WGUT + ((size_t)e * 2048 + 256 * pn + i0 + fr) * D_ + fq * 8;
    const bf16_t* Bl = Bg + (size_t)128 * D_;
    for (int rt = blockIdx.y; rt * 64 < ne; rt += gridDim.y) {
        const int rank = rt * 64 + wave * 16 + fr;
        const int tok = (rank < ne) ? (tokslot[e * CAP + rank] >> 2) : 0;
        const bf16_t* ap = HN + (size_t)tok * D_ + fq * 8;
        f32x4 ag = (f32x4){0.f, 0.f, 0.f, 0.f}, al = ag;
        for (int k0 = 0; k0 < D_; k0 += 32) {
            const bf16x8 av = *(const bf16x8*)(ap + k0);
            ag = MFMA16(*(const bf16x8*)(Bg + k0), av, ag); al = MFMA16(*(const bf16x8*)(Bl + k0), av, al);
        }
        if (rank < ne) {
#pragma unroll
            for (int j = 0; j < 4; ++j) {
                const int acol = a0 + 4 * fq + j;
                float gate = ag[j] + bgu[e * 2048 + 2 * acol], lin = al[j] + bgu[e * 2048 + 2 * acol + 1];
                gate = fminf(gate, 7.f); lin = fminf(fmaxf(lin, -7.f), 7.f);
                const float glu = gate / (1.f + __expf(-1.702f * gate));
                ACT[(size_t)(pstart[e] + rank) * FF + acol] = (bf16_t)f2bf((lin + 1.f) * glu);
            }
        }
    }
}
__global__ void __launch_bounds__(256) k_down(const bf16_t* ACT, const bf16_t* WDT, const float* bd, const int* cnt, const int* pstart, const int* tokslot, bf16_t* Y) {
    const int wave = threadIdx.x >> 6, lane = threadIdx.x & 63, fr = lane & 15, fq = lane >> 4, e = blockIdx.z, ne = cnt[e];
    const int col0 = blockIdx.x * 64;
    const bf16_t* bp = WDT + ((size_t)e * D_ + col0 + fr) * FF + fq * 8;
    for (int rt = blockIdx.y; rt * 64 < ne; rt += gridDim.y) {
        const int rank = rt * 64 + wave * 16 + fr;
        const bf16_t* ap = ACT + (size_t)(pstart[e] + ((rank < ne) ? rank : 0)) * FF + fq * 8;
        f32x4 acc[4];
#pragma unroll
        for (int n = 0; n < 4; ++n) acc[n] = (f32x4){0.f, 0.f, 0.f, 0.f};
        for (int k0 = 0; k0 < FF; k0 += 32) {
            const bf16x8 av = *(const bf16x8*)(ap + k0);
#pragma unroll
            for (int n = 0; n < 4; ++n) acc[n] = MFMA16(*(const bf16x8*)(bp + (size_t)n * 16 * FF + k0), av, acc[n]);
        }
        if (rank < ne) {
            const int slot = tokslot[e * CAP + rank];
#pragma unroll
            for (int n = 0; n < 4; ++n)
#pragma unroll
                for (int j = 0; j < 4; ++j) { const int c = col0 + n * 16 + 4 * fq + j; Y[(size_t)slot * D_ + c] = (bf16_t)f2bf(acc[n][j] + bd[e * D_ + c]); }
        }
    }
}
__global__ void k_final(const float* X1, const bf16_t* Y, const float* wslot, const float* mod, const float* g_final, float* out) {
    const int gw = (blockIdx.x * blockDim.x + threadIdx.x) >> 6, lane = threadIdx.x & 63; if (gw >= T_) return;
    const int r = gw, b = r / SEQ;
    const float* gt2 = mod + b * NMOD + 5 * D_;
    float w[4];
#pragma unroll
    for (int k = 0; k < 4; ++k) w[k] = wslot[r * 4 + k];
    f32x4 v[4]; float ss = 0.f;
#pragma unroll
    for (int j = 0; j < 4; ++j) {
        const int c0 = 4 * lane + 256 * j;
        f32x4 f = (f32x4){0.f, 0.f, 0.f, 0.f};
#pragma unroll
        for (int k = 0; k < 4; ++k) {
            const u32x2 y = *(const u32x2*)(Y + (size_t)(r * 4 + k) * D_ + c0);
            f.x += w[k] * bf2f(y.x & 0xffffu); f.y += w[k] * bf2f(y.x >> 16); f.z += w[k] * bf2f(y.y & 0xffffu); f.w += w[k] * bf2f(y.y >> 16);
        }
        const f32x4 x1 = *(const f32x4*)(X1 + (size_t)r * D_ + c0); const f32x4 g = *(const f32x4*)(gt2 + c0);
        v[j] = x1 + g * f;
        ss += (v[j].x * v[j].x + v[j].y * v[j].y) + (v[j].z * v[j].z + v[j].w * v[j].w);
    }
    const float rs = 1.f / sqrtf(wave_sum(ss) * (1.f / D_) + EPS);
#pragma unroll
    for (int j = 0; j < 4; ++j) { const int c0 = 4 * lane + 256 * j; const f32x4 g = *(const f32x4*)(g_final + c0); *(f32x4*)(out + (size_t)r * D_ + c0) = v[j] * rs * g; }
}

extern "C" void kernel_launch(void* const* d_in, const int* in_sizes, int n_in, void* d_out, int out_size, void* d_ws, size_t ws_size, hipStream_t stream) {
    static int grid = 0;
    if (grid == 0) {
        if (n_in != 19 || in_sizes[0] != T_ * D_ || out_size != T_ * D_ || ws_size < WS_END) { fprintf(stderr, "kernel_launch: unexpected shapes / workspace (n_in %d, ws %zu)\n", n_in, ws_size); grid = -1; return; }
        int dev = 0, cus = 0, per_cu = 0;
        if (hipGetDevice(&dev) != hipSuccess || hipDeviceGetAttribute(&cus, hipDeviceAttributeMultiprocessorCount, dev) != hipSuccess) { grid = -1; return; }
        if (hipFuncSetAttribute((const void*)mega, hipFuncAttributeMaxDynamicSharedMemorySize, LDS_BYTES) != hipSuccess) { fprintf(stderr, "hipFuncSetAttribute failed\n"); grid = -1; return; }
        if (hipOccupancyMaxActiveBlocksPerMultiprocessor(&per_cu, (const void*)mega, 512, LDS_BYTES) != hipSuccess || per_cu < 1) { fprintf(stderr, "occupancy query: %d\n", per_cu); }
        (void)hipGetLastError();
        grid = cus;
        if (grid != 256) fprintf(stderr, "kernel_launch: grid %d (expected 256)\n", grid);
    }
    if (grid < 0) return;
    unsigned char* ws = (unsigned char*)d_ws;
    (void)hipMemsetAsync(ws + WS_CTL, 0, CTL_ZERO_BYTES, stream);
    Args a{};
    for (int i = 0; i < 19; ++i) a.in[i] = (const float*)d_in[i];
    a.out = (float*)d_out; a.ws = ws;
    const float* const* in = a.in;
    float* MOD = (float*)(ws + WS_MOD); float* ROPE = (float*)(ws + WS_ROPE);
    bf16_t* POOLWT = (bf16_t*)(ws + WS_POOLWT); bf16_t* WINT = (bf16_t*)(ws + WS_WINT); bf16_t* WOUTT = (bf16_t*)(ws + WS_WOUTT);
    int* TOKSLOT = (int*)(ws + WS_TOKSLOT); float* WSLOT = (float*)(ws + WS_WSLOT);
    bf16_t* WGUT = (bf16_t*)(ws + WS_WGUT); bf16_t* WDT = (bf16_t*)(ws + WS_WDT); bf16_t* XN = (bf16_t*)(ws + WS_XN); bf16_t* PROJ = (bf16_t*)(ws + WS_PROJ);
    float* KVT = (float*)(ws + WS_KVT); bf16_t* RT = (bf16_t*)(ws + WS_RT); bf16_t* MIXIN = (bf16_t*)(ws + WS_MIXIN); float* X1 = (float*)(ws + WS_X1);
    bf16_t* HN = (bf16_t*)(ws + WS_HN); bf16_t* ACT = (bf16_t*)(ws + WS_ACT); bf16_t* Y = (bf16_t*)(ws + WS_Y);
    bf16_t* QR = (bf16_t*)(ws + WS_QR); bf16_t* KR = (bf16_t*)(ws + WS_KR); float* SG = (float*)(ws + WS_SG); float* OG = (float*)(ws + WS_OG);
    float* H2F = (float*)(ws + WS_H2F); float* LG = (float*)(ws + WS_LOGITS); bf16_t* PP = (bf16_t*)(ws + WS_PP);
    int* CNT = (int*)(ws + WS_CTL) + CW_CNT; int* PSTART = (int*)(ws + WS_CTL) + CW_PSTART;

    a.ph_lo = 0; a.ph_hi = 1; hipLaunchKernelGGL(mega, dim3(grid), dim3(512), LDS_BYTES, stream, a);
    a.ph_lo = 1; a.ph_hi = 2; hipLaunchKernelGGL(mega, dim3(grid), dim3(512), LDS_BYTES, stream, a);
    hipLaunchKernelGGL(k_sgemm<EpiStoreBf16>, dim3(INC / 64, T_ / 64), dim3(256), 0, stream, XN, WINT, EpiStoreBf16{PROJ, INC, D_});
    hipLaunchKernelGGL(k_pool_p, dim3(T_ * 512 / 256), dim3(256), 0, stream, PROJ, PP);
    hipLaunchKernelGGL(k_pool_mm, dim3(T_ * 512 / 256), dim3(256), 0, stream, PP, POOLWT, in[7], in[8], MIXIN);
    hipLaunchKernelGGL(k_rot, dim3(T_ * 256 / 256), dim3(256), 0, stream, PROJ, ROPE, QR, KR);
    hipLaunchKernelGGL(k_kv, dim3(32 * 15), dim3(256), 0, stream, PROJ, KR, KVT);
    hipLaunchKernelGGL(k_scan, dim3(32 * 16384 / 256), dim3(256), 0, stream, KVT, RT);
    hipLaunchKernelGGL(k_S, dim3(512), dim3(256), 0, stream, QR, KR, SG);
    hipLaunchKernelGGL(k_o, dim3(512), dim3(256), 0, stream, PROJ, QR, SG, RT, OG);
    hipLaunchKernelGGL(k_gn, dim3(T_ * 4 * 64 / 256), dim3(256), 0, stream, PROJ, OG, in[9], MIXIN);
    hipLaunchKernelGGL(k_sgemm<EpiOutProj>, dim3(D_ / 64, T_ / 64), dim3(256), 0, stream, MIXIN, WOUTT, EpiOutProj{in[0], MOD, X1, D_, 0});
    hipLaunchKernelGGL(k_h2, dim3(T_ * 64 / 256), dim3(256), 0, stream, X1, MOD, in[11], HN, H2F);
    hipLaunchKernelGGL(k_logits, dim3(T_ * NE / 256), dim3(256), 0, stream, H2F, in[12], in[13], LG);
    hipLaunchKernelGGL(k_topk, dim3(T_ / 256), dim3(256), 0, stream, LG, CNT, TOKSLOT, WSLOT);
    hipLaunchKernelGGL(k_offsets, dim3(1), dim3(64), 0, stream, CNT, PSTART);
    hipLaunchKernelGGL(k_gateup, dim3(FF / 16, 40, NE), dim3(256), 0, stream, HN, WGUT, in[15], CNT, PSTART, TOKSLOT, ACT);
    hipLaunchKernelGGL(k_down, dim3(D_ / 64, 40, NE), dim3(256), 0, stream, ACT, WDT, in[17], CNT, PSTART, TOKSLOT, Y);
    hipLaunchKernelGGL(k_final, dim3(T_ * 64 / 256), dim3(256), 0, stream, X1, Y, WSLOT, MOD, in[18], (float*)d_out);
}
```

```cpp
#include <hip/hip_runtime.h>
#include <cstdint>
#include <cstdio>

typedef unsigned short bf16_t;
typedef short bf16x8 __attribute__((ext_vector_type(8)));
typedef float f32x4 __attribute__((ext_vector_type(4)));
typedef unsigned u32x4 __attribute__((ext_vector_type(4)));
typedef unsigned u32x2 __attribute__((ext_vector_type(2)));
#define LAS __attribute__((address_space(3)))

#ifndef ONE_LAUNCH
#define ONE_LAUNCH 1
#endif
#ifndef SIMPLE_MIX
#define SIMPLE_MIX 0
#endif
#ifndef SIMPLE_ROUTER
#define SIMPLE_ROUTER 0
#endif
#ifndef SIMPLE_FINAL
#define SIMPLE_FINAL 0
#endif
#ifndef SIMPLE_INPROJ
#define SIMPLE_INPROJ 0
#endif
#ifndef SIMPLE_OUTPROJ
#define SIMPLE_OUTPROJ 0
#endif
#ifndef SIMPLE_GATEUP
#define SIMPLE_GATEUP 0
#endif
#ifndef SIMPLE_DOWN
#define SIMPLE_DOWN 0
#endif
constexpr int T_ = 16384, D_ = 1024, NB = 8, SEQ = 2048, INC = 2560, NE = 32, FF = 1024, TK = 65536, NMOD = 6144;
constexpr int CAP = 16384;
constexpr int ACT_ROWS = TK + NE * 256;
constexpr float EPS = 1e-6f;

constexpr size_t MiB = 1u << 20;
constexpr size_t WS_CTL = 0, CTL_ZERO_BYTES = 1 * MiB;
constexpr size_t WS_MODP = 1 * MiB;
constexpr size_t WS_MOD = 3 * MiB;
constexpr size_t WS_ROPE = 4 * MiB;
constexpr size_t WS_POOLWT = 5 * MiB;
constexpr size_t WS_WINT = 6 * MiB;
constexpr size_t WS_WOUTT = 11 * MiB;
constexpr size_t WS_TOKSLOT = 13 * MiB;
constexpr size_t WS_WSLOT = 15 * MiB;
constexpr size_t WS_WGUT = 16 * MiB;
constexpr size_t WS_WDT = 144 * MiB;
constexpr size_t WS_XN = 208 * MiB;
constexpr size_t WS_PROJ = 240 * MiB;
constexpr size_t WS_KVT = 320 * MiB;
constexpr size_t WS_RT = 352 * MiB;
constexpr size_t WS_MIXIN = 368 * MiB;
constexpr size_t WS_X1 = 400 * MiB;
constexpr size_t WS_HN = 464 * MiB;
constexpr size_t WS_ACT = 496 * MiB;
constexpr size_t WS_Y = 640 * MiB;
constexpr size_t WS_QR = 768 * MiB;
constexpr size_t WS_KR = 784 * MiB;
constexpr size_t WS_SG = 800 * MiB;
constexpr size_t WS_OG = 832 * MiB;
constexpr size_t WS_H2F = 864 * MiB;
constexpr size_t WS_LOGITS = 928 * MiB;
constexpr size_t WS_PP = 930 * MiB;
constexpr size_t WS_END = 946 * MiB;
constexpr int CW_CNT = 64;
constexpr int CW_PSTART = 128;

#define MFMA16(a, b, c) __builtin_amdgcn_mfma_f32_16x16x32_bf16(a, b, c, 0, 0, 0)
__device__ __forceinline__ unsigned f2bf(float f) { unsigned u = __float_as_uint(f); return (u + 0x7fffu + ((u >> 16) & 1u)) >> 16; }
__device__ __forceinline__ unsigned pk2(float lo, float hi) { return f2bf(lo) | (f2bf(hi) << 16); }
__device__ __forceinline__ float bf2f(unsigned h) { return __uint_as_float(h << 16); }
__device__ __forceinline__ float wave_sum(float v) {
#pragma unroll
    for (int o = 1; o < 64; o <<= 1) v += __shfl_xor(v, o);
    return v;
}
__device__ __forceinline__ float silu_f(float v) { return v / (1.f + __expf(-v)); }
__device__ __forceinline__ float log2_gamma(int h) { return log2f(1.f - exp2f(-5.f - (float)h)); }

constexpr int NWAVES = 8;
constexpr int LDS_BYTES = 147456;

template <int MAPMODE>
__device__ __forceinline__ void transpose_item(const float* W, int K, int N, bf16_t* WT, LAS float* scr, int item, int lane) {
    const int nblk = N / 32, kb = item / nblk, nb = item % nblk, k0 = 64 * kb, n0 = 32 * nb;
#pragma unroll 8
    for (int i = 0; i < 32; ++i) { const int kk = 2 * i + (lane >> 5); scr[kk * 33 + (lane & 31)] = W[(size_t)(k0 + kk) * N + n0 + (lane & 31)]; }
    asm volatile("s_waitcnt lgkmcnt(0)" ::: "memory");
    const int c = lane & 7;
#pragma unroll
    for (int j = 0; j < 4; ++j) {
        const int nl = (lane >> 3) + 8 * j; const LAS float* s = scr + (8 * c) * 33 + nl;
        u32x4 o; o.x = pk2(s[0 * 33], s[1 * 33]); o.y = pk2(s[2 * 33], s[3 * 33]); o.z = pk2(s[4 * 33], s[5 * 33]); o.w = pk2(s[6 * 33], s[7 * 33]);
        const int n = n0 + nl; int row = n;
        if (MAPMODE == 1) { const int a = n >> 1, bj = n & 1; row = 256 * (a >> 7) + 128 * bj + (a & 127); }
        *(u32x4*)(WT + (size_t)row * K + k0 + 8 * c) = o;
    }
    asm volatile("s_waitcnt lgkmcnt(0)" ::: "memory");
}

struct Args {
    const float* in[19]; float* out; unsigned char* ws; int ph_lo, ph_hi;
};

__device__ __forceinline__ void phase_p0(const Args& a, LAS unsigned char* lds, int vb, int G) {
    const int tid = threadIdx.x, lane = tid & 63, wave = tid >> 6;
    unsigned char* ws = a.ws;
    if (vb < 256) {
        LAS float* cact = (LAS float*)lds;
        LAS float* part = (LAS float*)(lds + 4096);
        const int kc = vb & 7, cc = vb >> 3;
        const float* c = a.in[1];
        for (int i = tid; i < 8 * 128; i += 512) { const int b = i >> 7, k = i & 127; cact[i] = silu_f(c[b * D_ + kc * 128 + k]); }
        __syncthreads();
        const int cg = tid % 48, ks = tid / 48;
        if (ks < 10) {
            f32x4 acc[8];
#pragma unroll
            for (int b = 0; b < 8; ++b) acc[b] = (f32x4){0.f, 0.f, 0.f, 0.f};
            const float* w = a.in[2] + (size_t)(kc * 128) * NMOD + cc * 192 + cg * 4;
            for (int k = ks; k < 128; k += 10) {
                const f32x4 wv = *(const f32x4*)(w + (size_t)k * NMOD);
#pragma unroll
                for (int b = 0; b < 8; ++b) acc[b] += wv * cact[b * 128 + k];
            }
#pragma unroll
            for (int b = 0; b < 8; ++b) *(LAS f32x4*)(part + (ks * 8 + b) * 192 + cg * 4) = acc[b];
        }
        __syncthreads();
        float* modp = (float*)(ws + WS_MODP);
        for (int i = tid; i < 8 * 192; i += 512) {
            const int b = i / 192, col = i % 192; float s = 0.f;
#pragma unroll
            for (int q = 0; q < 10; ++q) s += part[(q * 8 + b) * 192 + col];
            modp[((size_t)kc * 8 + b) * NMOD + cc * 192 + col] = s;
        }
        __syncthreads();
    }
    {
        float* cosT = (float*)(ws + WS_ROPE); float* sinT = cosT + SEQ * 64;
        for (int i = vb * 512 + tid; i < SEQ * 64; i += G * 512) {
            const int pos = i >> 6, j = i & 63;
            const double inv = (double)(float)exp(-(double)j * (9.210340371976184 / 64.0));
            const double ang = (double)((float)pos * (float)inv);
            const double q = rint(ang * 0.6366197723675814);
            double r = fma(-q, 1.5707963267948966, ang); r = fma(-q, 6.123233995736766e-17, r);
            const double r2 = r * r;
            double s = -1.0 / 39916800.0; s = s * r2 + 1.0 / 362880.0; s = s * r2 - 1.0 / 5040.0; s = s * r2 + 1.0 / 120.0; s = s * r2 - 1.0 / 6.0; s = s * r2 + 1.0; s *= r;
            double co = 1.0 / 479001600.0; co = co * r2 - 1.0 / 3628800.0; co = co * r2 + 1.0 / 40320.0; co = co * r2 - 1.0 / 720.0; co = co * r2 + 1.0 / 24.0; co = co * r2 - 0.5; co = co * r2 + 1.0;
            const int n = ((int)q) & 3;
            const double sv = (n == 0) ? s : (n == 1) ? co : (n == 2) ? -s : -co;
            const double cv = (n == 0) ? co : (n == 1) ? -s : (n == 2) ? -co : s;
            cosT[i] = (float)cv; sinT[i] = (float)sv;
        }
    }
    {
        LAS float* scr = (LAS float*)(lds + wave * 16384);
        const int gw = vb * NWAVES + wave, NGW = G * NWAVES;
        constexpr int I_IN = (D_ / 64) * (INC / 32), I_OUT = (D_ / 64) * (D_ / 32), I_POOL = 4 * 2 * 4, I_GU = (D_ / 64) * (2 * FF / 32), I_DN = (FF / 64) * (D_ / 32);
        constexpr int NITEMS = I_IN + I_OUT + I_POOL + NE * I_GU + NE * I_DN;
        for (int it = gw; it < NITEMS; it += NGW) {
            int r = it;
            if (r < I_IN) { transpose_item<0>(a.in[5], D_, INC, (bf16_t*)(ws + WS_WINT), scr, r, lane); continue; } r -= I_IN;
            if (r < I_OUT) { transpose_item<0>(a.in[10], D_, D_, (bf16_t*)(ws + WS_WOUTT), scr, r, lane); continue; } r -= I_OUT;
            if (r < I_POOL) { const int g = r / 8; transpose_item<0>(a.in[6] + g * 128 * 128, 128, 128, (bf16_t*)(ws + WS_POOLWT) + g * 128 * 128, scr, r % 8, lane); continue; } r -= I_POOL;
            if (r < NE * I_GU) { const int e = r / I_GU; transpose_item<1>(a.in[14] + (size_t)e * D_ * 2 * FF, D_, 2 * FF, (bf16_t*)(ws + WS_WGUT) + (size_t)e * 2 * FF * D_, scr, r % I_GU, lane); continue; } r -= NE * I_GU;
            { const int e = r / I_DN; transpose_item<0>(a.in[16] + (size_t)e * FF * D_, FF, D_, (bf16_t*)(ws + WS_WDT) + (size_t)e * D_ * FF, scr, r % I_DN, lane); }
        }
    }
}

__device__ __forceinline__ void phase_p1(const Args& a, LAS unsigned char* lds, int vb, int G) {
    const int tid = threadIdx.x, lane = tid & 63, wave = tid >> 6;
    unsigned char* ws = a.ws;
    const float* modp = (const float*)(ws + WS_MODP); float* mod = (float*)(ws + WS_MOD);
    for (int i = vb * 512 + tid; i < NB * NMOD; i += G * 512) {
        const int col = i % NMOD; float s = a.in[3][col];
#pragma unroll
        for (int q = 0; q < 8; ++q) s += modp[(size_t)q * NB * NMOD + i];
        mod[i] = s;
    }
    const int RPB = T_ / G;
    const int row0 = vb * RPB, b = row0 / SEQ;
    LAS float* shs = (LAS float*)lds;
    LAS float* scs = shs + 1024;
    for (int i = tid; i < 2048; i += 512) {
        float s = a.in[3][i];
#pragma unroll
        for (int q = 0; q < 8; ++q) s += modp[(size_t)q * NB * NMOD + (size_t)b * NMOD + i];
        if (i < 1024) shs[i] = s; else scs[i - 1024] = (1.f + s) * a.in[4][i - 1024];
    }
    __syncthreads();
    bf16_t* XN = (bf16_t*)(ws + WS_XN);
    for (int r = row0 + wave; r < row0 + RPB; r += NWAVES) {
        const f32x4* xr = (const f32x4*)(a.in[0] + (size_t)r * D_) + lane;
        f32x4 v[4]; float ss = 0.f;
#pragma unroll
        for (int j = 0; j < 4; ++j) { v[j] = xr[64 * j]; ss += (v[j].x * v[j].x + v[j].y * v[j].y) + (v[j].z * v[j].z + v[j].w * v[j].w); }
        const float rs = 1.f / sqrtf(wave_sum(ss) * (1.f / D_) + EPS);
        unsigned long long* o8 = (unsigned long long*)(XN + (size_t)r * D_) + lane;
#pragma unroll
        for (int j = 0; j < 4; ++j) {
            const int c0 = 4 * lane + 256 * j;
            const float h0 = v[j].x * rs * scs[c0] + shs[c0], h1 = v[j].y * rs * scs[c0 + 1] + shs[c0 + 1], h2 = v[j].z * rs * scs[c0 + 2] + shs[c0 + 2], h3 = v[j].w * rs * scs[c0 + 3] + shs[c0 + 3];
            o8[64 * j] = (unsigned long long)pk2(h0, h1) | ((unsigned long long)pk2(h2, h3) << 32);
        }
    }
    __syncthreads();
}


namespace pg8 {
constexpr int BM = 256, BK = 64, HALF = 128, HTB = HALF * BK * 2, STAGE_BYTES = 8 * HTB, NXCD = 8, WGM = 8;
__host__ __device__ __forceinline__ int lds_byte(int r, int c) { const int st = (r >> 4) * 2 + (c >> 5), rr = r & 15, cc = c & 31, ob = rr * 64 + cc * 2; return st * 1024 + (ob ^ (((ob >> 9) & 1) << 5)); }
__host__ __device__ __forceinline__ void stage_rc(int b, int& R, int& C) { const int st = b / 1024, sb = b % 1024, swz = sb ^ (((sb >> 9) & 1) << 5); R = (st >> 1) * 16 + swz / 64; C = (st & 1) * 32 + (swz % 64) / 2; }
__host__ __device__ __forceinline__ int perm32(int rho) { const int n = rho >> 4, i = rho & 15; return 8 * (i >> 2) + 4 * n + (i & 3); }

struct Unit { int pm, pn, e, r0; };
struct Gemm { const bf16_t* A; const bf16_t* Bt; int N, K; size_t bstride; };

struct TileOrder {
    int nM, nN, nwg, G, c;
    __device__ __forceinline__ void init(int nM_, int nN_, int G_, int c_) { nM = nM_; nN = nN_; nwg = nM * nN; G = G_; c = c_; }
    __device__ __forceinline__ bool tile(int i, int& pm, int& pn) const {
        const long L = (long)i * G + c; if (L >= nwg) return false;
        int wgid = (int)L; { const int q = nwg / NXCD, r = nwg % NXCD, xcd = wgid % NXCD, off = wgid / NXCD; wgid = (xcd < r ? xcd * (q + 1) : r * (q + 1) + (xcd - r) * q) + off; }
        const int nig = WGM * nN, gid = wgid / nig, fm = gid * WGM, gsz = (nM - fm) < WGM ? (nM - fm) : WGM;
        pm = fm + ((wgid % nig) % gsz); pn = (wgid % nig) / gsz; return true;
    }
};
struct DenseOrder : TileOrder {
    __device__ __forceinline__ bool next(int i, Unit& u) const { int pm, pn; if (!tile(i, pm, pn)) return false; u.pm = pm; u.pn = pn; u.e = 0; u.r0 = pm * BM; return true; }
    __device__ __forceinline__ int arow(int, const Unit& u, int lr) const { return u.r0 + lr; }
};

__device__ __forceinline__ unsigned cvt_pk_bf16(float lo, float hi) { unsigned r; asm volatile("v_cvt_pk_bf16_f32 %0, %1, %2" : "=v"(r) : "v"(lo), "v"(hi)); return r; }

template <class Epi, class Sched, bool ALIGN_EPI>
__device__ __forceinline__ void gemm_phase(LAS unsigned char* lds, const Gemm g, const Sched& S, const Epi& E) {
    const int tid = threadIdx.x, wid = __builtin_amdgcn_readfirstlane(tid >> 6), lane = tid & 63, wr = wid >> 2, wc = wid & 3, fr = lane & 15, fq = lane >> 4;
    const int K = g.K, nt = K / BK;
    int Rs[2], Cs[2]; unsigned voffB[2];
#pragma unroll
    for (int i = 0; i < 2; ++i) { int R, C; stage_rc(tid * 16 + i * 8192, R, C); Rs[i] = R; Cs[i] = C; const int Rb = Epi::PERM ? ((R & ~31) + perm32(R & 31)) : R; voffB[i] = (unsigned)(Rb * K + C) * 2u; }
    const size_t kstep = (size_t)(BK * 2);
    const size_t hstep = (size_t)HALF * K * 2;
    const size_t tstep = 2 * hstep;
    const unsigned ldsw = (unsigned)wid * 1024u;
    const int aoff = lds_byte(wr * 64 + fr, fq * 8), boff = lds_byte(wc * 32 + fr, fq * 8);
#define PG8_SA(b, h) (((b) * 2 + (h)) * HTB)
#define PG8_SB(b, h) ((4 + (b) * 2 + (h)) * HTB)
#define PG8_STAGE(bufoff, gbase, voff) do { _Pragma("unroll") for (int _i = 0; _i < 2; ++_i) \
        __builtin_amdgcn_global_load_lds((const unsigned*)((const char*)(gbase) + (voff)[_i]), (LAS unsigned*)(lds + (bufoff) + ldsw + _i * 8192), 16, 0, 0); } while (0)
#define PG8_LDA(dst, b, h) do { _Pragma("unroll") for (int m = 0; m < 4; ++m) _Pragma("unroll") for (int k = 0; k < 2; ++k) dst[m][k] = *(const LAS bf16x8*)(lds + PG8_SA(b, h) + aoff + m * 2048 + k * 1024); } while (0)
#define PG8_LDB(dst, b, h) do { _Pragma("unroll") for (int n = 0; n < 2; ++n) _Pragma("unroll") for (int k = 0; k < 2; ++k) dst[n][k] = *(const LAS bf16x8*)(lds + PG8_SB(b, h) + boff + n * 2048 + k * 1024); } while (0)
#define PG8_MMA(ai, bj, At, Bt) do { __builtin_amdgcn_s_setprio(1); _Pragma("unroll") for (int m = 0; m < 4; ++m) _Pragma("unroll") for (int n = 0; n < 2; ++n) _Pragma("unroll") for (int k = 0; k < 2; ++k) \
        acc[ai][bj][m][n] = __builtin_amdgcn_mfma_f32_16x16x32_bf16(Bt[n][k], At[m][k], acc[ai][bj][m][n], 0, 0, 0); __builtin_amdgcn_s_setprio(0); } while (0)
#define PG8_WAIT_V(n) asm volatile("s_waitcnt vmcnt(" #n ")" ::: "memory")
#define PG8_WAIT_L(n) asm volatile("s_waitcnt lgkmcnt(" #n ")" ::: "memory")
#define PG8_BAR __builtin_amdgcn_s_barrier()
#define PG8_SCHED __builtin_amdgcn_sched_barrier(0)
#define PG8_AOFF(dst, i_, u_) do { _Pragma("unroll") for (int _h = 0; _h < 2; ++_h) _Pragma("unroll") for (int _i = 0; _i < 2; ++_i) \
        dst[_h][_i] = ((unsigned)S.arow(i_, u_, _h * HALF + Rs[_i]) * (unsigned)K + (unsigned)Cs[_i]) * 2u; } while (0)
    Unit cur, nxt; int ui = 0;
    if (!S.next(0, cur)) return;
    f32x4 acc[2][2][4][2];
#pragma unroll
    for (int a = 0; a < 2; ++a)
#pragma unroll
        for (int b = 0; b < 2; ++b)
#pragma unroll
            for (int m = 0; m < 4; ++m)
#pragma unroll
                for (int n = 0; n < 2; ++n) acc[a][b][m][n] = (f32x4){0.f, 0.f, 0.f, 0.f};
    bf16x8 At[4][2], B0[2][2], B1[2][2];
    unsigned voffA[2][2], nvoffA[2][2];
    PG8_AOFF(voffA, 0, cur);
    const char* const cA = (const char*)g.A;
    const char* cB = (const char*)g.Bt + (size_t)cur.e * g.bstride + (size_t)cur.pn * tstep;
    PG8_STAGE(PG8_SB(0, 0), cB, voffB); PG8_STAGE(PG8_SB(0, 1), cB + hstep, voffB); PG8_STAGE(PG8_SA(0, 0), cA, voffA[0]); PG8_STAGE(PG8_SA(0, 1), cA, voffA[1]);
    if (wr == 1) PG8_BAR;
    PG8_WAIT_V(2); PG8_BAR;
    PG8_STAGE(PG8_SB(1, 0), cB + kstep, voffB); PG8_STAGE(PG8_SA(1, 0), cA + kstep, voffA[0]); PG8_STAGE(PG8_SB(1, 1), cB + hstep + kstep, voffB);
    PG8_WAIT_V(6); PG8_BAR;
    for (;;) {
        const bool has_next = S.next(ui + 1, nxt);
        if (has_next) { PG8_AOFF(nvoffA, ui + 1, nxt); }
        else {
#pragma unroll
            for (int h = 0; h < 2; ++h)
#pragma unroll
                for (int i = 0; i < 2; ++i) nvoffA[h][i] = voffA[h][i];
        }
        const char* nB = has_next ? (const char*)g.Bt + (size_t)nxt.e * g.bstride + (size_t)nxt.pn * tstep : cB;
        for (int t = 0; t < nt; t += 2) {
            const bool last = (t == nt - 2);
            const char* a1 = cA + (size_t)(t + 1) * kstep;
            const char* a2 = last ? cA : cA + (size_t)(t + 2) * kstep; const char* b2 = last ? nB : cB + (size_t)(t + 2) * kstep;
            const char* a3 = a2 + kstep; const char* b3 = b2 + kstep;
            unsigned v2[2][2];
#pragma unroll
            for (int h = 0; h < 2; ++h)
#pragma unroll
                for (int i = 0; i < 2; ++i) v2[h][i] = last ? nvoffA[h][i] : voffA[h][i];
            PG8_LDB(B0, 0, 0); PG8_LDB(B1, 0, 1); PG8_SCHED; PG8_LDA(At, 0, 0); PG8_STAGE(PG8_SA(1, 1), a1, voffA[1]);
            PG8_WAIT_V(8); PG8_WAIT_L(0); PG8_BAR; PG8_MMA(0, 0, At, B0); PG8_MMA(0, 1, At, B1); PG8_BAR; PG8_SCHED;
            PG8_LDA(At, 0, 1); PG8_STAGE(PG8_SB(0, 0), b2, voffB); PG8_STAGE(PG8_SB(0, 1), b2 + hstep, voffB); PG8_STAGE(PG8_SA(0, 0), a2, v2[0]);
            PG8_WAIT_V(8); PG8_WAIT_L(0); PG8_BAR; PG8_MMA(1, 0, At, B0); PG8_MMA(1, 1, At, B1); PG8_BAR; PG8_SCHED;
            PG8_LDB(B0, 1, 0); PG8_LDB(B1, 1, 1); PG8_SCHED; PG8_LDA(At, 1, 0); PG8_STAGE(PG8_SA(0, 1), a2, v2[1]);
            PG8_WAIT_V(8); PG8_WAIT_L(0); PG8_BAR; PG8_MMA(0, 0, At, B0); PG8_MMA(0, 1, At, B1); PG8_BAR; PG8_SCHED;
            PG8_LDA(At, 1, 1); PG8_STAGE(PG8_SB(1, 0), b3, voffB); PG8_STAGE(PG8_SB(1, 1), b3 + hstep, voffB); PG8_STAGE(PG8_SA(1, 0), a3, v2[0]);
            PG8_WAIT_V(8); PG8_WAIT_L(0); PG8_BAR; PG8_MMA(1, 0, At, B0); PG8_MMA(1, 1, At, B1); PG8_BAR; PG8_SCHED;
        }
        if constexpr (ALIGN_EPI) { if (wr == 0) PG8_BAR; }
        E(acc, cur, ui, wr, wc, fr, fq);
        if (!has_next) break;
#pragma unroll
        for (int a = 0; a < 2; ++a)
#pragma unroll
            for (int b = 0; b < 2; ++b)
#pragma unroll
                for (int m = 0; m < 4; ++m)
#pragma unroll
                    for (int n = 0; n < 2; ++n) acc[a][b][m][n] = (f32x4){0.f, 0.f, 0.f, 0.f};
        cur = nxt; cB = nB; ++ui;
#pragma unroll
        for (int h = 0; h < 2; ++h)
#pragma unroll
            for (int i = 0; i < 2; ++i) voffA[h][i] = nvoffA[h][i];
        if constexpr (ALIGN_EPI) { if (wr == 1) PG8_BAR; }
    }
    PG8_WAIT_V(0);
    if constexpr (!ALIGN_EPI) { if (wr == 0) PG8_BAR; }
    PG8_BAR;
#undef PG8_SA
#undef PG8_SB
#undef PG8_STAGE
#undef PG8_LDA
#undef PG8_LDB
#undef PG8_MMA
#undef PG8_WAIT_V
#undef PG8_WAIT_L
#undef PG8_BAR
#undef PG8_SCHED
#undef PG8_AOFF
}

struct EpiProj {
    static constexpr bool PERM = true;
    bf16_t* O;
    __device__ __forceinline__ void operator()(const f32x4 (&acc)[2][2][4][2], const Unit& u, int, int wr, int wc, int fr, int fq) const {
        const int row0 = u.r0 + wr * 64 + fr, col0 = u.pn * BM + wc * 32 + 8 * fq;
#pragma unroll
        for (int ai = 0; ai < 2; ++ai)
#pragma unroll
            for (int m = 0; m < 4; ++m) { bf16_t* rowp = O + (size_t)(row0 + ai * HALF + m * 16) * INC + col0;
#pragma unroll
                for (int bj = 0; bj < 2; ++bj) { const f32x4 v0 = acc[ai][bj][m][0], v1 = acc[ai][bj][m][1];
                    u32x4 w; w.x = cvt_pk_bf16(v0[0], v0[1]); w.y = cvt_pk_bf16(v0[2], v0[3]); w.z = cvt_pk_bf16(v1[0], v1[1]); w.w = cvt_pk_bf16(v1[2], v1[3]);
                    *(u32x4*)(rowp + bj * HALF) = w; } }
    }
};
struct EpiX1 {
    static constexpr bool PERM = false;
    const float* x; const float* mod; float* X1;
    __device__ __forceinline__ void operator()(const f32x4 (&acc)[2][2][4][2], const Unit& u, int, int wr, int wc, int fr, int fq) const {
        const int row0 = u.r0 + wr * 64 + fr, col0 = u.pn * BM + wc * 32 + 4 * fq, b = u.r0 / SEQ;
        f32x4 gv[2][2];
#pragma unroll
        for (int bj = 0; bj < 2; ++bj)
#pragma unroll
            for (int n = 0; n < 2; ++n) gv[bj][n] = *(const f32x4*)(mod + b * NMOD + 2 * D_ + col0 + bj * HALF + n * 16);
#pragma unroll
        for (int ai = 0; ai < 2; ++ai)
#pragma unroll
            for (int m = 0; m < 4; ++m) { const size_t off = (size_t)(row0 + ai * HALF + m * 16) * D_ + col0;
#pragma unroll
                for (int bj = 0; bj < 2; ++bj)
#pragma unroll
                    for (int n = 0; n < 2; ++n) { const f32x4 xv = *(const f32x4*)(x + off + bj * HALF + n * 16); *(f32x4*)(X1 + off + bj * HALF + n * 16) = xv + gv[bj][n] * acc[ai][bj][m][n]; }
                if (m & 1) asm volatile("" ::: "memory"); }
    }
};
}

constexpr int RING_BYTES = 131072, LDSCTL_OFF = RING_BYTES;
constexpr int L_MISC = LDSCTL_OFF;
constexpr int L_CNT = LDSCTL_OFF + 256;
constexpr int L_PSTART = LDSCTL_OFF + 384;
constexpr int L_NT = LDSCTL_OFF + 640;
constexpr int L_TILES = LDSCTL_OFF + 768;
constexpr int L_ROWTAB = LDSCTL_OFF + 2048;
constexpr int MAX_UNITS = 12;
static_assert(L_ROWTAB + MAX_UNITS * 1024 <= LDS_BYTES, "LDS map");
constexpr int CW_BAR = 4096;

struct GroupedOrder : pg8::TileOrder {
    LAS const int* tiles; LAS const int* rowtab; LAS const int* pstart; int mode;
    __device__ __forceinline__ bool next(int i, pg8::Unit& u) const { int pm, pn; if (!tile(i, pm, pn)) return false; const int t = tiles[pm]; u.pm = pm; u.pn = pn; u.e = t & 255; u.r0 = (t >> 8) * 256; return true; }
    __device__ __forceinline__ int arow(int i, const pg8::Unit& u, int lr) const { return mode == 0 ? rowtab[i * 256 + lr] : pstart[u.e] + u.r0 + lr; }
};
__device__ __forceinline__ void grouped_prepare(GroupedOrder& S, LAS unsigned char* lds, const unsigned char* ws, int nN, int G, int c, int mode) {
    const int tid = threadIdx.x;
    LAS int* cnt = (LAS int*)(lds + L_CNT); LAS int* pstart = (LAS int*)(lds + L_PSTART); LAS int* tiles = (LAS int*)(lds + L_TILES); LAS int* rowtab = (LAS int*)(lds + L_ROWTAB); LAS int* pNT = (LAS int*)(lds + L_NT);
    const int* gcnt = (const int*)(ws + WS_CTL) + CW_CNT;
    if (tid < NE) cnt[tid] = __hip_atomic_load(gcnt + tid, __ATOMIC_RELAXED, __HIP_MEMORY_SCOPE_AGENT);
    __syncthreads();
    if (tid == 0) { int s = 0, nt = 0; for (int e = 0; e < NE; ++e) { pstart[e] = s; const int k = (cnt[e] + 255) >> 8; for (int j = 0; j < k; ++j) tiles[nt++] = e | (j << 8); s += k * 256; } pstart[NE] = s; *pNT = nt; }
    __syncthreads();
    S.init(*pNT, nN, G, c); S.tiles = tiles; S.rowtab = rowtab; S.pstart = pstart; S.mode = mode;
    const int* tokslot = (const int*)(ws + WS_TOKSLOT);
    for (int i = 0; i < MAX_UNITS; ++i) {
        pg8::Unit u; if (!S.next(i, u)) break;
        if (tid < 256) { const int rank = u.r0 + tid; int v; if (rank < cnt[u.e]) { const int sl = tokslot[u.e * CAP + rank]; v = mode == 0 ? (sl >> 2) : sl; } else v = mode == 0 ? 0 : -1; rowtab[i * 256 + tid] = v; }
    }
    __syncthreads();
}
struct EpiGateUp {
    static constexpr bool PERM = true;
    bf16_t* ACT; const float* bgu; LAS const int* pstart;
    __device__ __forceinline__ void operator()(const f32x4 (&acc)[2][2][4][2], const pg8::Unit& u, int, int wr, int wc, int fr, int fq) const {
        const int a0 = u.pn * 128 + wc * 32 + 8 * fq;
        const int prow0 = pstart[u.e] + u.r0 + wr * 64 + fr;
        f32x4 bb[4];
#pragma unroll
        for (int q = 0; q < 4; ++q) bb[q] = *(const f32x4*)(bgu + (size_t)u.e * 2 * FF + 2 * a0 + 4 * q);
#pragma unroll
        for (int ai = 0; ai < 2; ++ai)
#pragma unroll
            for (int m = 0; m < 4; ++m) {
                float o[8];
#pragma unroll
                for (int n = 0; n < 2; ++n)
#pragma unroll
                    for (int j = 0; j < 4; ++j) {
                        const int q = n * 4 + j;
                        float gate = acc[ai][0][m][n][j] + bb[q >> 1][(q & 1) * 2], lin = acc[ai][1][m][n][j] + bb[q >> 1][(q & 1) * 2 + 1];
                        gate = fminf(gate, 7.f); lin = fminf(fmaxf(lin, -7.f), 7.f);
                        const float glu = gate * __builtin_amdgcn_rcpf(1.f + __expf(-1.702f * gate));
                        o[q] = (lin + 1.f) * glu;
                    }
                u32x4 w; w.x = pg8::cvt_pk_bf16(o[0], o[1]); w.y = pg8::cvt_pk_bf16(o[2], o[3]); w.z = pg8::cvt_pk_bf16(o[4], o[5]); w.w = pg8::cvt_pk_bf16(o[6], o[7]);
                *(u32x4*)(ACT + (size_t)(prow0 + ai * 128 + m * 16) * FF + a0) = w;
            }
    }
};
struct EpiDown {
    static constexpr bool PERM = true;
    bf16_t* Y; const float* bd; LAS const int* rowtab;
    __device__ __forceinline__ void operator()(const f32x4 (&acc)[2][2][4][2], const pg8::Unit& u, int ui, int wr, int wc, int fr, int fq) const {
        const int col0 = u.pn * 256 + wc * 32 + 8 * fq;
        f32x4 bv[2][2];
#pragma unroll
        for (int bj = 0; bj < 2; ++bj)
#pragma unroll
            for (int n = 0; n < 2; ++n) bv[bj][n] = *(const f32x4*)(bd + (size_t)u.e * D_ + col0 + bj * 128 + 4 * n);
#pragma unroll
        for (int ai = 0; ai < 2; ++ai)
#pragma unroll
            for (int m = 0; m < 4; ++m) {
                const int slot = rowtab[ui * 256 + ai * 128 + wr * 64 + m * 16 + fr];
                if (slot >= 0) {
#pragma unroll
                    for (int bj = 0; bj < 2; ++bj) { const f32x4 v0 = acc[ai][bj][m][0] + bv[bj][0], v1 = acc[ai][bj][m][1] + bv[bj][1];
                        u32x4 w; w.x = pg8::cvt_pk_bf16(v0[0], v0[1]); w.y = pg8::cvt_pk_bf16(v0[2], v0[3]); w.z = pg8::cvt_pk_bf16(v1[0], v1[1]); w.w = pg8::cvt_pk_bf16(v1[2], v1[3]);
                        *(u32x4*)(Y + (size_t)slot * D_ + col0 + bj * 128) = w; }
                }
            }
    }
};


#define XB_TMO      128
#define XB_XCNT(j)  (256  + 64 * (j))
#define XB_XSUB(j)  (1280 + 64 * (j))
#define XB_XGEN(j)  (2304 + 64 * (j))
#define XB_TOP      3328
#define XB_TOPGEN   3392
#define XCD_BAR_WORDS 3456
#define XB_SPIN_CAP (1u << 18)
__device__ __forceinline__ unsigned xb_ld(unsigned* p)              { return __hip_atomic_load(p, __ATOMIC_RELAXED, __HIP_MEMORY_SCOPE_AGENT); }
__device__ __forceinline__ unsigned xb_add(unsigned* p, unsigned v) { return __hip_atomic_fetch_add(p, v, __ATOMIC_RELAXED, __HIP_MEMORY_SCOPE_AGENT); }
__device__ __forceinline__ unsigned xb_xcc_id() { return (unsigned)__builtin_amdgcn_s_getreg((3 << 11) | 20) & 0xFu; }
#define XB_SPIN(cond, bar) do { unsigned _sp = 0; while (cond) { __builtin_amdgcn_s_sleep(1); \
    if ((++_sp & 255u) == 0u) { if (xb_ld(&(bar)[XB_TMO])) break; if (_sp > XB_SPIN_CAP) { atomicAdd(&(bar)[XB_TMO], 1u); break; } } } } while (0)
struct XcdBarrier { unsigned* bar; unsigned x; volatile LAS unsigned* st; };
__device__ __forceinline__ XcdBarrier xcd_barrier_post(unsigned* bar, volatile LAS unsigned* st) {
    XcdBarrier b; b.bar = bar; b.x = xb_xcc_id(); b.st = st;
    if (threadIdx.x == 0) (void)xb_add(&bar[XB_XCNT(b.x)], 1u);
    return b;
}
__device__ __forceinline__ void xcd_barrier_complete(unsigned* bar, unsigned x, unsigned& nloc, unsigned& nx) {
    const unsigned G = gridDim.x * gridDim.y * gridDim.z;
    unsigned sum, cnt, mine, sp = 0u;
    for (;;) {
        sum = 0u; cnt = 0u; mine = 0u;
#pragma unroll
        for (unsigned j = 0; j < 16; ++j) { const unsigned c = xb_ld(&bar[XB_XCNT(j)]); sum += c; cnt += (c > 0u) ? 1u : 0u; mine = (j == x) ? c : mine; }
        if (sum == G) break;
        __builtin_amdgcn_s_sleep(1);
        if ((++sp & 255u) == 0u) { if (xb_ld(&bar[XB_TMO])) break; if (sp > XB_SPIN_CAP) { atomicAdd(&bar[XB_TMO], 1u); break; } }
    }
    nloc = mine > 0u ? mine : 1u; nx = cnt > 0u ? cnt : 1u;
}
__device__ __forceinline__ void xcd_barrier(const XcdBarrier& b) {
    asm volatile("s_waitcnt vmcnt(0)" ::: "memory");
    __syncthreads();
    if (threadIdx.x == 0) {
        unsigned* bar = b.bar;
        __builtin_amdgcn_s_waitcnt(0);
        unsigned nloc = b.st[0], nx = b.st[1];
        if (nloc == 0u) { xcd_barrier_complete(bar, b.x, nloc, nx); b.st[0] = nloc; b.st[1] = nx; }
        const unsigned old = xb_add(&bar[XB_XSUB(b.x)], 1u);
        const unsigned gen = old / nloc;
        if (old + 1u == (gen + 1u) * nloc) {
            __builtin_amdgcn_fence(__ATOMIC_RELEASE, "agent");
            asm volatile("s_waitcnt vmcnt(0)" ::: "memory");
            const unsigned og = xb_add(&bar[XB_TOP], 1u);
            const unsigned tg = og / nx;
            if (og + 1u == (tg + 1u) * nx) xb_add(&bar[XB_TOPGEN], 1u);
            else XB_SPIN(xb_ld(&bar[XB_TOPGEN]) == tg, bar);
            __builtin_amdgcn_fence(__ATOMIC_ACQUIRE, "agent");
            xb_add(&bar[XB_XGEN(b.x)], 1u);
            asm volatile("s_waitcnt vmcnt(0)" ::: "memory");
        } else {
            XB_SPIN(xb_ld(&bar[XB_XGEN(b.x)]) == gen, bar);
            __builtin_amdgcn_fence(__ATOMIC_ACQUIRE, "agent");
            asm volatile("s_waitcnt vmcnt(0)" ::: "memory");
        }
    }
    __syncthreads();
}

constexpr int TS = 136;
__device__ __forceinline__ void unpack8(const u32x4 w, float (&o)[16], int base) {
#pragma unroll
    for (int m = 0; m < 4; ++m) { o[base + 2 * m] = bf2f(w[m] & 0xffffu); o[base + 2 * m + 1] = bf2f(w[m] >> 16); }
}
__device__ __forceinline__ void load_krot(const bf16_t* PROJ, const float* rope, int t, int pos, int h, int q, float (&o1)[16], float (&o2)[16]) {
    const bf16_t* kp = PROJ + (size_t)t * INC + 1024 + h * 128 + 16 * q;
    float k1[16], k2[16];
    unpack8(*(const u32x4*)kp, k1, 0); unpack8(*(const u32x4*)(kp + 8), k1, 8); unpack8(*(const u32x4*)(kp + 64), k2, 0); unpack8(*(const u32x4*)(kp + 72), k2, 8);
    const float* cp = rope + pos * 64 + 16 * q; const float* sp = cp + SEQ * 64;
    const float sc = 0.08838834764831845f;
#pragma unroll
    for (int i4 = 0; i4 < 4; ++i4) {
        const f32x4 c = *(const f32x4*)(cp + 4 * i4), s = *(const f32x4*)(sp + 4 * i4);
#pragma unroll
        for (int r = 0; r < 4; ++r) { const int i = 4 * i4 + r; o1[i] = (k1[i] * c[r] - k2[i] * s[r]) * sc; o2[i] = (k2[i] * c[r] + k1[i] * s[r]) * sc; }
    }
}
__device__ __forceinline__ void load_v32(const bf16_t* PROJ, int t, int h, int q, unsigned short (&v)[32]) {
    const bf16_t* vp = PROJ + (size_t)t * INC + 1536 + h * 128 + 32 * q;
#pragma unroll
    for (int c = 0; c < 4; ++c) { const u32x4 w = *(const u32x4*)(vp + 8 * c);
#pragma unroll
        for (int m = 0; m < 4; ++m) { v[8 * c + 2 * m] = (unsigned short)(w[m] & 0xffffu); v[8 * c + 2 * m + 1] = (unsigned short)(w[m] >> 16); } }
}

template <int W>
__device__ __forceinline__ void pool_fill(const bf16_t* PROJ, LAS bf16_t* P, int t0, int pos0, int g, int tid) {
    const int cp = tid & 63, seg = tid >> 6;
    const int tb = t0 + 16 * seg, pb = pos0 + 16 * seg;
    float v0[15 + W], v1[15 + W];
#pragma unroll
    for (int idx = 0; idx < 15 + W; ++idx) {
        const int dp = idx - (W - 1);
        unsigned u = 0u;
        if (pb + dp >= 0) u = *(const unsigned*)(PROJ + (size_t)(tb + dp) * INC + g * 128 + 2 * cp);
        v0[idx] = bf2f(u & 0xffffu); v1[idx] = bf2f(u >> 16);
    }
#pragma unroll
    for (int k = 0; k < 16; ++k) {
        float s0 = 0.f, s1 = 0.f;
#pragma unroll
        for (int q = 0; q < W; ++q) { s0 += v0[k + q]; s1 += v1[k + q]; }
        const int pos = pb + k; const float inv = 1.f / (float)((pos + 1 < W) ? pos + 1 : W);
        *(LAS unsigned*)(P + (16 * seg + k) * TS + 2 * cp) = pk2(s0 * inv - v0[k + W - 1], s1 * inv - v1[k + W - 1]);
    }
}
__device__ __forceinline__ void pool_unit(const Args& a, LAS unsigned char* lds, int u) {
    const int tid = threadIdx.x, lane = tid & 63, wave = __builtin_amdgcn_readfirstlane(tid >> 6), fr = lane & 15, fq = lane >> 4;
    const int chunk = u >> 2, g = u & 3, t0 = chunk * 128, pos0 = t0 % SEQ;
    const bf16_t* PROJ = (const bf16_t*)(a.ws + WS_PROJ); const bf16_t* PWT = (const bf16_t*)(a.ws + WS_POOLWT); bf16_t* MIXIN = (bf16_t*)(a.ws + WS_MIXIN);
    LAS bf16_t* P = (LAS bf16_t*)lds;
    if (g == 0) pool_fill<2>(PROJ, P, t0, pos0, g, tid); else if (g == 1) pool_fill<4>(PROJ, P, t0, pos0, g, tid); else if (g == 2) pool_fill<8>(PROJ, P, t0, pos0, g, tid); else pool_fill<16>(PROJ, P, t0, pos0, g, tid);
    __syncthreads();
    f32x4 acc[8];
#pragma unroll
    for (int nt = 0; nt < 8; ++nt) acc[nt] = (f32x4){0.f, 0.f, 0.f, 0.f};
#pragma unroll
    for (int ks = 0; ks < 4; ++ks) {
        const bf16x8 af = *(const LAS bf16x8*)(P + (16 * wave + fr) * TS + 32 * ks + 8 * fq);
#pragma unroll
        for (int nt = 0; nt < 8; ++nt) { const bf16x8 bf = *(const bf16x8*)(PWT + (size_t)(g * 128 + 16 * nt + fr) * 128 + 32 * ks + 8 * fq); acc[nt] = MFMA16(bf, af, acc[nt]); }
    }
    const int t = t0 + 16 * wave + fr;
#pragma unroll
    for (int nt = 0; nt < 8; ++nt) {
        const int ch = g * 128 + 16 * nt + 4 * fq;
        const f32x4 pb = *(const f32x4*)(a.in[7] + ch), ps = *(const f32x4*)(a.in[8] + ch);
        const f32x4 o = (acc[nt] + pb) * ps;
        u32x2 w; w.x = pk2(o[0], o[1]); w.y = pk2(o[2], o[3]);
        *(u32x2*)(MIXIN + (size_t)t * D_ + ch) = w;
    }
    __syncthreads();
}
__device__ __forceinline__ void kv_unit(const Args& a, LAS unsigned char* lds, int u) {
    const int tid = threadIdx.x, lane = tid & 63, wave = __builtin_amdgcn_readfirstlane(tid >> 6), fr = lane & 15, fq = lane >> 4;
    const int bh = u / 15, n = u % 15, b = bh >> 2, h = bh & 3, t0 = b * SEQ + n * 128, pos0 = n * 128;
    const bf16_t* PROJ = (const bf16_t*)(a.ws + WS_PROJ); const float* rope = (const float*)(a.ws + WS_ROPE); float* KVT = (float*)(a.ws + WS_KVT);
    LAS bf16_t* Kt = (LAS bf16_t*)lds; LAS bf16_t* Vt = Kt + 128 * TS;
    const float l2g = log2_gamma(h);
    {
        const int j = tid >> 2, q = tid & 3;
        float o1[16], o2[16]; load_krot(PROJ, rope, t0 + j, pos0 + j, h, q, o1, o2);
        const float kd = exp2f((float)(127 - j) * l2g);
#pragma unroll
        for (int i = 0; i < 16; ++i) { Kt[(16 * q + i) * TS + j] = (bf16_t)f2bf(o1[i] * kd); Kt[(64 + 16 * q + i) * TS + j] = (bf16_t)f2bf(o2[i] * kd); }
        unsigned short v[32]; load_v32(PROJ, t0 + j, h, q, v);
#pragma unroll
        for (int i = 0; i < 32; ++i) Vt[(32 * q + i) * TS + j] = v[i];
    }
    __syncthreads();
    f32x4 acc[8];
#pragma unroll
    for (int dt = 0; dt < 8; ++dt) acc[dt] = (f32x4){0.f, 0.f, 0.f, 0.f};
#pragma unroll
    for (int ks = 0; ks < 4; ++ks) {
        const bf16x8 vf = *(const LAS bf16x8*)(Vt + (16 * wave + fr) * TS + 32 * ks + 8 * fq);
#pragma unroll
        for (int dt = 0; dt < 8; ++dt) { const bf16x8 kf = *(const LAS bf16x8*)(Kt + (16 * dt + fr) * TS + 32 * ks + 8 * fq); acc[dt] = MFMA16(kf, vf, acc[dt]); }
    }
    float* op = KVT + ((size_t)(bh * 15 + n) << 14) + (size_t)(16 * wave + fr) * 128 + 4 * fq;
#pragma unroll
    for (int dt = 0; dt < 8; ++dt) *(f32x4*)(op + 16 * dt) = acc[dt];
    __syncthreads();
}
__device__ __forceinline__ void phase_scan(const Args& a, int vb, int G) {
    const float* KVT = (const float*)(a.ws + WS_KVT); bf16_t* RT = (bf16_t*)(a.ws + WS_RT);
    for (int i = vb * 512 + threadIdx.x; i < 32 * 4096; i += G * 512) {
        const int bh = i >> 12, ed = (i & 4095) * 4, h = bh & 3;
        const float cd = exp2f(128.f * log2_gamma(h)); f32x4 R = (f32x4){0.f, 0.f, 0.f, 0.f};
        f32x4 kv[15];
#pragma unroll
        for (int n = 0; n < 15; ++n) kv[n] = *(const f32x4*)(KVT + ((size_t)(bh * 15 + n) << 14) + ed);
#pragma unroll
        for (int n = 0; n < 16; ++n) {
            u32x2 w; w.x = pk2(R[0], R[1]); w.y = pk2(R[2], R[3]);
            *(u32x2*)(RT + ((size_t)(bh * 16 + n) << 14) + ed) = w;
            if (n < 15) R = R * cd + kv[n];
        }
    }
}
__device__ __forceinline__ bf16x8 pack8(const float (&v)[8]) {
    u32x4 w; w.x = pk2(v[0], v[1]); w.y = pk2(v[2], v[3]); w.z = pk2(v[4], v[5]); w.w = pk2(v[6], v[7]);
    return __builtin_bit_cast(bf16x8, w);
}
__device__ __forceinline__ void ret_unit(const Args& a, LAS unsigned char* lds, int u) {
    const int tid = threadIdx.x, lane = tid & 63, wave = __builtin_amdgcn_readfirstlane(tid >> 6), fr = lane & 15, fq = lane >> 4;
    const int bh = u >> 4, n = u & 15, b = bh >> 2, h = bh & 3, t0 = b * SEQ + n * 128, pos0 = n * 128;
    const bf16_t* PROJ = (const bf16_t*)(a.ws + WS_PROJ); const float* rope = (const float*)(a.ws + WS_ROPE); const bf16_t* RT = (const bf16_t*)(a.ws + WS_RT); bf16_t* MIXIN = (bf16_t*)(a.ws + WS_MIXIN);
    LAS bf16_t* Kn = (LAS bf16_t*)lds; LAS bf16_t* Vt = Kn + 128 * TS;
    const float l2g = log2_gamma(h);
    {
        const int j = tid >> 2, q = tid & 3;
        float o1[16], o2[16]; load_krot(PROJ, rope, t0 + j, pos0 + j, h, q, o1, o2);
        u32x4 w;
        w.x = pk2(o1[0], o1[1]); w.y = pk2(o1[2], o1[3]); w.z = pk2(o1[4], o1[5]); w.w = pk2(o1[6], o1[7]); *(LAS u32x4*)(Kn + j * TS + 16 * q) = w;
        w.x = pk2(o1[8], o1[9]); w.y = pk2(o1[10], o1[11]); w.z = pk2(o1[12], o1[13]); w.w = pk2(o1[14], o1[15]); *(LAS u32x4*)(Kn + j * TS + 16 * q + 8) = w;
        w.x = pk2(o2[0], o2[1]); w.y = pk2(o2[2], o2[3]); w.z = pk2(o2[4], o2[5]); w.w = pk2(o2[6], o2[7]); *(LAS u32x4*)(Kn + j * TS + 64 + 16 * q) = w;
        w.x = pk2(o2[8], o2[9]); w.y = pk2(o2[10], o2[11]); w.z = pk2(o2[12], o2[13]); w.w = pk2(o2[14], o2[15]); *(LAS u32x4*)(Kn + j * TS + 64 + 16 * q + 8) = w;
        unsigned short v[32]; load_v32(PROJ, t0 + j, h, q, v);
#pragma unroll
        for (int i = 0; i < 32; ++i) Vt[(32 * q + i) * TS + j] = v[i];
    }
    __syncthreads();
    const int il = 16 * wave + fr, t = t0 + il, pos = pos0 + il;
    bf16x8 qf[4];
    {
        const bf16_t* qp = PROJ + (size_t)t * INC + 512 + h * 128 + 8 * fq;
        float qa[16], qb[16];
        unpack8(*(const u32x4*)(qp), qa, 0); unpack8(*(const u32x4*)(qp + 32), qa, 8); unpack8(*(const u32x4*)(qp + 64), qb, 0); unpack8(*(const u32x4*)(qp + 96), qb, 8);
#pragma unroll
        for (int ks = 0; ks < 2; ++ks) {
            const float* cp = rope + pos * 64 + 32 * ks + 8 * fq; const float* sp = cp + SEQ * 64;
            float y1[8], y2[8];
#pragma unroll
            for (int i4 = 0; i4 < 2; ++i4) { const f32x4 c = *(const f32x4*)(cp + 4 * i4), s = *(const f32x4*)(sp + 4 * i4);
#pragma unroll
                for (int r = 0; r < 4; ++r) { const int i = 4 * i4 + r; const float x1 = qa[8 * ks + i], x2 = qb[8 * ks + i]; y1[i] = x1 * c[r] - x2 * s[r]; y2[i] = x2 * c[r] + x1 * s[r]; } }
            qf[ks] = pack8(y1); qf[ks + 2] = pack8(y2);
        }
    }
    f32x4 acc[8];
#pragma unroll
    for (int et = 0; et < 8; ++et) acc[et] = (f32x4){0.f, 0.f, 0.f, 0.f};
    if (n > 0) {
        const bf16_t* rp = RT + ((size_t)(bh * 16 + n) << 14) + fr * 128 + 8 * fq;
#pragma unroll
        for (int ks = 0; ks < 4; ++ks)
#pragma unroll
            for (int et = 0; et < 8; ++et) acc[et] = MFMA16(*(const bf16x8*)(rp + et * 16 * 128 + 32 * ks), qf[ks], acc[et]);
        const float qd = exp2f((float)(il + 1) * l2g);
#pragma unroll
        for (int et = 0; et < 8; ++et) acc[et] *= qd;
    }
#pragma unroll
    for (int ks2 = 0; ks2 < 4; ++ks2) {
        if (2 * ks2 <= wave) {
            float sv[8];
#pragma unroll
            for (int tt = 0; tt < 2; ++tt) {
                const int jt = 2 * ks2 + tt;
                f32x4 sacc = (f32x4){0.f, 0.f, 0.f, 0.f};
                if (jt <= wave) {
#pragma unroll
                    for (int ks = 0; ks < 4; ++ks) sacc = MFMA16(*(const LAS bf16x8*)(Kn + (16 * jt + fr) * TS + 32 * ks + 8 * fq), qf[ks], sacc);
                }
#pragma unroll
                for (int r = 0; r < 4; ++r) { const int diff = il - (16 * jt + 4 * fq + r); sv[4 * tt + r] = (diff >= 0) ? sacc[r] * exp2f((float)diff * l2g) : 0.f; }
            }
            const bf16x8 sf = pack8(sv);
#pragma unroll
            for (int et = 0; et < 8; ++et) {
                const LAS bf16_t* vp = Vt + (16 * et + fr) * TS + 32 * ks2 + 4 * fq;
                const u32x2 lo = *(const LAS u32x2*)vp, hi = *(const LAS u32x2*)(vp + 16);
                u32x4 vw; vw.x = lo.x; vw.y = lo.y; vw.z = hi.x; vw.w = hi.y;
                acc[et] = MFMA16(__builtin_bit_cast(bf16x8, vw), sf, acc[et]);
            }
        }
    }
    float sm = 0.f;
#pragma unroll
    for (int et = 0; et < 8; ++et) sm += (acc[et][0] + acc[et][1]) + (acc[et][2] + acc[et][3]);
    sm += __shfl_xor(sm, 16); sm += __shfl_xor(sm, 32);
    const float mu = sm * (1.f / 128.f);
    float sq = 0.f;
#pragma unroll
    for (int et = 0; et < 8; ++et) { const f32x4 d = acc[et] - mu; sq += (d[0] * d[0] + d[1] * d[1]) + (d[2] * d[2] + d[3] * d[3]); }
    sq += __shfl_xor(sq, 16); sq += __shfl_xor(sq, 32);
    const float rs = 1.f / sqrtf(sq * (1.f / 128.f) + EPS);
#pragma unroll
    for (int et = 0; et < 8; ++et) {
        const int c = h * 128 + 16 * et + 4 * fq;
        const u32x2 gw = *(const u32x2*)(PROJ + (size_t)t * INC + 2048 + c);
        const f32x4 gn = *(const f32x4*)(a.in[9] + c);
        const float g0 = bf2f(gw.x & 0xffffu), g1 = bf2f(gw.x >> 16), g2 = bf2f(gw.y & 0xffffu), g3 = bf2f(gw.y >> 16);
        const f32x4 d = (acc[et] - mu) * rs * gn;
        u32x2 w; w.x = pk2(silu_f(g0) * d[0], silu_f(g1) * d[1]); w.y = pk2(silu_f(g2) * d[2], silu_f(g3) * d[3]);
        *(u32x2*)(MIXIN + (size_t)t * D_ + 512 + c) = w;
    }
    __syncthreads();
}

constexpr int HST = 1026;
constexpr int R_H = 0, R_PART = 65792, R_LOGIT = R_PART + 16384, R_PE = R_LOGIT + 2048, R_PW = R_PE + 1024, R_PL = R_PW + 1024, R_HIST = R_PL + 1024, R_BASE = R_HIST + 128;
static_assert(16 * HST * 4 <= R_PART && R_BASE + 128 <= RING_BYTES, "router LDS map");
__device__ __forceinline__ void phase_router(const Args& a, LAS unsigned char* lds, int vb, int G) {
    const int tid = threadIdx.x, lane = tid & 63, wave = __builtin_amdgcn_readfirstlane(tid >> 6), fr = lane & 15, fq = lane >> 4;
    unsigned char* ws = a.ws;
    const float* X1 = (const float*)(ws + WS_X1); const float* mod = (const float*)(ws + WS_MOD); bf16_t* HN = (bf16_t*)(ws + WS_HN);
    LAS float* H = (LAS float*)(lds + R_H); LAS float* part = (LAS float*)(lds + R_PART); LAS float* logit = (LAS float*)(lds + R_LOGIT);
    LAS int* pe = (LAS int*)(lds + R_PE); LAS float* pw = (LAS float*)(lds + R_PW); LAS int* pl = (LAS int*)(lds + R_PL); LAS int* hist = (LAS int*)(lds + R_HIST); LAS int* base = (LAS int*)(lds + R_BASE);
    const int RPB = T_ / G, row0 = vb * RPB, b = row0 / SEQ;
    float wreg[32][2];
#pragma unroll
    for (int kk = 0; kk < 32; ++kk)
#pragma unroll
        for (int nt = 0; nt < 2; ++nt) wreg[kk][nt] = a.in[12][(size_t)(128 * wave + 4 * kk + fq) * NE + 16 * nt + fr];
    if (tid < NE) hist[tid] = 0;
    const float* sh = mod + b * NMOD + 3 * D_; const float* sc = mod + b * NMOD + 4 * D_;
    for (int sub = 0; sub < RPB / 16; ++sub) {
#pragma unroll
        for (int rr = 0; rr < 2; ++rr) {
            const int lr = 2 * wave + rr, r = row0 + sub * 16 + lr;
            const f32x4* xr = (const f32x4*)(X1 + (size_t)r * D_) + lane;
            f32x4 v[4]; float ss = 0.f;
#pragma unroll
            for (int j = 0; j < 4; ++j) { v[j] = xr[64 * j]; ss += (v[j].x * v[j].x + v[j].y * v[j].y) + (v[j].z * v[j].z + v[j].w * v[j].w); }
            const float rs = 1.f / sqrtf(wave_sum(ss) * (1.f / D_) + EPS);
#pragma unroll
            for (int j = 0; j < 4; ++j) {
                const int c0 = 4 * lane + 256 * j;
                const f32x4 g = *(const f32x4*)(a.in[11] + c0), s1 = *(const f32x4*)(sc + c0), s0 = *(const f32x4*)(sh + c0);
                const f32x4 hv = v[j] * rs * g * (1.f + s1) + s0;
                *(unsigned long long*)(HN + (size_t)r * D_ + c0) = (unsigned long long)pk2(hv[0], hv[1]) | ((unsigned long long)pk2(hv[2], hv[3]) << 32);
                LAS float* hp = H + lr * HST + c0; hp[0] = hv[0]; hp[1] = hv[1]; hp[2] = hv[2]; hp[3] = hv[3];
            }
        }
        __syncthreads();
        f32x4 lacc[2] = {(f32x4){0.f, 0.f, 0.f, 0.f}, (f32x4){0.f, 0.f, 0.f, 0.f}};
#pragma unroll
        for (int kk = 0; kk < 32; ++kk) {
            const float av = H[fr * HST + 128 * wave + 4 * kk + fq];
            lacc[0] = __builtin_amdgcn_mfma_f32_16x16x4f32(av, wreg[kk][0], lacc[0], 0, 0, 0);
            lacc[1] = __builtin_amdgcn_mfma_f32_16x16x4f32(av, wreg[kk][1], lacc[1], 0, 0, 0);
        }
#pragma unroll
        for (int nt = 0; nt < 2; ++nt)
#pragma unroll
            for (int r = 0; r < 4; ++r) part[(wave * 16 + 4 * fq + r) * 32 + 16 * nt + fr] = lacc[nt][r];
        __syncthreads();
        {
            const int tk = tid >> 5, e = tid & 31; float s = a.in[13][e];
#pragma unroll
            for (int w = 0; w < 8; ++w) s += part[(w * 16 + tk) * 32 + e];
            logit[tk * 32 + e] = s;
        }
        __syncthreads();
        if (tid < 16) {
            float v[NE];
#pragma unroll
            for (int e = 0; e < NE; ++e) v[e] = logit[tid * 32 + e];
            float tv[4]; int ti[4];
#pragma unroll
            for (int k = 0; k < 4; ++k) {
                float best = -INFINITY; int bi = 0;
#pragma unroll
                for (int e = 0; e < NE; ++e) if (v[e] > best) { best = v[e]; bi = e; }
                tv[k] = best; ti[k] = bi;
#pragma unroll
                for (int e = 0; e < NE; ++e) if (e == bi) v[e] = -INFINITY;
            }
            float ex[4], se = 0.f;
#pragma unroll
            for (int k = 0; k < 4; ++k) { ex[k] = __expf(tv[k] - tv[0]); se += ex[k]; }
            const float inv = 1.f / se;
#pragma unroll
            for (int k = 0; k < 4; ++k) { const int pi = (sub * 16 + tid) * 4 + k; pe[pi] = ti[k]; pw[pi] = ex[k] * inv; }
        }
        __syncthreads();
    }
    const int npair = RPB * 4;
    if (tid < npair) pl[tid] = atomicAdd((int*)(hist + pe[tid]), 1);
    __syncthreads();
    if (tid < NE) base[tid] = (int)__hip_atomic_fetch_add((int*)(ws + WS_CTL) + CW_CNT + tid, hist[tid], __ATOMIC_RELAXED, __HIP_MEMORY_SCOPE_AGENT);
    __syncthreads();
    if (tid < npair) {
        const int e = pe[tid], slot = row0 * 4 + tid;
        ((int*)(ws + WS_TOKSLOT))[e * CAP + base[e] + pl[tid]] = slot;
        ((float*)(ws + WS_WSLOT))[slot] = pw[tid];
    }
    __syncthreads();
}
__device__ __forceinline__ void phase_final(const Args& a, int vb, int G) {
    const int tid = threadIdx.x, lane = tid & 63, wave = tid >> 6;
    const float* X1 = (const float*)(a.ws + WS_X1); const bf16_t* Y = (const bf16_t*)(a.ws + WS_Y); const float* wslot = (const float*)(a.ws + WS_WSLOT); const float* mod = (const float*)(a.ws + WS_MOD);
    for (int r = vb * NWAVES + wave; r < T_; r += G * NWAVES) {
        const int b = r / SEQ; const float* gt2 = mod + b * NMOD + 5 * D_;
        float w[4];
#pragma unroll
        for (int k = 0; k < 4; ++k) w[k] = wslot[r * 4 + k];
        f32x4 v[4]; float ss = 0.f;
#pragma unroll
        for (int j = 0; j < 4; ++j) {
            const int c0 = 4 * lane + 256 * j;
            f32x4 f = (f32x4){0.f, 0.f, 0.f, 0.f};
#pragma unroll
            for (int k = 0; k < 4; ++k) {
                const u32x2 y = *(const u32x2*)(Y + (size_t)(r * 4 + k) * D_ + c0);
                f.x += w[k] * bf2f(y.x & 0xffffu); f.y += w[k] * bf2f(y.x >> 16); f.z += w[k] * bf2f(y.y & 0xffffu); f.w += w[k] * bf2f(y.y >> 16);
            }
            const f32x4 x1 = *(const f32x4*)(X1 + (size_t)r * D_ + c0); const f32x4 g = *(const f32x4*)(gt2 + c0);
            v[j] = x1 + g * f;
            ss += (v[j].x * v[j].x + v[j].y * v[j].y) + (v[j].z * v[j].z + v[j].w * v[j].w);
        }
        const float rs = 1.f / sqrtf(wave_sum(ss) * (1.f / D_) + EPS);
#pragma unroll
        for (int j = 0; j < 4; ++j) { const int c0 = 4 * lane + 256 * j; const f32x4 g = *(const f32x4*)(a.in[18] + c0); *(f32x4*)(a.out + (size_t)r * D_ + c0) = v[j] * rs * g; }
    }
}

__global__ void __launch_bounds__(512, 2) mega(Args a) {
    extern __shared__ __attribute__((aligned(16))) unsigned char lds_raw[];
    LAS unsigned char* lds = (LAS unsigned char*)lds_raw;
    const int G = gridDim.x, bx = blockIdx.x;
    const int vb = (G % 8 == 0) ? (bx % 8) * (G / 8) + bx / 8 : bx;
    unsigned char* ws = a.ws;
    for (int u = threadIdx.x; u < (LDS_BYTES - LDSCTL_OFF) / 4; u += 512) ((LAS unsigned*)(lds + LDSCTL_OFF))[u] = 0u;
    __syncthreads();
    const bool multi = (a.ph_hi - a.ph_lo) > 1;
    XcdBarrier bar; bar.bar = (unsigned*)(ws + WS_CTL) + CW_BAR; bar.x = 0; bar.st = nullptr;
    if (multi) bar = xcd_barrier_post((unsigned*)(ws + WS_CTL) + CW_BAR, (volatile LAS unsigned*)(lds + L_MISC) + 8);
#define SEAM(k) do { if (IN(k) && IN((k) + 1)) xcd_barrier(bar); } while (0)
#define IN(k) (a.ph_lo <= (k) && (k) < a.ph_hi)
    if (IN(0)) phase_p0(a, lds, vb, G);
    SEAM(0);
    if (IN(1)) phase_p1(a, lds, vb, G);
    SEAM(1);
    if (IN(2)) {
        pg8::Gemm g{(const bf16_t*)(ws + WS_XN), (const bf16_t*)(ws + WS_WINT), INC, D_, 0};
        pg8::DenseOrder S; S.init(T_ / 256, INC / 256, G, bx);
        pg8::EpiProj E{(bf16_t*)(ws + WS_PROJ)};
        pg8::gemm_phase<pg8::EpiProj, pg8::DenseOrder, true>(lds, g, S, E);
    }
    SEAM(2);
    if (IN(3)) { for (int L = vb; L < 512 + 480; L += G) { if (L < 512) pool_unit(a, lds, L); else kv_unit(a, lds, L - 512); } }
    SEAM(3);
    if (IN(4)) phase_scan(a, vb, G);
    SEAM(4);
    if (IN(5)) { for (int L = vb; L < 512; L += G) ret_unit(a, lds, L); }
    SEAM(5);
    if (IN(6)) {
        pg8::Gemm g{(const bf16_t*)(ws + WS_MIXIN), (const bf16_t*)(ws + WS_WOUTT), D_, D_, 0};
        pg8::DenseOrder S; S.init(T_ / 256, D_ / 256, G, bx);
        pg8::EpiX1 E{a.in[0], (const float*)(ws + WS_MOD), (float*)(ws + WS_X1)};
        pg8::gemm_phase<pg8::EpiX1, pg8::DenseOrder, true>(lds, g, S, E);
    }
    SEAM(6);
    if (IN(7)) phase_router(a, lds, vb, G);
    SEAM(7);
    if (IN(8)) {
        GroupedOrder S; grouped_prepare(S, lds, ws, 2 * FF / 256, G, bx, 0);
        pg8::Gemm g{(const bf16_t*)(ws + WS_HN), (const bf16_t*)(ws + WS_WGUT), 2 * FF, D_, (size_t)2 * FF * D_ * 2};
        EpiGateUp E{(bf16_t*)(ws + WS_ACT), a.in[15], (LAS const int*)(lds + L_PSTART)};
        pg8::gemm_phase<EpiGateUp, GroupedOrder, true>(lds, g, S, E);
    }
    SEAM(8);
    if (IN(9)) {
        GroupedOrder S; grouped_prepare(S, lds, ws, D_ / 256, G, bx, 1);
        pg8::Gemm g{(const bf16_t*)(ws + WS_ACT), (const bf16_t*)(ws + WS_WDT), D_, FF, (size_t)D_ * FF * 2};
        EpiDown E{(bf16_t*)(ws + WS_Y), a.in[17], (LAS const int*)(lds + L_ROWTAB)};
        pg8::gemm_phase<EpiDown, GroupedOrder, true>(lds, g, S, E);
    }
    SEAM(9);
    if (IN(10)) phase_final(a, vb, G);
#undef SEAM
#undef IN
}


template <class Epi>
__global__ void __launch_bounds__(256) k_sgemm(const bf16_t* A, const bf16_t* Bt, Epi epi) {
    const int K = epi.K;
    const int wave = threadIdx.x >> 6, lane = threadIdx.x & 63, fr = lane & 15, fq = lane >> 4;
    const int row0 = blockIdx.y * 64 + wave * 16, col0 = blockIdx.x * 64;
    f32x4 acc[4];
#pragma unroll
    for (int n = 0; n < 4; ++n) acc[n] = (f32x4){0.f, 0.f, 0.f, 0.f};
    const bf16_t* ap = A + (size_t)(row0 + fr) * K + fq * 8;
    const bf16_t* bp = Bt + (size_t)(col0 + fr) * K + fq * 8;
    for (int k0 = 0; k0 < K; k0 += 32) {
        const bf16x8 av = *(const bf16x8*)(ap + k0);
#pragma unroll
        for (int n = 0; n < 4; ++n) { const bf16x8 bv = *(const bf16x8*)(bp + (size_t)n * 16 * K + k0); acc[n] = MFMA16(bv, av, acc[n]); }
    }
#pragma unroll
    for (int n = 0; n < 4; ++n)
#pragma unroll
        for (int j = 0; j < 4; ++j) epi(row0 + fr, col0 + n * 16 + 4 * fq + j, acc[n][j]);
}
struct EpiStoreBf16 { bf16_t* O; int ldc; int K; __device__ void operator()(int r, int c, float v) const { O[(size_t)r * ldc + c] = (bf16_t)f2bf(v); } };
struct EpiOutProj { const float* x; const float* mod; float* X1; int K; int pad; __device__ void operator()(int r, int c, float v) const { const int b = r / SEQ; X1[(size_t)r * D_ + c] = x[(size_t)r * D_ + c] + mod[b * NMOD + 2 * D_ + c] * v; } };

__global__ void k_pool_p(const bf16_t* PROJ, bf16_t* PP) {
    const int i = blockIdx.x * blockDim.x + threadIdx.x; if (i >= T_ * 512) return;
    const int t = i >> 9, ch = i & 511, g = ch >> 7, w = 2 << g, pos = t % SEQ;
    float s = 0.f;
    for (int q = 0; q < w; ++q) if (pos - q >= 0) s += bf2f(PROJ[(size_t)(t - q) * INC + ch]);
    const float cnt = (float)((pos + 1 < w) ? pos + 1 : w);
    PP[i] = (bf16_t)f2bf(s / cnt - bf2f(PROJ[(size_t)t * INC + ch]));
}
__global__ void k_pool_mm(const bf16_t* PP, const bf16_t* PWT, const float* pool_b, const float* pool_scale, bf16_t* MIXIN) {
    const int i = blockIdx.x * blockDim.x + threadIdx.x; if (i >= T_ * 512) return;
    const int t = i >> 9, ch = i & 511, g = ch >> 7, d = ch & 127;
    float s = 0.f;
    for (int c = 0; c < 128; ++c) s += bf2f(PP[(size_t)t * 512 + g * 128 + c]) * bf2f(PWT[(g * 128 + d) * 128 + c]);
    MIXIN[(size_t)t * D_ + ch] = (bf16_t)f2bf((s + pool_b[ch]) * pool_scale[ch]);
}
__global__ void k_rot(const bf16_t* PROJ, const float* rope, bf16_t* QR, bf16_t* KR) {
    const int i = blockIdx.x * blockDim.x + threadIdx.x; if (i >= T_ * 256) return;
    const int t = i >> 8, h = (i >> 6) & 3, d = i & 63, pos = t % SEQ;
    const float c = rope[pos * 64 + d], s = rope[SEQ * 64 + pos * 64 + d];
    const bf16_t* p = PROJ + (size_t)t * INC;
    const float q1 = bf2f(p[512 + h * 128 + d]), q2 = bf2f(p[512 + h * 128 + 64 + d]);
    const float k1 = bf2f(p[1024 + h * 128 + d]), k2 = bf2f(p[1024 + h * 128 + 64 + d]);
    const float sc = 0.08838834764831845f;
    QR[(size_t)t * 512 + h * 128 + d] = (bf16_t)f2bf(q1 * c - q2 * s); QR[(size_t)t * 512 + h * 128 + 64 + d] = (bf16_t)f2bf(q2 * c + q1 * s);
    KR[(size_t)t * 512 + h * 128 + d] = (bf16_t)f2bf((k1 * c - k2 * s) * sc); KR[(size_t)t * 512 + h * 128 + 64 + d] = (bf16_t)f2bf((k2 * c + k1 * s) * sc);
}
__global__ void k_kv(const bf16_t* PROJ, const bf16_t* KR, float* KVT) {
    const int bh = blockIdx.x / 15, n = blockIdx.x % 15, b = bh >> 2, h = bh & 3, t0 = b * SEQ + n * 128;
    const float l2g = log2_gamma(h);
    for (int idx = threadIdx.x; idx < 16384; idx += blockDim.x) {
        const int e = idx >> 7, d = idx & 127; float s = 0.f;
        for (int j = 0; j < 128; ++j) s += exp2f((float)(127 - j) * l2g) * bf2f(KR[(size_t)(t0 + j) * 512 + h * 128 + d]) * bf2f(PROJ[(size_t)(t0 + j) * INC + 1536 + h * 128 + e]);
        KVT[((size_t)(bh * 15 + n) * 128 + e) * 128 + d] = s;
    }
}
__global__ void k_scan(const float* KVT, bf16_t* RT) {
    const int i = blockIdx.x * blockDim.x + threadIdx.x; if (i >= 32 * 16384) return;
    const int bh = i >> 14, ed = i & 16383, h = bh & 3;
    const float cd = exp2f(128.f * log2_gamma(h)); float R = 0.f;
    for (int n = 0; n < 16; ++n) { RT[((size_t)(bh * 16 + n) << 14) + ed] = (bf16_t)f2bf(R); if (n < 15) R = R * cd + KVT[((size_t)(bh * 15 + n) << 14) + ed]; }
}
__global__ void k_S(const bf16_t* QR, const bf16_t* KR, float* SG) {
    const int u = blockIdx.x, bh = u >> 4, n = u & 15, b = bh >> 2, h = bh & 3, t0 = b * SEQ + n * 128;
    const float l2g = log2_gamma(h);
    for (int idx = threadIdx.x; idx < 16384; idx += blockDim.x) {
        const int i = idx >> 7, j = idx & 127; float s = 0.f;
        if (i >= j) { for (int d = 0; d < 128; ++d) s += bf2f(QR[(size_t)(t0 + i) * 512 + h * 128 + d]) * bf2f(KR[(size_t)(t0 + j) * 512 + h * 128 + d]); s *= exp2f((float)(i - j) * l2g); }
        SG[((size_t)u << 14) + idx] = s;
    }
}
__global__ void k_o(const bf16_t* PROJ, const bf16_t* QR, const float* SG, const bf16_t* RT, float* OG) {
    const int u = blockIdx.x, bh = u >> 4, n = u & 15, b = bh >> 2, h = bh & 3, t0 = b * SEQ + n * 128;
    const float l2g = log2_gamma(h);
    for (int idx = threadIdx.x; idx < 16384; idx += blockDim.x) {
        const int i = idx >> 7, e = idx & 127; float s = 0.f, r = 0.f;
        for (int j = 0; j <= i; ++j) s += SG[((size_t)u << 14) + i * 128 + j] * bf2f(PROJ[(size_t)(t0 + j) * INC + 1536 + h * 128 + e]);
        for (int d = 0; d < 128; ++d) r += bf2f(QR[(size_t)(t0 + i) * 512 + h * 128 + d]) * bf2f(RT[((size_t)(bh * 16 + n) << 14) + e * 128 + d]);
        OG[(size_t)(t0 + i) * 512 + h * 128 + e] = s + r * exp2f((float)(i + 1) * l2g);
    }
}
__global__ void k_gn(const bf16_t* PROJ, const float* OG, const float* gn, bf16_t* MIXIN) {
    const int gw = (blockIdx.x * blockDim.x + threadIdx.x) >> 6, lane = threadIdx.x & 63; if (gw >= T_ * 4) return;
    const int t = gw >> 2, h = gw & 3;
    const float o0 = OG[(size_t)t * 512 + h * 128 + 2 * lane], o1 = OG[(size_t)t * 512 + h * 128 + 2 * lane + 1];
    const float mu = wave_sum(o0 + o1) * (1.f / 128.f);
    const float d0 = o0 - mu, d1 = o1 - mu;
    const float var = wave_sum(d0 * d0 + d1 * d1) * (1.f / 128.f);
    const float rs = 1.f / sqrtf(var + EPS);
    const int c = h * 128 + 2 * lane;
    const float g0 = bf2f(PROJ[(size_t)t * INC + 2048 + c]), g1 = bf2f(PROJ[(size_t)t * INC + 2048 + c + 1]);
    *(unsigned*)(MIXIN + (size_t)t * D_ + 512 + c) = pk2(silu_f(g0) * d0 * rs * gn[c], silu_f(g1) * d1 * rs * gn[c + 1]);
}
__global__ void k_h2(const float* X1, const float* mod, const float* g_ffn, bf16_t* HN, float* H2F) {
    const int gw = (blockIdx.x * blockDim.x + threadIdx.x) >> 6, lane = threadIdx.x & 63; if (gw >= T_) return;
    const int r = gw, b = r / SEQ;
    const f32x4* xr = (const f32x4*)(X1 + (size_t)r * D_) + lane;
    f32x4 v[4]; float ss = 0.f;
#pragma unroll
    for (int j = 0; j < 4; ++j) { v[j] = xr[64 * j]; ss += (v[j].x * v[j].x + v[j].y * v[j].y) + (v[j].z * v[j].z + v[j].w * v[j].w); }
    const float rs = 1.f / sqrtf(wave_sum(ss) * (1.f / D_) + EPS);
    const float* sh = mod + b * NMOD + 3 * D_; const float* sc = mod + b * NMOD + 4 * D_;
#pragma unroll
    for (int j = 0; j < 4; ++j) {
        const int c0 = 4 * lane + 256 * j; float hv[4];
#pragma unroll
        for (int q = 0; q < 4; ++q) hv[q] = v[j][q] * rs * g_ffn[c0 + q] * (1.f + sc[c0 + q]) + sh[c0 + q];
        *(f32x4*)(H2F + (size_t)r * D_ + c0) = (f32x4){hv[0], hv[1], hv[2], hv[3]};
        *(unsigned long long*)(HN + (size_t)r * D_ + c0) = (unsigned long long)pk2(hv[0], hv[1]) | ((unsigned long long)pk2(hv[2], hv[3]) << 32);
    }
}
__global__ void k_logits(const float* H2F, const float* wr, const float* br, float* LG) {
    const int i = blockIdx.x * blockDim.x + threadIdx.x; if (i >= T_ * NE) return;
    const int t = i >> 5, e = i & 31; float s = 0.f;
    for (int k = 0; k < D_; ++k) s += H2F[(size_t)t * D_ + k] * wr[k * NE + e];
    LG[i] = s + br[e];
}
__global__ void k_topk(const float* LG, int* cnt, int* tokslot, float* wslot) {
    const int t = blockIdx.x * blockDim.x + threadIdx.x; if (t >= T_) return;
    float v[NE];
#pragma unroll
    for (int e = 0; e < NE; ++e) v[e] = LG[t * NE + e];
    float tv[4]; int ti[4];
#pragma unroll
    for (int k = 0; k < 4; ++k) {
        float best = -INFINITY; int bi = 0;
#pragma unroll
        for (int e = 0; e < NE; ++e) if (v[e] > best) { best = v[e]; bi = e; }
        tv[k] = best; ti[k] = bi;
#pragma unroll
        for (int e = 0; e < NE; ++e) if (e == bi) v[e] = -INFINITY;
    }
    float ex[4], se = 0.f;
#pragma unroll
    for (int k = 0; k < 4; ++k) { ex[k] = __expf(tv[k] - tv[0]); se += ex[k]; }
#pragma unroll
    for (int k = 0; k < 4; ++k) { const int rank = atomicAdd(&cnt[ti[k]], 1); tokslot[ti[k] * CAP + rank] = t * 4 + k; wslot[t * 4 + k] = ex[k] / se; }
}
__global__ void k_offsets(const int* cnt, int* pstart) {
    if (threadIdx.x == 0 && blockIdx.x == 0) { int s = 0; for (int e = 0; e < NE; ++e) { pstart[e] = s; s += ((cnt[e] + 255) / 256) * 256; } pstart[NE] = s; }
}
__global__ void __launch_bounds__(256) k_gateup(const bf16_t* HN, const bf16_t* WGUT, const float* bgu, const int* cnt, const int* pstart, const int* tokslot, bf16_t* ACT) {
    const int wave = threadIdx.x >> 6, lane = threadIdx.x & 63, fr = lane & 15, fq = lane >> 4, e = blockIdx.z, ne = cnt[e];
    const int a0 = blockIdx.x * 16;
    const int pn = a0 >> 7, i0 = a0 & 127;
    const bf16_t* Bg = WGUT + ((size_t)e * 2048 + 256 * pn + i0 + fr) * D_ + fq * 8;
    const bf16_t* Bl = Bg + (size_t)128 * D_;
    for (int rt = blockIdx.y; rt * 64 < ne; rt += gridDim.y) {
        const int rank = rt * 64 + wave * 16 + fr;
        const int tok = (rank < ne) ? (tokslot[e * CAP + rank] >> 2) : 0;
        const bf16_t* ap = HN + (size_t)tok * D_ + fq * 8;
        f32x4 ag = (f32x4){0.f, 0.f, 0.f, 0.f}, al = ag;
        for (int k0 = 0; k0 < D_; k0 += 32) {
            const bf16x8 av = *(const bf16x8*)(ap + k0);
            ag = MFMA16(*(const bf16x8*)(Bg + k0), av, ag); al = MFMA16(*(const bf16x8*)(Bl + k0), av, al);
        }
        if (rank < ne) {
#pragma unroll
            for (int j = 0; j < 4; ++j) {
                const int acol = a0 + 4 * fq + j;
                float gate = ag[j] + bgu[e * 2048 + 2 * acol], lin = al[j] + bgu[e * 2048 + 2 * acol + 1];
                gate = fminf(gate, 7.f); lin = fminf(fmaxf(lin, -7.f), 7.f);
                const float glu = gate / (1.f + __expf(-1.702f * gate));
                ACT[(size_t)(pstart[e] + rank) * FF + acol] = (bf16_t)f2bf((lin + 1.f) * glu);
            }
        }
    }
}
__global__ void __launch_bounds__(256) k_down(const bf16_t* ACT, const bf16_t* WDT, const float* bd, const int* cnt, const int* pstart, const int* tokslot, bf16_t* Y) {
    const int wave = threadIdx.x >> 6, lane = threadIdx.x & 63, fr = lane & 15, fq = lane >> 4, e = blockIdx.z, ne = cnt[e];
    const int col0 = blockIdx.x * 64;
    const bf16_t* bp = WDT + ((size_t)e * D_ + col0 + fr) * FF + fq * 8;
    for (int rt = blockIdx.y; rt * 64 < ne; rt += gridDim.y) {
        const int rank = rt * 64 + wave * 16 + fr;
        const bf16_t* ap = ACT + (size_t)(pstart[e] + ((rank < ne) ? rank : 0)) * FF + fq * 8;
        f32x4 acc[4];
#pragma unroll
        for (int n = 0; n < 4; ++n) acc[n] = (f32x4){0.f, 0.f, 0.f, 0.f};
        for (int k0 = 0; k0 < FF; k0 += 32) {
            const bf16x8 av = *(const bf16x8*)(ap + k0);
#pragma unroll
            for (int n = 0; n < 4; ++n) acc[n] = MFMA16(*(const bf16x8*)(bp + (size_t)n * 16 * FF + k0), av, acc[n]);
        }
        if (rank < ne) {
            const int slot = tokslot[e * CAP + rank];
#pragma unroll
            for (int n = 0; n < 4; ++n)
#pragma unroll
                for (int j = 0; j < 4; ++j) { const int c = col0 + n * 16 + 4 * fq + j; Y[(size_t)slot * D_ + c] = (bf16_t)f2bf(acc[n][j] + bd[e * D_ + c]); }
        }
    }
}
__global__ void k_final(const float* X1, const bf16_t* Y, const float* wslot, const float* mod, const float* g_final, float* out) {
    const int gw = (blockIdx.x * blockDim.x + threadIdx.x) >> 6, lane = threadIdx.x & 63; if (gw >= T_) return;
    const int r = gw, b = r / SEQ;
    const float* gt2 = mod + b * NMOD + 5 * D_;
    float w[4];
#pragma unroll
    for (int k = 0; k < 4; ++k) w[k] = wslot[r * 4 + k];
    f32x4 v[4]; float ss = 0.f;
#pragma unroll
    for (int j = 0; j < 4; ++j) {
        const int c0 = 4 * lane + 256 * j;
        f32x4 f = (f32x4){0.f, 0.f, 0.f, 0.f};
#pragma unroll
        for (int k = 0; k < 4; ++k) {
            const u32x2 y = *(const u32x2*)(Y + (size_t)(r * 4 + k) * D_ + c0);
            f.x += w[k] * bf2f(y.x & 0xffffu); f.y += w[k] * bf2f(y.x >> 16); f.z += w[k] * bf2f(y.y & 0xffffu); f.w += w[k] * bf2f(y.y >> 16);
        }
        const f32x4 x1 = *(const f32x4*)(X1 + (size_t)r * D_ + c0); const f32x4 g = *(const f32x4*)(gt2 + c0);
        v[j] = x1 + g * f;
        ss += (v[j].x * v[j].x + v[j].y * v[j].y) + (v[j].z * v[j].z + v[j].w * v[j].w);
    }
    const float rs = 1.f / sqrtf(wave_sum(ss) * (1.f / D_) + EPS);
#pragma unroll
    for (int j = 0; j < 4; ++j) { const int c0 = 4 * lane + 256 * j; const f32x4 g = *(const f32x4*)(g_final + c0); *(f32x4*)(out + (size_t)r * D_ + c0) = v[j] * rs * g; }
}

extern "C" void kernel_launch(void* const* d_in, const int* in_sizes, int n_in, void* d_out, int out_size, void* d_ws, size_t ws_size, hipStream_t stream) {
    static int grid = 0;
    if (grid == 0) {
        if (n_in != 19 || in_sizes[0] != T_ * D_ || out_size != T_ * D_ || ws_size < WS_END) { fprintf(stderr, "kernel_launch: unexpected shapes / workspace (n_in %d, ws %zu)\n", n_in, ws_size); grid = -1; return; }
        int dev = 0, cus = 0, per_cu = 0;
        if (hipGetDevice(&dev) != hipSuccess || hipDeviceGetAttribute(&cus, hipDeviceAttributeMultiprocessorCount, dev) != hipSuccess) { grid = -1; return; }
        if (hipFuncSetAttribute((const void*)mega, hipFuncAttributeMaxDynamicSharedMemorySize, LDS_BYTES) != hipSuccess) { fprintf(stderr, "hipFuncSetAttribute failed\n"); grid = -1; return; }
        if (hipOccupancyMaxActiveBlocksPerMultiprocessor(&per_cu, (const void*)mega, 512, LDS_BYTES) != hipSuccess || per_cu < 1) { fprintf(stderr, "occupancy query: %d\n", per_cu); }
        (void)hipGetLastError();
        grid = cus;
        if (grid != 256) fprintf(stderr, "kernel_launch: grid %d (expected 256)\n", grid);
    }
    if (grid < 0) return;
    unsigned char* ws = (unsigned char*)d_ws;
    (void)hipMemsetAsync(ws + WS_CTL, 0, CTL_ZERO_BYTES, stream);
    Args a{};
    for (int i = 0; i < 19; ++i) a.in[i] = (const float*)d_in[i];
    a.out = (float*)d_out; a.ws = ws;
    const float* const* in = a.in;
    float* MOD = (float*)(ws + WS_MOD); float* ROPE = (float*)(ws + WS_ROPE);
    bf16_t* POOLWT = (bf16_t*)(ws + WS_POOLWT); bf16_t* WINT = (bf16_t*)(ws + WS_WINT); bf16_t* WOUTT = (bf16_t*)(ws + WS_WOUTT);
    int* TOKSLOT = (int*)(ws + WS_TOKSLOT); float* WSLOT = (float*)(ws + WS_WSLOT);
    bf16_t* WGUT = (bf16_t*)(ws + WS_WGUT); bf16_t* WDT = (bf16_t*)(ws + WS_WDT); bf16_t* XN = (bf16_t*)(ws + WS_XN); bf16_t* PROJ = (bf16_t*)(ws + WS_PROJ);
    float* KVT = (float*)(ws + WS_KVT); bf16_t* RT = (bf16_t*)(ws + WS_RT); bf16_t* MIXIN = (bf16_t*)(ws + WS_MIXIN); float* X1 = (float*)(ws + WS_X1);
    bf16_t* HN = (bf16_t*)(ws + WS_HN); bf16_t* ACT = (bf16_t*)(ws + WS_ACT); bf16_t* Y = (bf16_t*)(ws + WS_Y);
    bf16_t* QR = (bf16_t*)(ws + WS_QR); bf16_t* KR = (bf16_t*)(ws + WS_KR); float* SG = (float*)(ws + WS_SG); float* OG = (float*)(ws + WS_OG);
    float* H2F = (float*)(ws + WS_H2F); float* LG = (float*)(ws + WS_LOGITS); bf16_t* PP = (bf16_t*)(ws + WS_PP);
    int* CNT = (int*)(ws + WS_CTL) + CW_CNT; int* PSTART = (int*)(ws + WS_CTL) + CW_PSTART;

#define MEGA(lo, hi) do { a.ph_lo = (lo); a.ph_hi = (hi); hipLaunchKernelGGL(mega, dim3(grid), dim3(512), LDS_BYTES, stream, a); } while (0)
#if ONE_LAUNCH
    MEGA(0, 11);
#else
    MEGA(0, 1);
    MEGA(1, 2);
#if SIMPLE_INPROJ
    hipLaunchKernelGGL(k_sgemm<EpiStoreBf16>, dim3(INC / 64, T_ / 64), dim3(256), 0, stream, XN, WINT, EpiStoreBf16{PROJ, INC, D_});
#else
    MEGA(2, 3);
#endif
#if SIMPLE_MIX
    hipLaunchKernelGGL(k_pool_p, dim3(T_ * 512 / 256), dim3(256), 0, stream, PROJ, PP);
    hipLaunchKernelGGL(k_pool_mm, dim3(T_ * 512 / 256), dim3(256), 0, stream, PP, POOLWT, in[7], in[8], MIXIN);
    hipLaunchKernelGGL(k_rot, dim3(T_ * 256 / 256), dim3(256), 0, stream, PROJ, ROPE, QR, KR);
    hipLaunchKernelGGL(k_kv, dim3(32 * 15), dim3(256), 0, stream, PROJ, KR, KVT);
    hipLaunchKernelGGL(k_scan, dim3(32 * 16384 / 256), dim3(256), 0, stream, KVT, RT);
    hipLaunchKernelGGL(k_S, dim3(512), dim3(256), 0, stream, QR, KR, SG);
    hipLaunchKernelGGL(k_o, dim3(512), dim3(256), 0, stream, PROJ, QR, SG, RT, OG);
    hipLaunchKernelGGL(k_gn, dim3(T_ * 4 * 64 / 256), dim3(256), 0, stream, PROJ, OG, in[9], MIXIN);
#else
    MEGA(3, 4);
    MEGA(4, 5);
    MEGA(5, 6);
#endif
#if SIMPLE_OUTPROJ
    hipLaunchKernelGGL(k_sgemm<EpiOutProj>, dim3(D_ / 64, T_ / 64), dim3(256), 0, stream, MIXIN, WOUTT, EpiOutProj{in[0], MOD, X1, D_, 0});
#else
    MEGA(6, 7);
#endif
#if SIMPLE_ROUTER
    hipLaunchKernelGGL(k_h2, dim3(T_ * 64 / 256), dim3(256), 0, stream, X1, MOD, in[11], HN, H2F);
    hipLaunchKernelGGL(k_logits, dim3(T_ * NE / 256), dim3(256), 0, stream, H2F, in[12], in[13], LG);
    hipLaunchKernelGGL(k_topk, dim3(T_ / 256), dim3(256), 0, stream, LG, CNT, TOKSLOT, WSLOT);
#else
    MEGA(7, 8);
#endif
#if SIMPLE_GATEUP || SIMPLE_DOWN
    hipLaunchKernelGGL(k_offsets, dim3(1), dim3(64), 0, stream, CNT, PSTART);
#endif
#if SIMPLE_GATEUP
    hipLaunchKernelGGL(k_gateup, dim3(FF / 16, 40, NE), dim3(256), 0, stream, HN, WGUT, in[15], CNT, PSTART, TOKSLOT, ACT);
#else
    MEGA(8, 9);
#endif
#if SIMPLE_DOWN
    hipLaunchKernelGGL(k_down, dim3(D_ / 64, 40, NE), dim3(256), 0, stream, ACT, WDT, in[17], CNT, PSTART, TOKSLOT, Y);
#else
    MEGA(9, 10);
#endif
#if SIMPLE_FINAL
    hipLaunchKernelGGL(k_final, dim3(T_ * 64 / 256), dim3(256), 0, stream, X1, Y, WSLOT, MOD, in[18], (float*)d_out);
#else
    MEGA(10, 11);
#endif
#endif
}
```

```cpp
#include <hip/hip_runtime.h>
#include <cstdint>
#include <cstdio>

typedef unsigned short bf16_t;
typedef short bf16x8 __attribute__((ext_vector_type(8)));
typedef float f32x4 __attribute__((ext_vector_type(4)));
typedef unsigned u32x4 __attribute__((ext_vector_type(4)));
typedef unsigned u32x2 __attribute__((ext_vector_type(2)));
#define LAS __attribute__((address_space(3)))

#ifndef GU_F8
#define GU_F8 true
#endif
#ifndef DN_F8
#define DN_F8 true
#endif
#ifndef REPEAT_MASK
#define REPEAT_MASK 0
#endif
#ifndef ONE_LAUNCH
#define ONE_LAUNCH 1
#endif
#ifndef SIMPLE_MIX
#define SIMPLE_MIX 0
#endif
#ifndef SIMPLE_ROUTER
#define SIMPLE_ROUTER 0
#endif
#ifndef SIMPLE_FINAL
#define SIMPLE_FINAL 0
#endif
#ifndef SIMPLE_INPROJ
#define SIMPLE_INPROJ 0
#endif
#ifndef SIMPLE_OUTPROJ
#define SIMPLE_OUTPROJ 0
#endif
#ifndef SIMPLE_GATEUP
#define SIMPLE_GATEUP 0
#endif
#ifndef SIMPLE_DOWN
#define SIMPLE_DOWN 0
#endif
constexpr int T_ = 16384, D_ = 1024, NB = 8, SEQ = 2048, INC = 2560, NE = 32, FF = 1024, TK = 65536, NMOD = 6144;
constexpr int CAP = 16384;
constexpr int ACT_ROWS = TK + NE * 256;
constexpr float EPS = 1e-6f;

constexpr size_t MiB = 1u << 20;
constexpr size_t WS_CTL = 0, CTL_ZERO_BYTES = 1 * MiB;
constexpr size_t WS_MODP = 1 * MiB;
constexpr size_t WS_MOD = 3 * MiB;
constexpr size_t WS_ROPE = 4 * MiB;
constexpr size_t WS_POOLWT = 5 * MiB;
constexpr size_t WS_WINT = 6 * MiB;
constexpr size_t WS_WOUTT = 11 * MiB;
constexpr size_t WS_TOKSLOT = 13 * MiB;
constexpr size_t WS_WSLOT = 15 * MiB;
constexpr size_t WS_WGUT = 16 * MiB;
constexpr size_t WS_WDT = 144 * MiB;
constexpr size_t WS_XN = 208 * MiB;
constexpr size_t WS_PROJ = 240 * MiB;
constexpr size_t WS_KVT = 320 * MiB;
constexpr size_t WS_RT = 352 * MiB;
constexpr size_t WS_MIXIN = 368 * MiB;
constexpr size_t WS_X1 = 400 * MiB;
constexpr size_t WS_HN = 464 * MiB;
constexpr size_t WS_ACT = 496 * MiB;
constexpr size_t WS_Y = 640 * MiB;
constexpr size_t WS_QR = 768 * MiB;
constexpr size_t WS_KR = 784 * MiB;
constexpr size_t WS_SG = 800 * MiB;
constexpr size_t WS_OG = 832 * MiB;
constexpr size_t WS_H2F = 864 * MiB;
constexpr size_t WS_LOGITS = 928 * MiB;
constexpr size_t WS_PP = 930 * MiB;
constexpr size_t WS_END = 946 * MiB;
constexpr int CW_CNT = 64;
constexpr int CW_PSTART = 128;

#define MFMA16(a, b, c) __builtin_amdgcn_mfma_f32_16x16x32_bf16(a, b, c, 0, 0, 0)
__device__ __forceinline__ unsigned f2bf(float f) { unsigned u = __float_as_uint(f); return (u + 0x7fffu + ((u >> 16) & 1u)) >> 16; }
__device__ __forceinline__ unsigned pk2(float lo, float hi) { return f2bf(lo) | (f2bf(hi) << 16); }
__device__ __forceinline__ float bf2f(unsigned h) { return __uint_as_float(h << 16); }
__device__ __forceinline__ float wave_sum(float v) {
#pragma unroll
    for (int o = 1; o < 64; o <<= 1) v += __shfl_xor(v, o);
    return v;
}
__device__ __forceinline__ float silu_f(float v) { return v / (1.f + __expf(-v)); }
__device__ __forceinline__ float log2_gamma(int h) { return log2f(1.f - exp2f(-5.f - (float)h)); }

constexpr int NWAVES = 8;
constexpr float WSCALE = 64.f;
constexpr int SCALE_W = 121, SCALE_ONE = 127, SCALE_ACT = 125;
constexpr float ASCALE = 4.f;
typedef int i32x8 __attribute__((ext_vector_type(8)));
typedef int i32x4 __attribute__((ext_vector_type(4)));
constexpr int LDS_BYTES = 147456;

template <int MAPMODE, bool F8 = false>
__device__ __forceinline__ void transpose_item(const float* W, int K, int N, bf16_t* WT, LAS float* scr, int item, int lane) {
    const int nblk = N / 32, kb = item / nblk, nb = item % nblk, k0 = 64 * kb, n0 = 32 * nb;
#pragma unroll 8
    for (int i = 0; i < 32; ++i) { const int kk = 2 * i + (lane >> 5); scr[kk * 33 + (lane & 31)] = W[(size_t)(k0 + kk) * N + n0 + (lane & 31)]; }
    asm volatile("s_waitcnt lgkmcnt(0)" ::: "memory");
    const int c = lane & 7;
#pragma unroll
    for (int j = 0; j < 4; ++j) {
        const int nl = (lane >> 3) + 8 * j; const LAS float* s = scr + (8 * c) * 33 + nl;
        const int n = n0 + nl; int row = n;
        if (MAPMODE == 1) { const int a = n >> 1, bj = n & 1; row = 256 * (a >> 7) + 128 * bj + (a & 127); }
        if constexpr (F8) {
            int w0 = __builtin_amdgcn_cvt_pk_fp8_f32(s[0 * 33] * WSCALE, s[1 * 33] * WSCALE, 0, false); w0 = __builtin_amdgcn_cvt_pk_fp8_f32(s[2 * 33] * WSCALE, s[3 * 33] * WSCALE, w0, true);
            int w1 = __builtin_amdgcn_cvt_pk_fp8_f32(s[4 * 33] * WSCALE, s[5 * 33] * WSCALE, 0, false); w1 = __builtin_amdgcn_cvt_pk_fp8_f32(s[6 * 33] * WSCALE, s[7 * 33] * WSCALE, w1, true);
            u32x2 o; o.x = (unsigned)w0; o.y = (unsigned)w1;
            *(u32x2*)((unsigned char*)WT + (size_t)row * K + k0 + 8 * c) = o;
        } else {
            u32x4 o; o.x = pk2(s[0 * 33], s[1 * 33]); o.y = pk2(s[2 * 33], s[3 * 33]); o.z = pk2(s[4 * 33], s[5 * 33]); o.w = pk2(s[6 * 33], s[7 * 33]);
            *(u32x4*)(WT + (size_t)row * K + k0 + 8 * c) = o;
        }
    }
    asm volatile("s_waitcnt lgkmcnt(0)" ::: "memory");
}

struct Args {
    const float* in[19]; float* out; unsigned char* ws; int ph_lo, ph_hi;
};

__device__ __forceinline__ void phase_p0(const Args& a, LAS unsigned char* lds, int vb, int G) {
    const int tid = threadIdx.x, lane = tid & 63, wave = tid >> 6;
    unsigned char* ws = a.ws;
    if (vb < 256) {
        LAS float* cact = (LAS float*)lds;
        LAS float* part = (LAS float*)(lds + 4096);
        const int kc = vb & 7, cc = vb >> 3;
        const float* c = a.in[1];
        for (int i = tid; i < 8 * 128; i += 512) { const int b = i >> 7, k = i & 127; cact[i] = silu_f(c[b * D_ + kc * 128 + k]); }
        __syncthreads();
        const int cg = tid % 48, ks = tid / 48;
        if (ks < 10) {
            f32x4 acc[8];
#pragma unroll
            for (int b = 0; b < 8; ++b) acc[b] = (f32x4){0.f, 0.f, 0.f, 0.f};
            const float* w = a.in[2] + (size_t)(kc * 128) * NMOD + cc * 192 + cg * 4;
            for (int k = ks; k < 128; k += 10) {
                const f32x4 wv = *(const f32x4*)(w + (size_t)k * NMOD);
#pragma unroll
                for (int b = 0; b < 8; ++b) acc[b] += wv * cact[b * 128 + k];
            }
#pragma unroll
            for (int b = 0; b < 8; ++b) *(LAS f32x4*)(part + (ks * 8 + b) * 192 + cg * 4) = acc[b];
        }
        __syncthreads();
        float* modp = (float*)(ws + WS_MODP);
        for (int i = tid; i < 8 * 192; i += 512) {
            const int b = i / 192, col = i % 192; float s = 0.f;
#pragma unroll
            for (int q = 0; q < 10; ++q) s += part[(q * 8 + b) * 192 + col];
            modp[((size_t)kc * 8 + b) * NMOD + cc * 192 + col] = s;
        }
        __syncthreads();
    }
    {
        float* cosT = (float*)(ws + WS_ROPE); float* sinT = cosT + SEQ * 64;
        for (int i = vb * 512 + tid; i < SEQ * 64; i += G * 512) {
            const int pos = i >> 6, j = i & 63;
            const double inv = (double)(float)exp(-(double)j * (9.210340371976184 / 64.0));
            const double ang = (double)((float)pos * (float)inv);
            const double q = rint(ang * 0.6366197723675814);
            double r = fma(-q, 1.5707963267948966, ang); r = fma(-q, 6.123233995736766e-17, r);
            const double r2 = r * r;
            double s = -1.0 / 39916800.0; s = s * r2 + 1.0 / 362880.0; s = s * r2 - 1.0 / 5040.0; s = s * r2 + 1.0 / 120.0; s = s * r2 - 1.0 / 6.0; s = s * r2 + 1.0; s *= r;
            double co = 1.0 / 479001600.0; co = co * r2 - 1.0 / 3628800.0; co = co * r2 + 1.0 / 40320.0; co = co * r2 - 1.0 / 720.0; co = co * r2 + 1.0 / 24.0; co = co * r2 - 0.5; co = co * r2 + 1.0;
            const int n = ((int)q) & 3;
            const double sv = (n == 0) ? s : (n == 1) ? co : (n == 2) ? -s : -co;
            const double cv = (n == 0) ? co : (n == 1) ? -s : (n == 2) ? -co : s;
            cosT[i] = (float)cv; sinT[i] = (float)sv;
        }
    }
    {
        LAS float* scr = (LAS float*)(lds + wave * 16384);
        const int gw = vb * NWAVES + wave, NGW = G * NWAVES;
        constexpr int I_IN = (D_ / 64) * (INC / 32), I_OUT = (D_ / 64) * (D_ / 32), I_POOL = 4 * 2 * 4, I_GU = (D_ / 64) * (2 * FF / 32), I_DN = (FF / 64) * (D_ / 32);
        constexpr int NITEMS = I_IN + I_OUT + I_POOL + NE * I_GU + NE * I_DN;
        for (int it = gw; it < NITEMS; it += NGW) {
            int r = it;
            if (r < I_IN) { transpose_item<0>(a.in[5], D_, INC, (bf16_t*)(ws + WS_WINT), scr, r, lane); continue; } r -= I_IN;
            if (r < I_OUT) { transpose_item<0>(a.in[10], D_, D_, (bf16_t*)(ws + WS_WOUTT), scr, r, lane); continue; } r -= I_OUT;
            if (r < I_POOL) { const int g = r / 8; transpose_item<0>(a.in[6] + g * 128 * 128, 128, 128, (bf16_t*)(ws + WS_POOLWT) + g * 128 * 128, scr, r % 8, lane); continue; } r -= I_POOL;
            if (r < NE * I_GU) { const int e = r / I_GU; transpose_item<1, GU_F8>(a.in[14] + (size_t)e * D_ * 2 * FF, D_, 2 * FF, (bf16_t*)(ws + WS_WGUT + (size_t)e * 2 * FF * D_ * (GU_F8 ? 1 : 2)), scr, r % I_GU, lane); continue; } r -= NE * I_GU;
            { const int e = r / I_DN; transpose_item<0, DN_F8>(a.in[16] + (size_t)e * FF * D_, FF, D_, (bf16_t*)(ws + WS_WDT + (size_t)e * D_ * FF * (DN_F8 ? 1 : 2)), scr, r % I_DN, lane); }
        }
    }
}

__device__ __forceinline__ void phase_p1(const Args& a, LAS unsigned char* lds, int vb, int G) {
    const int tid = threadIdx.x, lane = tid & 63, wave = tid >> 6;
    unsigned char* ws = a.ws;
    const float* modp = (const float*)(ws + WS_MODP); float* mod = (float*)(ws + WS_MOD);
    for (int i = vb * 512 + tid; i < NB * NMOD; i += G * 512) {
        const int col = i % NMOD; float s = a.in[3][col];
#pragma unroll
        for (int q = 0; q < 8; ++q) s += modp[(size_t)q * NB * NMOD + i];
        mod[i] = s;
    }
    const int RPB = T_ / G;
    const int row0 = vb * RPB, b = row0 / SEQ;
    LAS float* shs = (LAS float*)lds;
    LAS float* scs = shs + 1024;
    for (int i = tid; i < 2048; i += 512) {
        float s = a.in[3][i];
#pragma unroll
        for (int q = 0; q < 8; ++q) s += modp[(size_t)q * NB * NMOD + (size_t)b * NMOD + i];
        if (i < 1024) shs[i] = s; else scs[i - 1024] = (1.f + s) * a.in[4][i - 1024];
    }
    __syncthreads();
    bf16_t* XN = (bf16_t*)(ws + WS_XN);
    for (int r = row0 + wave; r < row0 + RPB; r += NWAVES) {
        const f32x4* xr = (const f32x4*)(a.in[0] + (size_t)r * D_) + lane;
        f32x4 v[4]; float ss = 0.f;
#pragma unroll
        for (int j = 0; j < 4; ++j) { v[j] = xr[64 * j]; ss += (v[j].x * v[j].x + v[j].y * v[j].y) + (v[j].z * v[j].z + v[j].w * v[j].w); }
        const float rs = 1.f / sqrtf(wave_sum(ss) * (1.f / D_) + EPS);
        unsigned long long* o8 = (unsigned long long*)(XN + (size_t)r * D_) + lane;
#pragma unroll
        for (int j = 0; j < 4; ++j) {
            const int c0 = 4 * lane + 256 * j;
            const float h0 = v[j].x * rs * scs[c0] + shs[c0], h1 = v[j].y * rs * scs[c0 + 1] + shs[c0 + 1], h2 = v[j].z * rs * scs[c0 + 2] + shs[c0 + 2], h3 = v[j].w * rs * scs[c0 + 3] + shs[c0 + 3];
            o8[64 * j] = (unsigned long long)pk2(h0, h1) | ((unsigned long long)pk2(h2, h3) << 32);
        }
    }
    __syncthreads();
}


namespace pg8 {
constexpr int BM = 256, BK = 64, HALF = 128, HTB = HALF * BK * 2, STAGE_BYTES = 8 * HTB, NXCD = 8, WGM = 8;
__host__ __device__ __forceinline__ int lds_byte(int r, int c) { const int st = (r >> 4) * 2 + (c >> 5), rr = r & 15, cc = c & 31, ob = rr * 64 + cc * 2; return st * 1024 + (ob ^ (((ob >> 9) & 1) << 5)); }
__host__ __device__ __forceinline__ void stage_rc(int b, int& R, int& C) { const int st = b / 1024, sb = b % 1024, swz = sb ^ (((sb >> 9) & 1) << 5); R = (st >> 1) * 16 + swz / 64; C = (st & 1) * 32 + (swz % 64) / 2; }
__host__ __device__ __forceinline__ int perm32(int rho) { const int n = rho >> 4, i = rho & 15; return 8 * (i >> 2) + 4 * n + (i & 3); }

struct Unit { int pm, pn, e, r0; };
struct Gemm { const bf16_t* A; const bf16_t* Bt; int N, K; size_t bstride; int sw, so; };

struct TileOrder {
    int nM, nN, nwg, G, c;
    __device__ __forceinline__ void init(int nM_, int nN_, int G_, int c_) { nM = nM_; nN = nN_; nwg = nM * nN; G = G_; c = c_; }
    __device__ __forceinline__ bool tile(int i, int& pm, int& pn) const {
        const long L = (long)i * G + c; if (L >= nwg) return false;
        int wgid = (int)L; { const int q = nwg / NXCD, r = nwg % NXCD, xcd = wgid % NXCD, off = wgid / NXCD; wgid = (xcd < r ? xcd * (q + 1) : r * (q + 1) + (xcd - r) * q) + off; }
        const int nig = WGM * nN, gid = wgid / nig, fm = gid * WGM, gsz = (nM - fm) < WGM ? (nM - fm) : WGM;
        pm = fm + ((wgid % nig) % gsz); pn = (wgid % nig) / gsz; return true;
    }
};
struct DenseOrder : TileOrder {
    __device__ __forceinline__ bool next(int i, Unit& u) const { int pm, pn; if (!tile(i, pm, pn)) return false; u.pm = pm; u.pn = pn; u.e = 0; u.r0 = pm * BM; return true; }
    __device__ __forceinline__ int arow(int, const Unit& u, int lr) const { return u.r0 + lr; }
};

__device__ __forceinline__ unsigned cvt_pk_bf16(float lo, float hi) { unsigned r; asm volatile("v_cvt_pk_bf16_f32 %0, %1, %2" : "=v"(r) : "v"(lo), "v"(hi)); return r; }

template <class Epi, class Sched, bool ALIGN_EPI, bool F8 = false>
__device__ __forceinline__ void gemm_phase(LAS unsigned char* lds, const Gemm g, const Sched& S, const Epi& E) {
    const int tid = threadIdx.x, wid = __builtin_amdgcn_readfirstlane(tid >> 6), lane = tid & 63, wr = wid >> 2, wc = wid & 3, fr = lane & 15, fq = lane >> 4;
    const int K = F8 ? g.K / 2 : g.K, nt = K / BK;
    unsigned voffB[2];
#pragma unroll
    for (int i = 0; i < 2; ++i) { int R, C; stage_rc(tid * 16 + i * 8192, R, C); const int Rb = Epi::PERM ? ((R & ~31) + perm32(R & 31)) : R; voffB[i] = (unsigned)(Rb * K + C) * 2u; }
    const size_t kstep = (size_t)(BK * 2);
    const size_t hstep = (size_t)HALF * K * 2;
    const size_t tstep = 2 * hstep;
    const unsigned ldsw = (unsigned)wid * 1024u;
    const int aoff = lds_byte(wr * 64 + fr, fq * 8), boff = lds_byte(wc * 32 + fr, fq * 8);
#define PG8_SA(b, h) (((b) * 2 + (h)) * HTB)
#define PG8_SB(b, h) ((4 + (b) * 2 + (h)) * HTB)
#define PG8_STAGE(bufoff, gbase, voff) do { _Pragma("unroll") for (int _i = 0; _i < 2; ++_i) \
        __builtin_amdgcn_global_load_lds((const unsigned*)((const char*)(gbase) + (voff)[_i]), (LAS unsigned*)(lds + (bufoff) + ldsw + _i * 8192), 16, 0, 0); } while (0)
#define PG8_LDA(dst, b, h) do { _Pragma("unroll") for (int m = 0; m < 4; ++m) _Pragma("unroll") for (int k = 0; k < 2; ++k) dst[m][k] = *(const LAS bf16x8*)(lds + PG8_SA(b, h) + aoff + m * 2048 + k * 1024); } while (0)
#define PG8_LDB(dst, b, h) do { _Pragma("unroll") for (int n = 0; n < 2; ++n) _Pragma("unroll") for (int k = 0; k < 2; ++k) dst[n][k] = *(const LAS bf16x8*)(lds + PG8_SB(b, h) + boff + n * 2048 + k * 1024); } while (0)
#define PG8_CAT(x) __builtin_shufflevector(__builtin_bit_cast(i32x4, x[0]), __builtin_bit_cast(i32x4, x[1]), 0, 1, 2, 3, 4, 5, 6, 7)
#define PG8_MMA(ai, bj, At, Bt) do { __builtin_amdgcn_s_setprio(1); _Pragma("unroll") for (int m = 0; m < 4; ++m) _Pragma("unroll") for (int n = 0; n < 2; ++n) { \
        if constexpr (F8) { asm volatile("v_mfma_scale_f32_16x16x128_f8f6f4 %0, %1, %2, %0, %3, %4 op_sel_hi:[0,0,0]" : "+v"(acc[ai][bj][m][n]) : "v"(PG8_CAT(Bt[n])), "v"(PG8_CAT(At[m])), "v"(f8sw), "v"(f8so)); } \
        else { _Pragma("unroll") for (int k = 0; k < 2; ++k) acc[ai][bj][m][n] = __builtin_amdgcn_mfma_f32_16x16x32_bf16(Bt[n][k], At[m][k], acc[ai][bj][m][n], 0, 0, 0); } } \
        __builtin_amdgcn_s_setprio(0); } while (0)
#define PG8_WAIT_V(n) asm volatile("s_waitcnt vmcnt(" #n ")" ::: "memory")
#define PG8_WAIT_L(n) asm volatile("s_waitcnt lgkmcnt(" #n ")" ::: "memory")
#define PG8_BAR __builtin_amdgcn_s_barrier()
#define PG8_SCHED __builtin_amdgcn_sched_barrier(0)
#define PG8_AOFF(dst, i_, u_) do { _Pragma("unroll") for (int _i = 0; _i < 2; ++_i) { int _R, _C; stage_rc(tid * 16 + _i * 8192, _R, _C); _Pragma("unroll") for (int _h = 0; _h < 2; ++_h) \
        dst[_h][_i] = ((unsigned)S.arow(i_, u_, _h * HALF + _R) * (unsigned)K + (unsigned)_C) * 2u; } } while (0)
    Unit cur, nxt; int ui = 0;
    if (!S.next(0, cur)) return;
    int f8sw = g.sw, f8so = g.so;
    if constexpr (F8) asm volatile("" : "+v"(f8sw), "+v"(f8so));
    f32x4 acc[2][2][4][2];
#pragma unroll
    for (int a = 0; a < 2; ++a)
#pragma unroll
        for (int b = 0; b < 2; ++b)
#pragma unroll
            for (int m = 0; m < 4; ++m)
#pragma unroll
                for (int n = 0; n < 2; ++n) acc[a][b][m][n] = (f32x4){0.f, 0.f, 0.f, 0.f};
    bf16x8 At[4][2], B0[2][2], B1[2][2];
    unsigned voffA[2][2], v2[2][2];
    PG8_AOFF(voffA, 0, cur);
    const char* const cA = (const char*)g.A;
    const char* cB = (const char*)g.Bt + (size_t)cur.e * g.bstride + (size_t)cur.pn * tstep;
    PG8_STAGE(PG8_SB(0, 0), cB, voffB); PG8_STAGE(PG8_SB(0, 1), cB + hstep, voffB); PG8_STAGE(PG8_SA(0, 0), cA, voffA[0]); PG8_STAGE(PG8_SA(0, 1), cA, voffA[1]);
    if (wr == 1) PG8_BAR;
    PG8_WAIT_V(2); PG8_BAR;
    PG8_STAGE(PG8_SB(1, 0), cB + kstep, voffB); PG8_STAGE(PG8_SA(1, 0), cA + kstep, voffA[0]); PG8_STAGE(PG8_SB(1, 1), cB + hstep + kstep, voffB);
    PG8_WAIT_V(6); PG8_BAR;
    for (;;) {
        const bool has_next = S.next(ui + 1, nxt);
        const char* nB = has_next ? (const char*)g.Bt + (size_t)nxt.e * g.bstride + (size_t)nxt.pn * tstep : cB;
#pragma unroll 1
        for (int t = 0; t < nt; t += 2) {
            const bool last = (t == nt - 2);
            const char* a1 = cA + (size_t)(t + 1) * kstep;
            const char* a2 = last ? cA : cA + (size_t)(t + 2) * kstep; const char* b2 = last ? nB : cB + (size_t)(t + 2) * kstep;
            const char* a3 = a2 + kstep; const char* b3 = b2 + kstep;
            if (last && has_next) { PG8_AOFF(v2, ui + 1, nxt); }
            else {
#pragma unroll
                for (int h = 0; h < 2; ++h)
#pragma unroll
                    for (int i = 0; i < 2; ++i) v2[h][i] = voffA[h][i];
            }
            PG8_LDB(B0, 0, 0); PG8_LDB(B1, 0, 1); PG8_SCHED; PG8_LDA(At, 0, 0); PG8_STAGE(PG8_SA(1, 1), a1, voffA[1]);
            PG8_WAIT_V(8); PG8_WAIT_L(0); PG8_BAR; PG8_MMA(0, 0, At, B0); PG8_MMA(0, 1, At, B1); PG8_BAR; PG8_SCHED;
            PG8_LDA(At, 0, 1); PG8_STAGE(PG8_SB(0, 0), b2, voffB); PG8_STAGE(PG8_SB(0, 1), b2 + hstep, voffB); PG8_STAGE(PG8_SA(0, 0), a2, v2[0]);
            PG8_WAIT_V(8); PG8_WAIT_L(0); PG8_BAR; PG8_MMA(1, 0, At, B0); PG8_MMA(1, 1, At, B1); PG8_BAR; PG8_SCHED;
            PG8_LDB(B0, 1, 0); PG8_LDB(B1, 1, 1); PG8_SCHED; PG8_LDA(At, 1, 0); PG8_STAGE(PG8_SA(0, 1), a2, v2[1]);
            PG8_WAIT_V(8); PG8_WAIT_L(0); PG8_BAR; PG8_MMA(0, 0, At, B0); PG8_MMA(0, 1, At, B1); PG8_BAR; PG8_SCHED;
            PG8_LDA(At, 1, 1); PG8_STAGE(PG8_SB(1, 0), b3, voffB); PG8_STAGE(PG8_SB(1, 1), b3 + hstep, voffB); PG8_STAGE(PG8_SA(1, 0), a3, v2[0]);
            PG8_WAIT_V(8); PG8_WAIT_L(0); PG8_BAR; PG8_MMA(1, 0, At, B0); PG8_MMA(1, 1, At, B1); PG8_BAR; PG8_SCHED;
        }
        if constexpr (ALIGN_EPI) { if (wr == 0) PG8_BAR; }
        if constexpr (F8) asm volatile("s_nop 15\n\ts_nop 15" ::: "memory");
        E(acc, cur, ui, wr, wc, fr, fq);
        if (!has_next) break;
#pragma unroll
        for (int a = 0; a < 2; ++a)
#pragma unroll
            for (int b = 0; b < 2; ++b)
#pragma unroll
                for (int m = 0; m < 4; ++m)
#pragma unroll
                    for (int n = 0; n < 2; ++n) acc[a][b][m][n] = (f32x4){0.f, 0.f, 0.f, 0.f};
        cur = nxt; cB = nB; ++ui;
#pragma unroll
        for (int h = 0; h < 2; ++h)
#pragma unroll
            for (int i = 0; i < 2; ++i) voffA[h][i] = v2[h][i];
        if constexpr (ALIGN_EPI) { if (wr == 1) PG8_BAR; }
    }
    PG8_WAIT_V(0);
    if constexpr (!ALIGN_EPI) { if (wr == 0) PG8_BAR; }
    PG8_BAR;
#undef PG8_SA
#undef PG8_SB
#undef PG8_STAGE
#undef PG8_LDA
#undef PG8_LDB
#undef PG8_MMA
#undef PG8_CAT
#undef PG8_WAIT_V
#undef PG8_WAIT_L
#undef PG8_BAR
#undef PG8_SCHED
#undef PG8_AOFF
}

struct EpiProj {
    static constexpr bool PERM = true;
    bf16_t* O;
    __device__ __forceinline__ void operator()(const f32x4 (&acc)[2][2][4][2], const Unit& u, int, int wr, int wc, int fr, int fq) const {
        const int row0 = u.r0 + wr * 64 + fr, col0 = u.pn * BM + wc * 32 + 8 * fq;
#pragma unroll
        for (int ai = 0; ai < 2; ++ai)
#pragma unroll
            for (int m = 0; m < 4; ++m) { bf16_t* rowp = O + (size_t)(row0 + ai * HALF + m * 16) * INC + col0;
#pragma unroll
                for (int bj = 0; bj < 2; ++bj) { const f32x4 v0 = acc[ai][bj][m][0], v1 = acc[ai][bj][m][1];
                    u32x4 w; w.x = cvt_pk_bf16(v0[0], v0[1]); w.y = cvt_pk_bf16(v0[2], v0[3]); w.z = cvt_pk_bf16(v1[0], v1[1]); w.w = cvt_pk_bf16(v1[2], v1[3]);
                    *(u32x4*)(rowp + bj * HALF) = w; } }
    }
};
struct EpiX1 {
    static constexpr bool PERM = false;
    const float* x; const float* mod; float* X1;
    __device__ __forceinline__ void operator()(const f32x4 (&acc)[2][2][4][2], const Unit& u, int, int wr, int wc, int fr, int fq) const {
        const int row0 = u.r0 + wr * 64 + fr, col0 = u.pn * BM + wc * 32 + 4 * fq, b = u.r0 / SEQ;
        f32x4 gv[2][2];
#pragma unroll
        for (int bj = 0; bj < 2; ++bj)
#pragma unroll
            for (int n = 0; n < 2; ++n) gv[bj][n] = *(const f32x4*)(mod + b * NMOD + 2 * D_ + col0 + bj * HALF + n * 16);
#pragma unroll
        for (int ai = 0; ai < 2; ++ai)
#pragma unroll
            for (int m = 0; m < 4; ++m) { const size_t off = (size_t)(row0 + ai * HALF + m * 16) * D_ + col0;
#pragma unroll
                for (int bj = 0; bj < 2; ++bj)
#pragma unroll
                    for (int n = 0; n < 2; ++n) { const f32x4 xv = *(const f32x4*)(x + off + bj * HALF + n * 16); *(f32x4*)(X1 + off + bj * HALF + n * 16) = xv + gv[bj][n] * acc[ai][bj][m][n]; }
                if (m & 1) asm volatile("" ::: "memory"); }
    }
};
}

constexpr int RING_BYTES = 131072, LDSCTL_OFF = RING_BYTES;
constexpr int L_MISC = LDSCTL_OFF;
constexpr int L_CNT = LDSCTL_OFF + 256;
constexpr int L_PSTART = LDSCTL_OFF + 384;
constexpr int L_NT = LDSCTL_OFF + 640;
constexpr int L_TILES = LDSCTL_OFF + 768;
constexpr int L_ROWTAB = LDSCTL_OFF + 2048;
constexpr int MAX_UNITS = 12;
static_assert(L_ROWTAB + MAX_UNITS * 1024 <= LDS_BYTES, "LDS map");
constexpr int CW_BAR = 4096;

struct GroupedOrder : pg8::TileOrder {
    LAS const int* tiles; LAS const int* rowtab; LAS const int* pstart; int mode;
    __device__ __forceinline__ bool next(int i, pg8::Unit& u) const { int pm, pn; if (!tile(i, pm, pn)) return false; const int t = tiles[pm]; u.pm = pm; u.pn = pn; u.e = t & 255; u.r0 = (t >> 8) * 256; return true; }
    __device__ __forceinline__ int arow(int i, const pg8::Unit& u, int lr) const { return mode == 0 ? rowtab[i * 256 + lr] : pstart[u.e] + u.r0 + lr; }
};
__device__ __forceinline__ void grouped_prepare(GroupedOrder& S, LAS unsigned char* lds, const unsigned char* ws, int nN, int G, int c, int mode) {
    const int tid = threadIdx.x;
    LAS int* cnt = (LAS int*)(lds + L_CNT); LAS int* pstart = (LAS int*)(lds + L_PSTART); LAS int* tiles = (LAS int*)(lds + L_TILES); LAS int* rowtab = (LAS int*)(lds + L_ROWTAB); LAS int* pNT = (LAS int*)(lds + L_NT);
    const int* gcnt = (const int*)(ws + WS_CTL) + CW_CNT;
    if (tid < NE) cnt[tid] = __hip_atomic_load(gcnt + tid, __ATOMIC_RELAXED, __HIP_MEMORY_SCOPE_AGENT);
    __syncthreads();
    if (tid == 0) { int s = 0, nt = 0; for (int e = 0; e < NE; ++e) { pstart[e] = s; const int k = (cnt[e] + 255) >> 8; for (int j = 0; j < k; ++j) tiles[nt++] = e | (j << 8); s += k * 256; } pstart[NE] = s; *pNT = nt; }
    __syncthreads();
    S.init(*pNT, nN, G, c); S.tiles = tiles; S.rowtab = rowtab; S.pstart = pstart; S.mode = mode;
    const int* tokslot = (const int*)(ws + WS_TOKSLOT);
    for (int i = 0; i < MAX_UNITS; ++i) {
        pg8::Unit u; if (!S.next(i, u)) break;
        if (tid < 256) { const int rank = u.r0 + tid; int v; if (rank < cnt[u.e]) { const int sl = tokslot[u.e * CAP + rank]; v = mode == 0 ? (sl >> 2) : sl; } else v = mode == 0 ? 0 : -1; rowtab[i * 256 + tid] = v; }
    }
    __syncthreads();
}
struct EpiGateUp {
    static constexpr bool PERM = true;
    bf16_t* ACT; const float* bgu; LAS const int* pstart;
    __device__ __forceinline__ void operator()(const f32x4 (&acc)[2][2][4][2], const pg8::Unit& u, int, int wr, int wc, int fr, int fq) const {
        const int a0 = u.pn * 128 + wc * 32 + 8 * fq;
        const int prow0 = pstart[u.e] + u.r0 + wr * 64 + fr;
        f32x4 bb[4];
#pragma unroll
        for (int q = 0; q < 4; ++q) bb[q] = *(const f32x4*)(bgu + (size_t)u.e * 2 * FF + 2 * a0 + 4 * q);
#pragma unroll
        for (int ai = 0; ai < 2; ++ai)
#pragma unroll
            for (int m = 0; m < 4; ++m) {
                float o[8];
#pragma unroll
                for (int n = 0; n < 2; ++n)
#pragma unroll
                    for (int j = 0; j < 4; ++j) {
                        const int q = n * 4 + j;
                        float gate = acc[ai][0][m][n][j] + bb[q >> 1][(q & 1) * 2], lin = acc[ai][1][m][n][j] + bb[q >> 1][(q & 1) * 2 + 1];
                        gate = fminf(gate, 7.f); lin = fminf(fmaxf(lin, -7.f), 7.f);
                        const float glu = gate * __builtin_amdgcn_rcpf(1.f + __expf(-1.702f * gate));
                        o[q] = (lin + 1.f) * glu;
                    }
                if constexpr (DN_F8) {
                    int w0 = __builtin_amdgcn_cvt_pk_fp8_f32(o[0] * ASCALE, o[1] * ASCALE, 0, false); w0 = __builtin_amdgcn_cvt_pk_fp8_f32(o[2] * ASCALE, o[3] * ASCALE, w0, true);
                    int w1 = __builtin_amdgcn_cvt_pk_fp8_f32(o[4] * ASCALE, o[5] * ASCALE, 0, false); w1 = __builtin_amdgcn_cvt_pk_fp8_f32(o[6] * ASCALE, o[7] * ASCALE, w1, true);
                    u32x2 w; w.x = (unsigned)w0; w.y = (unsigned)w1;
                    *(u32x2*)((unsigned char*)ACT + (size_t)(prow0 + ai * 128 + m * 16) * FF + a0) = w;
                } else {
                    u32x4 w; w.x = pg8::cvt_pk_bf16(o[0], o[1]); w.y = pg8::cvt_pk_bf16(o[2], o[3]); w.z = pg8::cvt_pk_bf16(o[4], o[5]); w.w = pg8::cvt_pk_bf16(o[6], o[7]);
                    *(u32x4*)(ACT + (size_t)(prow0 + ai * 128 + m * 16) * FF + a0) = w;
                }
            }
    }
};
struct EpiDown {
    static constexpr bool PERM = true;
    bf16_t* Y; const float* bd; LAS const int* rowtab;
    __device__ __forceinline__ void operator()(const f32x4 (&acc)[2][2][4][2], const pg8::Unit& u, int ui, int wr, int wc, int fr, int fq) const {
        const int col0 = u.pn * 256 + wc * 32 + 8 * fq;
        f32x4 bv[2][2];
#pragma unroll
        for (int bj = 0; bj < 2; ++bj)
#pragma unroll
            for (int n = 0; n < 2; ++n) bv[bj][n] = *(const f32x4*)(bd + (size_t)u.e * D_ + col0 + bj * 128 + 4 * n);
#pragma unroll
        for (int ai = 0; ai < 2; ++ai)
#pragma unroll
            for (int m = 0; m < 4; ++m) {
                const int slot = rowtab[ui * 256 + ai * 128 + wr * 64 + m * 16 + fr];
                if (slot >= 0) {
#pragma unroll
                    for (int bj = 0; bj < 2; ++bj) { const f32x4 v0 = acc[ai][bj][m][0] + bv[bj][0], v1 = acc[ai][bj][m][1] + bv[bj][1];
                        u32x4 w; w.x = pg8::cvt_pk_bf16(v0[0], v0[1]); w.y = pg8::cvt_pk_bf16(v0[2], v0[3]); w.z = pg8::cvt_pk_bf16(v1[0], v1[1]); w.w = pg8::cvt_pk_bf16(v1[2], v1[3]);
                        *(u32x4*)(Y + (size_t)slot * D_ + col0 + bj * 128) = w; }
                }
            }
    }
};


#define XB_TMO      128
#define XB_XCNT(j)  (256  + 64 * (j))
#define XB_XSUB(j)  (1280 + 64 * (j))
#define XB_XGEN(j)  (2304 + 64 * (j))
#define XB_TOP      3328
#define XB_TOPGEN   3392
#define XCD_BAR_WORDS 3456
#define XB_SPIN_CAP (1u << 18)
__device__ __forceinline__ unsigned xb_ld(unsigned* p)              { return __hip_atomic_load(p, __ATOMIC_RELAXED, __HIP_MEMORY_SCOPE_AGENT); }
__device__ __forceinline__ unsigned xb_add(unsigned* p, unsigned v) { return __hip_atomic_fetch_add(p, v, __ATOMIC_RELAXED, __HIP_MEMORY_SCOPE_AGENT); }
__device__ __forceinline__ unsigned xb_xcc_id() { return (unsigned)__builtin_amdgcn_s_getreg((3 << 11) | 20) & 0xFu; }
#define XB_SPIN(cond, bar) do { unsigned _sp = 0; while (cond) { __builtin_amdgcn_s_sleep(1); \
    if ((++_sp & 255u) == 0u) { if (xb_ld(&(bar)[XB_TMO])) break; if (_sp > XB_SPIN_CAP) { atomicAdd(&(bar)[XB_TMO], 1u); break; } } } } while (0)
struct XcdBarrier { unsigned* bar; unsigned x; volatile LAS unsigned* st; };
__device__ __forceinline__ XcdBarrier xcd_barrier_post(unsigned* bar, volatile LAS unsigned* st) {
    XcdBarrier b; b.bar = bar; b.x = xb_xcc_id(); b.st = st;
    if (threadIdx.x == 0) (void)xb_add(&bar[XB_XCNT(b.x)], 1u);
    return b;
}
__device__ __forceinline__ void xcd_barrier_complete(unsigned* bar, unsigned x, unsigned& nloc, unsigned& nx) {
    const unsigned G = gridDim.x * gridDim.y * gridDim.z;
    unsigned sum, cnt, mine, sp = 0u;
    for (;;) {
        sum = 0u; cnt = 0u; mine = 0u;
#pragma unroll
        for (unsigned j = 0; j < 16; ++j) { const unsigned c = xb_ld(&bar[XB_XCNT(j)]); sum += c; cnt += (c > 0u) ? 1u : 0u; mine = (j == x) ? c : mine; }
        if (sum == G) break;
        __builtin_amdgcn_s_sleep(1);
        if ((++sp & 255u) == 0u) { if (xb_ld(&bar[XB_TMO])) break; if (sp > XB_SPIN_CAP) { atomicAdd(&bar[XB_TMO], 1u); break; } }
    }
    nloc = mine > 0u ? mine : 1u; nx = cnt > 0u ? cnt : 1u;
}
__device__ __forceinline__ void xcd_barrier(const XcdBarrier& b) {
    asm volatile("s_waitcnt vmcnt(0)" ::: "memory");
    __syncthreads();
    if (threadIdx.x == 0) {
        unsigned* bar = b.bar;
        __builtin_amdgcn_s_waitcnt(0);
        unsigned nloc = b.st[0], nx = b.st[1];
        if (nloc == 0u) { xcd_barrier_complete(bar, b.x, nloc, nx); b.st[0] = nloc; b.st[1] = nx; }
        const unsigned old = xb_add(&bar[XB_XSUB(b.x)], 1u);
        const unsigned gen = old / nloc;
        if (old + 1u == (gen + 1u) * nloc) {
            __builtin_amdgcn_fence(__ATOMIC_RELEASE, "agent");
            asm volatile("s_waitcnt vmcnt(0)" ::: "memory");
            const unsigned og = xb_add(&bar[XB_TOP], 1u);
            const unsigned tg = og / nx;
            if (og + 1u == (tg + 1u) * nx) xb_add(&bar[XB_TOPGEN], 1u);
            else XB_SPIN(xb_ld(&bar[XB_TOPGEN]) == tg, bar);
            __builtin_amdgcn_fence(__ATOMIC_ACQUIRE, "agent");
            xb_add(&bar[XB_XGEN(b.x)], 1u);
            asm volatile("s_waitcnt vmcnt(0)" ::: "memory");
        } else {
            XB_SPIN(xb_ld(&bar[XB_XGEN(b.x)]) == gen, bar);
            __builtin_amdgcn_fence(__ATOMIC_ACQUIRE, "agent");
            asm volatile("s_waitcnt vmcnt(0)" ::: "memory");
        }
    }
    __syncthreads();
}

constexpr int TS = 136;
__device__ __forceinline__ void unpack8(const u32x4 w, float (&o)[16], int base) {
#pragma unroll
    for (int m = 0; m < 4; ++m) { o[base + 2 * m] = bf2f(w[m] & 0xffffu); o[base + 2 * m + 1] = bf2f(w[m] >> 16); }
}
__device__ __forceinline__ void load_krot(const bf16_t* PROJ, const float* rope, int t, int pos, int h, int q, float (&o1)[16], float (&o2)[16]) {
    const bf16_t* kp = PROJ + (size_t)t * INC + 1024 + h * 128 + 16 * q;
    float k1[16], k2[16];
    unpack8(*(const u32x4*)kp, k1, 0); unpack8(*(const u32x4*)(kp + 8), k1, 8); unpack8(*(const u32x4*)(kp + 64), k2, 0); unpack8(*(const u32x4*)(kp + 72), k2, 8);
    const float* cp = rope + pos * 64 + 16 * q; const float* sp = cp + SEQ * 64;
    const float sc = 0.08838834764831845f;
#pragma unroll
    for (int i4 = 0; i4 < 4; ++i4) {
        const f32x4 c = *(const f32x4*)(cp + 4 * i4), s = *(const f32x4*)(sp + 4 * i4);
#pragma unroll
        for (int r = 0; r < 4; ++r) { const int i = 4 * i4 + r; o1[i] = (k1[i] * c[r] - k2[i] * s[r]) * sc; o2[i] = (k2[i] * c[r] + k1[i] * s[r]) * sc; }
    }
}
__device__ __forceinline__ void load_v32(const bf16_t* PROJ, int t, int h, int q, unsigned short (&v)[32]) {
    const bf16_t* vp = PROJ + (size_t)t * INC + 1536 + h * 128 + 32 * q;
#pragma unroll
    for (int c = 0; c < 4; ++c) { const u32x4 w = *(const u32x4*)(vp + 8 * c);
#pragma unroll
        for (int m = 0; m < 4; ++m) { v[8 * c + 2 * m] = (unsigned short)(w[m] & 0xffffu); v[8 * c + 2 * m + 1] = (unsigned short)(w[m] >> 16); } }
}

template <int W>
__device__ __forceinline__ void pool_fill(const bf16_t* PROJ, LAS bf16_t* P, int t0, int pos0, int g, int tid) {
    const int cp = tid & 63, seg = tid >> 6;
    const int tb = t0 + 16 * seg, pb = pos0 + 16 * seg;
    float v0[15 + W], v1[15 + W];
#pragma unroll
    for (int idx = 0; idx < 15 + W; ++idx) {
        const int dp = idx - (W - 1);
        unsigned u = 0u;
        if (pb + dp >= 0) u = *(const unsigned*)(PROJ + (size_t)(tb + dp) * INC + g * 128 + 2 * cp);
        v0[idx] = bf2f(u & 0xffffu); v1[idx] = bf2f(u >> 16);
    }
#pragma unroll
    for (int k = 0; k < 16; ++k) {
        float s0 = 0.f, s1 = 0.f;
#pragma unroll
        for (int q = 0; q < W; ++q) { s0 += v0[k + q]; s1 += v1[k + q]; }
        const int pos = pb + k; const float inv = 1.f / (float)((pos + 1 < W) ? pos + 1 : W);
        *(LAS unsigned*)(P + (16 * seg + k) * TS + 2 * cp) = pk2(s0 * inv - v0[k + W - 1], s1 * inv - v1[k + W - 1]);
    }
}
__device__ __forceinline__ void pool_unit(const Args& a, LAS unsigned char* lds, int u) {
    const int tid = threadIdx.x, lane = tid & 63, wave = __builtin_amdgcn_readfirstlane(tid >> 6), fr = lane & 15, fq = lane >> 4;
    const int chunk = u >> 2, g = u & 3, t0 = chunk * 128, pos0 = t0 % SEQ;
    const bf16_t* PROJ = (const bf16_t*)(a.ws + WS_PROJ); const bf16_t* PWT = (const bf16_t*)(a.ws + WS_POOLWT); bf16_t* MIXIN = (bf16_t*)(a.ws + WS_MIXIN);
    LAS bf16_t* P = (LAS bf16_t*)lds;
    if (g == 0) pool_fill<2>(PROJ, P, t0, pos0, g, tid); else if (g == 1) pool_fill<4>(PROJ, P, t0, pos0, g, tid); else if (g == 2) pool_fill<8>(PROJ, P, t0, pos0, g, tid); else pool_fill<16>(PROJ, P, t0, pos0, g, tid);
    __syncthreads();
    f32x4 acc[8];
#pragma unroll
    for (int nt = 0; nt < 8; ++nt) acc[nt] = (f32x4){0.f, 0.f, 0.f, 0.f};
#pragma unroll
    for (int ks = 0; ks < 4; ++ks) {
        const bf16x8 af = *(const LAS bf16x8*)(P + (16 * wave + fr) * TS + 32 * ks + 8 * fq);
#pragma unroll
        for (int nt = 0; nt < 8; ++nt) { const bf16x8 bf = *(const bf16x8*)(PWT + (size_t)(g * 128 + 16 * nt + fr) * 128 + 32 * ks + 8 * fq); acc[nt] = MFMA16(bf, af, acc[nt]); }
    }
    const int t = t0 + 16 * wave + fr;
#pragma unroll
    for (int nt = 0; nt < 8; ++nt) {
        const int ch = g * 128 + 16 * nt + 4 * fq;
        const f32x4 pb = *(const f32x4*)(a.in[7] + ch), ps = *(const f32x4*)(a.in[8] + ch);
        const f32x4 o = (acc[nt] + pb) * ps;
        u32x2 w; w.x = pk2(o[0], o[1]); w.y = pk2(o[2], o[3]);
        *(u32x2*)(MIXIN + (size_t)t * D_ + ch) = w;
    }
    __syncthreads();
}
__device__ __forceinline__ void kv_unit(const Args& a, LAS unsigned char* lds, int u) {
    const int tid = threadIdx.x, lane = tid & 63, wave = __builtin_amdgcn_readfirstlane(tid >> 6), fr = lane & 15, fq = lane >> 4;
    const int bh = u / 15, n = u % 15, b = bh >> 2, h = bh & 3, t0 = b * SEQ + n * 128, pos0 = n * 128;
    const bf16_t* PROJ = (const bf16_t*)(a.ws + WS_PROJ); const float* rope = (const float*)(a.ws + WS_ROPE); float* KVT = (float*)(a.ws + WS_KVT);
    LAS bf16_t* Kt = (LAS bf16_t*)lds; LAS bf16_t* Vt = Kt + 128 * TS;
    const float l2g = log2_gamma(h);
    {
        const int j = tid >> 2, q = tid & 3;
        float o1[16], o2[16]; load_krot(PROJ, rope, t0 + j, pos0 + j, h, q, o1, o2);
        const float kd = exp2f((float)(127 - j) * l2g);
#pragma unroll
        for (int i = 0; i < 16; ++i) { Kt[(16 * q + i) * TS + j] = (bf16_t)f2bf(o1[i] * kd); Kt[(64 + 16 * q + i) * TS + j] = (bf16_t)f2bf(o2[i] * kd); }
        unsigned short v[32]; load_v32(PROJ, t0 + j, h, q, v);
#pragma unroll
        for (int i = 0; i < 32; ++i) Vt[(32 * q + i) * TS + j] = v[i];
    }
    __syncthreads();
    f32x4 acc[8];
#pragma unroll
    for (int dt = 0; dt < 8; ++dt) acc[dt] = (f32x4){0.f, 0.f, 0.f, 0.f};
#pragma unroll
    for (int ks = 0; ks < 4; ++ks) {
        const bf16x8 vf = *(const LAS bf16x8*)(Vt + (16 * wave + fr) * TS + 32 * ks + 8 * fq);
#pragma unroll
        for (int dt = 0; dt < 8; ++dt) { const bf16x8 kf = *(const LAS bf16x8*)(Kt + (16 * dt + fr) * TS + 32 * ks + 8 * fq); acc[dt] = MFMA16(kf, vf, acc[dt]); }
    }
    float* op = KVT + ((size_t)(bh * 15 + n) << 14) + (size_t)(16 * wave + fr) * 128 + 4 * fq;
#pragma unroll
    for (int dt = 0; dt < 8; ++dt) *(f32x4*)(op + 16 * dt) = acc[dt];
    __syncthreads();
}
__device__ __forceinline__ void phase_scan(const Args& a, int vb, int G) {
    const float* KVT = (const float*)(a.ws + WS_KVT); bf16_t* RT = (bf16_t*)(a.ws + WS_RT);
    for (int i = vb * 512 + threadIdx.x; i < 32 * 4096; i += G * 512) {
        const int bh = i >> 12, ed = (i & 4095) * 4, h = bh & 3;
        const float cd = exp2f(128.f * log2_gamma(h)); f32x4 R = (f32x4){0.f, 0.f, 0.f, 0.f};
        f32x4 kv[15];
#pragma unroll
        for (int n = 0; n < 15; ++n) kv[n] = *(const f32x4*)(KVT + ((size_t)(bh * 15 + n) << 14) + ed);
#pragma unroll
        for (int n = 0; n < 16; ++n) {
            u32x2 w; w.x = pk2(R[0], R[1]); w.y = pk2(R[2], R[3]);
            *(u32x2*)(RT + ((size_t)(bh * 16 + n) << 14) + ed) = w;
            if (n < 15) R = R * cd + kv[n];
        }
    }
}
__device__ __forceinline__ bf16x8 pack8(const float (&v)[8]) {
    u32x4 w; w.x = pk2(v[0], v[1]); w.y = pk2(v[2], v[3]); w.z = pk2(v[4], v[5]); w.w = pk2(v[6], v[7]);
    return __builtin_bit_cast(bf16x8, w);
}
__device__ __forceinline__ void ret_unit(const Args& a, LAS unsigned char* lds, int u) {
    const int tid = threadIdx.x, lane = tid & 63, wave = __builtin_amdgcn_readfirstlane(tid >> 6), fr = lane & 15, fq = lane >> 4;
    const int bh = u >> 4, n = u & 15, b = bh >> 2, h = bh & 3, t0 = b * SEQ + n * 128, pos0 = n * 128;
    const bf16_t* PROJ = (const bf16_t*)(a.ws + WS_PROJ); const float* rope = (const float*)(a.ws + WS_ROPE); const bf16_t* RT = (const bf16_t*)(a.ws + WS_RT); bf16_t* MIXIN = (bf16_t*)(a.ws + WS_MIXIN);
    LAS bf16_t* Kn = (LAS bf16_t*)lds; LAS bf16_t* Vt = Kn + 128 * TS;
    const float l2g = log2_gamma(h);
    {
        const int j = tid >> 2, q = tid & 3;
        float o1[16], o2[16]; load_krot(PROJ, rope, t0 + j, pos0 + j, h, q, o1, o2);
        u32x4 w;
        w.x = pk2(o1[0], o1[1]); w.y = pk2(o1[2], o1[3]); w.z = pk2(o1[4], o1[5]); w.w = pk2(o1[6], o1[7]); *(LAS u32x4*)(Kn + j * TS + 16 * q) = w;
        w.x = pk2(o1[8], o1[9]); w.y = pk2(o1[10], o1[11]); w.z = pk2(o1[12], o1[13]); w.w = pk2(o1[14], o1[15]); *(LAS u32x4*)(Kn + j * TS + 16 * q + 8) = w;
        w.x = pk2(o2[0], o2[1]); w.y = pk2(o2[2], o2[3]); w.z = pk2(o2[4], o2[5]); w.w = pk2(o2[6], o2[7]); *(LAS u32x4*)(Kn + j * TS + 64 + 16 * q) = w;
        w.x = pk2(o2[8], o2[9]); w.y = pk2(o2[10], o2[11]); w.z = pk2(o2[12], o2[13]); w.w = pk2(o2[14], o2[15]); *(LAS u32x4*)(Kn + j * TS + 64 + 16 * q + 8) = w;
        unsigned short v[32]; load_v32(PROJ, t0 + j, h, q, v);
#pragma unroll
        for (int i = 0; i < 32; ++i) Vt[(32 * q + i) * TS + j] = v[i];
    }
    __syncthreads();
    const int il = 16 * wave + fr, t = t0 + il, pos = pos0 + il;
    bf16x8 qf[4];
    {
        const bf16_t* qp = PROJ + (size_t)t * INC + 512 + h * 128 + 8 * fq;
        float qa[16], qb[16];
        unpack8(*(const u32x4*)(qp), qa, 0); unpack8(*(const u32x4*)(qp + 32), qa, 8); unpack8(*(const u32x4*)(qp + 64), qb, 0); unpack8(*(const u32x4*)(qp + 96), qb, 8);
#pragma unroll
        for (int ks = 0; ks < 2; ++ks) {
            const float* cp = rope + pos * 64 + 32 * ks + 8 * fq; const float* sp = cp + SEQ * 64;
            float y1[8], y2[8];
#pragma unroll
            for (int i4 = 0; i4 < 2; ++i4) { const f32x4 c = *(const f32x4*)(cp + 4 * i4), s = *(const f32x4*)(sp + 4 * i4);
#pragma unroll
                for (int r = 0; r < 4; ++r) { const int i = 4 * i4 + r; const float x1 = qa[8 * ks + i], x2 = qb[8 * ks + i]; y1[i] = x1 * c[r] - x2 * s[r]; y2[i] = x2 * c[r] + x1 * s[r]; } }
            qf[ks] = pack8(y1); qf[ks + 2] = pack8(y2);
        }
    }
    f32x4 acc[8];
#pragma unroll
    for (int et = 0; et < 8; ++et) acc[et] = (f32x4){0.f, 0.f, 0.f, 0.f};
    if (n > 0) {
        const bf16_t* rp = RT + ((size_t)(bh * 16 + n) << 14) + fr * 128 + 8 * fq;
#pragma unroll
        for (int ks = 0; ks < 4; ++ks)
#pragma unroll
            for (int et = 0; et < 8; ++et) acc[et] = MFMA16(*(const bf16x8*)(rp + et * 16 * 128 + 32 * ks), qf[ks], acc[et]);
        const float qd = exp2f((float)(il + 1) * l2g);
#pragma unroll
        for (int et = 0; et < 8; ++et) acc[et] *= qd;
    }
#pragma unroll
    for (int ks2 = 0; ks2 < 4; ++ks2) {
        if (2 * ks2 <= wave) {
            float sv[8];
#pragma unroll
            for (int tt = 0; tt < 2; ++tt) {
                const int jt = 2 * ks2 + tt;
                f32x4 sacc = (f32x4){0.f, 0.f, 0.f, 0.f};
                if (jt <= wave) {
#pragma unroll
                    for (int ks = 0; ks < 4; ++ks) sacc = MFMA16(*(const LAS bf16x8*)(Kn + (16 * jt + fr) * TS + 32 * ks + 8 * fq), qf[ks], sacc);
                }
#pragma unroll
                for (int r = 0; r < 4; ++r) { const int diff = il - (16 * jt + 4 * fq + r); sv[4 * tt + r] = (diff >= 0) ? sacc[r] * exp2f((float)diff * l2g) : 0.f; }
            }
            const bf16x8 sf = pack8(sv);
#pragma unroll
            for (int et = 0; et < 8; ++et) {
                const LAS bf16_t* vp = Vt + (16 * et + fr) * TS + 32 * ks2 + 4 * fq;
                const u32x2 lo = *(const LAS u32x2*)vp, hi = *(const LAS u32x2*)(vp + 16);
                u32x4 vw; vw.x = lo.x; vw.y = lo.y; vw.z = hi.x; vw.w = hi.y;
                acc[et] = MFMA16(__builtin_bit_cast(bf16x8, vw), sf, acc[et]);
            }
        }
    }
    float sm = 0.f;
#pragma unroll
    for (int et = 0; et < 8; ++et) sm += (acc[et][0] + acc[et][1]) + (acc[et][2] + acc[et][3]);
    sm += __shfl_xor(sm, 16); sm += __shfl_xor(sm, 32);
    const float mu = sm * (1.f / 128.f);
    float sq = 0.f;
#pragma unroll
    for (int et = 0; et < 8; ++et) { const f32x4 d = acc[et] - mu; sq += (d[0] * d[0] + d[1] * d[1]) + (d[2] * d[2] + d[3] * d[3]); }
    sq += __shfl_xor(sq, 16); sq += __shfl_xor(sq, 32);
    const float rs = 1.f / sqrtf(sq * (1.f / 128.f) + EPS);
#pragma unroll
    for (int et = 0; et < 8; ++et) {
        const int c = h * 128 + 16 * et + 4 * fq;
        const u32x2 gw = *(const u32x2*)(PROJ + (size_t)t * INC + 2048 + c);
        const f32x4 gn = *(const f32x4*)(a.in[9] + c);
        const float g0 = bf2f(gw.x & 0xffffu), g1 = bf2f(gw.x >> 16), g2 = bf2f(gw.y & 0xffffu), g3 = bf2f(gw.y >> 16);
        const f32x4 d = (acc[et] - mu) * rs * gn;
        u32x2 w; w.x = pk2(silu_f(g0) * d[0], silu_f(g1) * d[1]); w.y = pk2(silu_f(g2) * d[2], silu_f(g3) * d[3]);
        *(u32x2*)(MIXIN + (size_t)t * D_ + 512 + c) = w;
    }
    __syncthreads();
}

constexpr int HST = 1026;
constexpr int R_H = 0, R_PART = 65792, R_LOGIT = R_PART + 16384, R_PE = R_LOGIT + 2048, R_PW = R_PE + 1024, R_PL = R_PW + 1024, R_HIST = R_PL + 1024, R_BASE = R_HIST + 128;
static_assert(16 * HST * 4 <= R_PART && R_BASE + 128 <= RING_BYTES, "router LDS map");
__device__ __forceinline__ void phase_router(const Args& a, LAS unsigned char* lds, int vb, int G) {
    const int tid = threadIdx.x, lane = tid & 63, wave = __builtin_amdgcn_readfirstlane(tid >> 6), fr = lane & 15, fq = lane >> 4;
    unsigned char* ws = a.ws;
    const float* X1 = (const float*)(ws + WS_X1); const float* mod = (const float*)(ws + WS_MOD); bf16_t* HN = (bf16_t*)(ws + WS_HN);
    LAS float* H = (LAS float*)(lds + R_H); LAS float* part = (LAS float*)(lds + R_PART); LAS float* logit = (LAS float*)(lds + R_LOGIT);
    LAS int* pe = (LAS int*)(lds + R_PE); LAS float* pw = (LAS float*)(lds + R_PW); LAS int* pl = (LAS int*)(lds + R_PL); LAS int* hist = (LAS int*)(lds + R_HIST); LAS int* base = (LAS int*)(lds + R_BASE);
    const int RPB = T_ / G, row0 = vb * RPB, b = row0 / SEQ;
    float wreg[32][2];
#pragma unroll
    for (int kk = 0; kk < 32; ++kk)
#pragma unroll
        for (int nt = 0; nt < 2; ++nt) wreg[kk][nt] = a.in[12][(size_t)(128 * wave + 4 * kk + fq) * NE + 16 * nt + fr];
    if (tid < NE) hist[tid] = 0;
    const float* sh = mod + b * NMOD + 3 * D_; const float* sc = mod + b * NMOD + 4 * D_;
    for (int sub = 0; sub < RPB / 16; ++sub) {
#pragma unroll
        for (int rr = 0; rr < 2; ++rr) {
            const int lr = 2 * wave + rr, r = row0 + sub * 16 + lr;
            const f32x4* xr = (const f32x4*)(X1 + (size_t)r * D_) + lane;
            f32x4 v[4]; float ss = 0.f;
#pragma unroll
            for (int j = 0; j < 4; ++j) { v[j] = xr[64 * j]; ss += (v[j].x * v[j].x + v[j].y * v[j].y) + (v[j].z * v[j].z + v[j].w * v[j].w); }
            const float rs = 1.f / sqrtf(wave_sum(ss) * (1.f / D_) + EPS);
#pragma unroll
            for (int j = 0; j < 4; ++j) {
                const int c0 = 4 * lane + 256 * j;
                const f32x4 g = *(const f32x4*)(a.in[11] + c0), s1 = *(const f32x4*)(sc + c0), s0 = *(const f32x4*)(sh + c0);
                const f32x4 hv = v[j] * rs * g * (1.f + s1) + s0;
                if constexpr (GU_F8) { int w8 = __builtin_amdgcn_cvt_pk_fp8_f32(hv[0], hv[1], 0, false); w8 = __builtin_amdgcn_cvt_pk_fp8_f32(hv[2], hv[3], w8, true); *(int*)((unsigned char*)HN + (size_t)r * D_ + c0) = w8; }
                else *(unsigned long long*)(HN + (size_t)r * D_ + c0) = (unsigned long long)pk2(hv[0], hv[1]) | ((unsigned long long)pk2(hv[2], hv[3]) << 32);
                LAS float* hp = H + lr * HST + c0; hp[0] = hv[0]; hp[1] = hv[1]; hp[2] = hv[2]; hp[3] = hv[3];
            }
        }
        __syncthreads();
        f32x4 lacc[2] = {(f32x4){0.f, 0.f, 0.f, 0.f}, (f32x4){0.f, 0.f, 0.f, 0.f}};
#pragma unroll
        for (int kk = 0; kk < 32; ++kk) {
            const float av = H[fr * HST + 128 * wave + 4 * kk + fq];
            lacc[0] = __builtin_amdgcn_mfma_f32_16x16x4f32(av, wreg[kk][0], lacc[0], 0, 0, 0);
            lacc[1] = __builtin_amdgcn_mfma_f32_16x16x4f32(av, wreg[kk][1], lacc[1], 0, 0, 0);
        }
#pragma unroll
        for (int nt = 0; nt < 2; ++nt)
#pragma unroll
            for (int r = 0; r < 4; ++r) part[(wave * 16 + 4 * fq + r) * 32 + 16 * nt + fr] = lacc[nt][r];
        __syncthreads();
        {
            const int tk = tid >> 5, e = tid & 31; float s = a.in[13][e];
#pragma unroll
            for (int w = 0; w < 8; ++w) s += part[(w * 16 + tk) * 32 + e];
            logit[tk * 32 + e] = s;
        }
        __syncthreads();
        if (tid < 16) {
            float v[NE];
#pragma unroll
            for (int e = 0; e < NE; ++e) v[e] = logit[tid * 32 + e];
            float tv[4]; int ti[4];
#pragma unroll
            for (int k = 0; k < 4; ++k) {
                float best = -INFINITY; int bi = 0;
#pragma unroll
                for (int e = 0; e < NE; ++e) if (v[e] > best) { best = v[e]; bi = e; }
                tv[k] = best; ti[k] = bi;
#pragma unroll
                for (int e = 0; e < NE; ++e) if (e == bi) v[e] = -INFINITY;
            }
            float ex[4], se = 0.f;
#pragma unroll
            for (int k = 0; k < 4; ++k) { ex[k] = __expf(tv[k] - tv[0]); se += ex[k]; }
            const float inv = 1.f / se;
#pragma unroll
            for (int k = 0; k < 4; ++k) { const int pi = (sub * 16 + tid) * 4 + k; pe[pi] = ti[k]; pw[pi] = ex[k] * inv; }
        }
        __syncthreads();
    }
    const int npair = RPB * 4;
    if (tid < npair) pl[tid] = atomicAdd((int*)(hist + pe[tid]), 1);
    __syncthreads();
    if (tid < NE) base[tid] = (int)__hip_atomic_fetch_add((int*)(ws + WS_CTL) + CW_CNT + tid, hist[tid], __ATOMIC_RELAXED, __HIP_MEMORY_SCOPE_AGENT);
    __syncthreads();
    if (tid < npair) {
        const int e = pe[tid], slot = row0 * 4 + tid;
        ((int*)(ws + WS_TOKSLOT))[e * CAP + base[e] + pl[tid]] = slot;
        ((float*)(ws + WS_WSLOT))[slot] = pw[tid];
    }
    __syncthreads();
}
__device__ __forceinline__ void phase_final(const Args& a, int vb, int G) {
    const int tid = threadIdx.x, lane = tid & 63, wave = tid >> 6;
    const float* X1 = (const float*)(a.ws + WS_X1); const bf16_t* Y = (const bf16_t*)(a.ws + WS_Y); const float* wslot = (const float*)(a.ws + WS_WSLOT); const float* mod = (const float*)(a.ws + WS_MOD);
    for (int r = vb * NWAVES + wave; r < T_; r += G * NWAVES) {
        const int b = r / SEQ; const float* gt2 = mod + b * NMOD + 5 * D_;
        float w[4];
#pragma unroll
        for (int k = 0; k < 4; ++k) w[k] = wslot[r * 4 + k];
        f32x4 v[4]; float ss = 0.f;
#pragma unroll
        for (int j = 0; j < 4; ++j) {
            const int c0 = 4 * lane + 256 * j;
            f32x4 f = (f32x4){0.f, 0.f, 0.f, 0.f};
#pragma unroll
            for (int k = 0; k < 4; ++k) {
                const u32x2 y = *(const u32x2*)(Y + (size_t)(r * 4 + k) * D_ + c0);
                f.x += w[k] * bf2f(y.x & 0xffffu); f.y += w[k] * bf2f(y.x >> 16); f.z += w[k] * bf2f(y.y & 0xffffu); f.w += w[k] * bf2f(y.y >> 16);
            }
            const f32x4 x1 = *(const f32x4*)(X1 + (size_t)r * D_ + c0); const f32x4 g = *(const f32x4*)(gt2 + c0);
            v[j] = x1 + g * f;
            ss += (v[j].x * v[j].x + v[j].y * v[j].y) + (v[j].z * v[j].z + v[j].w * v[j].w);
        }
        const float rs = 1.f / sqrtf(wave_sum(ss) * (1.f / D_) + EPS);
#pragma unroll
        for (int j = 0; j < 4; ++j) { const int c0 = 4 * lane + 256 * j; const f32x4 g = *(const f32x4*)(a.in[18] + c0); *(f32x4*)(a.out + (size_t)r * D_ + c0) = v[j] * rs * g; }
    }
}

__global__ void __launch_bounds__(512, 2) mega(Args a) {
    extern __shared__ __attribute__((aligned(16))) unsigned char lds_raw[];
    LAS unsigned char* lds = (LAS unsigned char*)lds_raw;
    const int G = gridDim.x, bx = blockIdx.x;
    const int vb = (G % 8 == 0) ? (bx % 8) * (G / 8) + bx / 8 : bx;
    unsigned char* ws = a.ws;
    for (int u = threadIdx.x; u < (LDS_BYTES - LDSCTL_OFF) / 4; u += 512) ((LAS unsigned*)(lds + LDSCTL_OFF))[u] = 0u;
    __syncthreads();
    const bool multi = (a.ph_hi - a.ph_lo) > 1;
    XcdBarrier bar; bar.bar = (unsigned*)(ws + WS_CTL) + CW_BAR; bar.x = 0; bar.st = nullptr;
    if (multi) bar = xcd_barrier_post((unsigned*)(ws + WS_CTL) + CW_BAR, (volatile LAS unsigned*)(lds + L_MISC) + 8);
#define SEAM(k) do { if (IN(k) && IN((k) + 1)) xcd_barrier(bar); } while (0)
#define IN(k) (a.ph_lo <= (k) && (k) < a.ph_hi)
    if (IN(0)) phase_p0(a, lds, vb, G);
    SEAM(0);
    if (IN(1)) phase_p1(a, lds, vb, G);
    SEAM(1);
    if (IN(2)) {
        pg8::Gemm g{(const bf16_t*)(ws + WS_XN), (const bf16_t*)(ws + WS_WINT), INC, D_, 0, 127, 127};
        pg8::DenseOrder S; S.init(T_ / 256, INC / 256, G, bx);
        pg8::EpiProj E{(bf16_t*)(ws + WS_PROJ)};
        pg8::gemm_phase<pg8::EpiProj, pg8::DenseOrder, true>(lds, g, S, E);
    }
    SEAM(2);
    if (IN(3)) { for (int L = vb; L < 512 + 480; L += G) { if (L < 512) pool_unit(a, lds, L); else kv_unit(a, lds, L - 512); } }
    SEAM(3);
    if (IN(4)) phase_scan(a, vb, G);
    SEAM(4);
    if (IN(5)) { for (int L = vb; L < 512; L += G) ret_unit(a, lds, L); }
    SEAM(5);
    if (IN(6)) {
        pg8::Gemm g{(const bf16_t*)(ws + WS_MIXIN), (const bf16_t*)(ws + WS_WOUTT), D_, D_, 0, 127, 127};
        pg8::DenseOrder S; S.init(T_ / 256, D_ / 256, G, bx);
        pg8::EpiX1 E{a.in[0], (const float*)(ws + WS_MOD), (float*)(ws + WS_X1)};
        pg8::gemm_phase<pg8::EpiX1, pg8::DenseOrder, true>(lds, g, S, E);
    }
    SEAM(6);
    if (IN(7)) phase_router(a, lds, vb, G);
    SEAM(7);
    if (IN(8)) {
        GroupedOrder S; grouped_prepare(S, lds, ws, 2 * FF / 256, G, bx, 0);
        pg8::Gemm g{(const bf16_t*)(ws + WS_HN), (const bf16_t*)(ws + WS_WGUT), 2 * FF, D_, (size_t)2 * FF * D_ * (GU_F8 ? 1 : 2), SCALE_W, SCALE_ONE};
        EpiGateUp E{(bf16_t*)(ws + WS_ACT), a.in[15], (LAS const int*)(lds + L_PSTART)};
        pg8::gemm_phase<EpiGateUp, GroupedOrder, true, GU_F8>(lds, g, S, E);
    }
    SEAM(8);
    if (IN(9)) {
        GroupedOrder S; grouped_prepare(S, lds, ws, D_ / 256, G, bx, 1);
        pg8::Gemm g{(const bf16_t*)(ws + WS_ACT), (const bf16_t*)(ws + WS_WDT), D_, FF, (size_t)D_ * FF * (DN_F8 ? 1 : 2), SCALE_W, SCALE_ACT};
        EpiDown E{(bf16_t*)(ws + WS_Y), a.in[17], (LAS const int*)(lds + L_ROWTAB)};
        pg8::gemm_phase<EpiDown, GroupedOrder, true, DN_F8>(lds, g, S, E);
    }
    SEAM(9);
    if (IN(10)) phase_final(a, vb, G);
#undef SEAM
#undef IN
}


template <class Epi>
__global__ void __launch_bounds__(256) k_sgemm(const bf16_t* A, const bf16_t* Bt, Epi epi) {
    const int K = epi.K;
    const int wave = threadIdx.x >> 6, lane = threadIdx.x & 63, fr = lane & 15, fq = lane >> 4;
    const int row0 = blockIdx.y * 64 + wave * 16, col0 = blockIdx.x * 64;
    f32x4 acc[4];
#pragma unroll
    for (int n = 0; n < 4; ++n) acc[n] = (f32x4){0.f, 0.f, 0.f, 0.f};
    const bf16_t* ap = A + (size_t)(row0 + fr) * K + fq * 8;
    const bf16_t* bp = Bt + (size_t)(col0 + fr) * K + fq * 8;
    for (int k0 = 0; k0 < K; k0 += 32) {
        const bf16x8 av = *(const bf16x8*)(ap + k0);
#pragma unroll
        for (int n = 0; n < 4; ++n) { const bf16x8 bv = *(const bf16x8*)(bp + (size_t)n * 16 * K + k0); acc[n] = MFMA16(bv, av, acc[n]); }
    }
#pragma unroll
    for (int n = 0; n < 4; ++n)
#pragma unroll
        for (int j = 0; j < 4; ++j) epi(row0 + fr, col0 + n * 16 + 4 * fq + j, acc[n][j]);
}
struct EpiStoreBf16 { bf16_t* O; int ldc; int K; __device__ void operator()(int r, int c, float v) const { O[(size_t)r * ldc + c] = (bf16_t)f2bf(v); } };
struct EpiOutProj { const float* x; const float* mod; float* X1; int K; int pad; __device__ void operator()(int r, int c, float v) const { const int b = r / SEQ; X1[(size_t)r * D_ + c] = x[(size_t)r * D_ + c] + mod[b * NMOD + 2 * D_ + c] * v; } };

__global__ void k_pool_p(const bf16_t* PROJ, bf16_t* PP) {
    const int i = blockIdx.x * blockDim.x + threadIdx.x; if (i >= T_ * 512) return;
    const int t = i >> 9, ch = i & 511, g = ch >> 7, w = 2 << g, pos = t % SEQ;
    float s = 0.f;
    for (int q = 0; q < w; ++q) if (pos - q >= 0) s += bf2f(PROJ[(size_t)(t - q) * INC + ch]);
    const float cnt = (float)((pos + 1 < w) ? pos + 1 : w);
    PP[i] = (bf16_t)f2bf(s / cnt - bf2f(PROJ[(size_t)t * INC + ch]));
}
__global__ void k_pool_mm(const bf16_t* PP, const bf16_t* PWT, const float* pool_b, const float* pool_scale, bf16_t* MIXIN) {
    const int i = blockIdx.x * blockDim.x + threadIdx.x; if (i >= T_ * 512) return;
    const int t = i >> 9, ch = i & 511, g = ch >> 7, d = ch & 127;
    float s = 0.f;
    for (int c = 0; c < 128; ++c) s += bf2f(PP[(size_t)t * 512 + g * 128 + c]) * bf2f(PWT[(g * 128 + d) * 128 + c]);
    MIXIN[(size_t)t * D_ + ch] = (bf16_t)f2bf((s + pool_b[ch]) * pool_scale[ch]);
}
__global__ void k_rot(const bf16_t* PROJ, const float* rope, bf16_t* QR, bf16_t* KR) {
    const int i = blockIdx.x * blockDim.x + threadIdx.x; if (i >= T_ * 256) return;
    const int t = i >> 8, h = (i >> 6) & 3, d = i & 63, pos = t % SEQ;
    const float c = rope[pos * 64 + d], s = rope[SEQ * 64 + pos * 64 + d];
    const bf16_t* p = PROJ + (size_t)t * INC;
    const float q1 = bf2f(p[512 + h * 128 + d]), q2 = bf2f(p[512 + h * 128 + 64 + d]);
    const float k1 = bf2f(p[1024 + h * 128 + d]), k2 = bf2f(p[1024 + h * 128 + 64 + d]);
    const float sc = 0.08838834764831845f;
    QR[(size_t)t * 512 + h * 128 + d] = (bf16_t)f2bf(q1 * c - q2 * s); QR[(size_t)t * 512 + h * 128 + 64 + d] = (bf16_t)f2bf(q2 * c + q1 * s);
    KR[(size_t)t * 512 + h * 128 + d] = (bf16_t)f2bf((k1 * c - k2 * s) * sc); KR[(size_t)t * 512 + h * 128 + 64 + d] = (bf16_t)f2bf((k2 * c + k1 * s) * sc);
}
__global__ void k_kv(const bf16_t* PROJ, const bf16_t* KR, float* KVT) {
    const int bh = blockIdx.x / 15, n = blockIdx.x % 15, b = bh >> 2, h = bh & 3, t0 = b * SEQ + n * 128;
    const float l2g = log2_gamma(h);
    for (int idx = threadIdx.x; idx < 16384; idx += blockDim.x) {
        const int e = idx >> 7, d = idx & 127; float s = 0.f;
        for (int j = 0; j < 128; ++j) s += exp2f((float)(127 - j) * l2g) * bf2f(KR[(size_t)(t0 + j) * 512 + h * 128 + d]) * bf2f(PROJ[(size_t)(t0 + j) * INC + 1536 + h * 128 + e]);
        KVT[((size_t)(bh * 15 + n) * 128 + e) * 128 + d] = s;
    }
}
__global__ void k_scan(const float* KVT, bf16_t* RT) {
    const int i = blockIdx.x * blockDim.x + threadIdx.x; if (i >= 32 * 16384) return;
    const int bh = i >> 14, ed = i & 16383, h = bh & 3;
    const float cd = exp2f(128.f * log2_gamma(h)); float R = 0.f;
    for (int n = 0; n < 16; ++n) { RT[((size_t)(bh * 16 + n) << 14) + ed] = (bf16_t)f2bf(R); if (n < 15) R = R * cd + KVT[((size_t)(bh * 15 + n) << 14) + ed]; }
}
__global__ void k_S(const bf16_t* QR, const bf16_t* KR, float* SG) {
    const int u = blockIdx.x, bh = u >> 4, n = u & 15, b = bh >> 2, h = bh & 3, t0 = b * SEQ + n * 128;
    const float l2g = log2_gamma(h);
    for (int idx = threadIdx.x; idx < 16384; idx += blockDim.x) {
        const int i = idx >> 7, j = idx & 127; float s = 0.f;
        if (i >= j) { for (int d = 0; d < 128; ++d) s += bf2f(QR[(size_t)(t0 + i) * 512 + h * 128 + d]) * bf2f(KR[(size_t)(t0 + j) * 512 + h * 128 + d]); s *= exp2f((float)(i - j) * l2g); }
        SG[((size_t)u << 14) + idx] = s;
    }
}
__global__ void k_o(const bf16_t* PROJ, const bf16_t* QR, const float* SG, const bf16_t* RT, float* OG) {
    const int u = blockIdx.x, bh = u >> 4, n = u & 15, b = bh >> 2, h = bh & 3, t0 = b * SEQ + n * 128;
    const float l2g = log2_gamma(h);
    for (int idx = threadIdx.x; idx < 16384; idx += blockDim.x) {
        const int i = idx >> 7, e = idx & 127; float s = 0.f, r = 0.f;
        for (int j = 0; j <= i; ++j) s += SG[((size_t)u << 14) + i * 128 + j] * bf2f(PROJ[(size_t)(t0 + j) * INC + 1536 + h * 128 + e]);
        for (int d = 0; d < 128; ++d) r += bf2f(QR[(size_t)(t0 + i) * 512 + h * 128 + d]) * bf2f(RT[((size_t)(bh * 16 + n) << 14) + e * 128 + d]);
        OG[(size_t)(t0 + i) * 512 + h * 128 + e] = s + r * exp2f((float)(i + 1) * l2g);
    }
}
__global__ void k_gn(const bf16_t* PROJ, const float* OG, const float* gn, bf16_t* MIXIN) {
    const int gw = (blockIdx.x * blockDim.x + threadIdx.x) >> 6, lane = threadIdx.x & 63; if (gw >= T_ * 4) return;
    const int t = gw >> 2, h = gw & 3;
    const float o0 = OG[(size_t)t * 512 + h * 128 + 2 * lane], o1 = OG[(size_t)t * 512 + h * 128 + 2 * lane + 1];
    const float mu = wave_sum(o0 + o1) * (1.f / 128.f);
    const float d0 = o0 - mu, d1 = o1 - mu;
    const float var = wave_sum(d0 * d0 + d1 * d1) * (1.f / 128.f);
    const float rs = 1.f / sqrtf(var + EPS);
    const int c = h * 128 + 2 * lane;
    const float g0 = bf2f(PROJ[(size_t)t * INC + 2048 + c]), g1 = bf2f(PROJ[(size_t)t * INC + 2048 + c + 1]);
    *(unsigned*)(MIXIN + (size_t)t * D_ + 512 + c) = pk2(silu_f(g0) * d0 * rs * gn[c], silu_f(g1) * d1 * rs * gn[c + 1]);
}
__global__ void k_h2(const float* X1, const float* mod, const float* g_ffn, bf16_t* HN, float* H2F) {
    const int gw = (blockIdx.x * blockDim.x + threadIdx.x) >> 6, lane = threadIdx.x & 63; if (gw >= T_) return;
    const int r = gw, b = r / SEQ;
    const f32x4* xr = (const f32x4*)(X1 + (size_t)r * D_) + lane;
    f32x4 v[4]; float ss = 0.f;
#pragma unroll
    for (int j = 0; j < 4; ++j) { v[j] = xr[64 * j]; ss += (v[j].x * v[j].x + v[j].y * v[j].y) + (v[j].z * v[j].z + v[j].w * v[j].w); }
    const float rs = 1.f / sqrtf(wave_sum(ss) * (1.f / D_) + EPS);
    const float* sh = mod + b * NMOD + 3 * D_; const float* sc = mod + b * NMOD + 4 * D_;
#pragma unroll
    for (int j = 0; j < 4; ++j) {
        const int c0 = 4 * lane + 256 * j; float hv[4];
#pragma unroll
        for (int q = 0; q < 4; ++q) hv[q] = v[j][q] * rs * g_ffn[c0 + q] * (1.f + sc[c0 + q]) + sh[c0 + q];
        *(f32x4*)(H2F + (size_t)r * D_ + c0) = (f32x4){hv[0], hv[1], hv[2], hv[3]};
        *(unsigned long long*)(HN + (size_t)r * D_ + c0) = (unsigned long long)pk2(hv[0], hv[1]) | ((unsigned long long)pk2(hv[2], hv[3]) << 32);
    }
}
__global__ void k_logits(const float* H2F, const float* wr, const float* br, float* LG) {
    const int i = blockIdx.x * blockDim.x + threadIdx.x; if (i >= T_ * NE) return;
    const int t = i >> 5, e = i & 31; float s = 0.f;
    for (int k = 0; k < D_; ++k) s += H2F[(size_t)t * D_ + k] * wr[k * NE + e];
    LG[i] = s + br[e];
}
__global__ void k_topk(const float* LG, int* cnt, int* tokslot, float* wslot) {
    const int t = blockIdx.x * blockDim.x + threadIdx.x; if (t >= T_) return;
    float v[NE];
#pragma unroll
    for (int e = 0; e < NE; ++e) v[e] = LG[t * NE + e];
    float tv[4]; int ti[4];
#pragma unroll
    for (int k = 0; k < 4; ++k) {
        float best = -INFINITY; int bi = 0;
#pragma unroll
        for (int e = 0; e < NE; ++e) if (v[e] > best) { best = v[e]; bi = e; }
        tv[k] = best; ti[k] = bi;
#pragma unroll
        for (int e = 0; e < NE; ++e) if (e == bi) v[e] = -INFINITY;
    }
    float ex[4], se = 0.f;
#pragma unroll
    for (int k = 0; k < 4; ++k) { ex[k] = __expf(tv[k] - tv[0]); se += ex[k]; }
#pragma unroll
    for (int k = 0; k < 4; ++k) { const int rank = atomicAdd(&cnt[ti[k]], 1); tokslot[ti[k] * CAP + rank] = t * 4 + k; wslot[t * 4 + k] = ex[k] / se; }
}
__global__ void k_offsets(const int* cnt, int* pstart) {
    if (threadIdx.x == 0 && blockIdx.x == 0) { int s = 0; for (int e = 0; e < NE; ++e) { pstart[e] = s; s += ((cnt[e] + 255) / 256) * 256; } pstart[NE] = s; }
}
__global__ void __launch_bounds__(256) k_gateup(const bf16_t* HN, const bf16_t* WGUT, const float* bgu, const int* cnt, const int* pstart, const int* tokslot, bf16_t* ACT) {
    const int wave = threadIdx.x >> 6, lane = threadIdx.x & 63, fr = lane & 15, fq = lane >> 4, e = blockIdx.z, ne = cnt[e];
    const int a0 = blockIdx.x * 16;
    const int pn = a0 >> 7, i0 = a0 & 127;
    const bf16_t* Bg = WGUT + ((size_t)e * 2048 + 256 * pn + i0 + fr) * D_ + fq * 8;
    const bf16_t* Bl = Bg + (size_t)128 * D_;
    for (int rt = blockIdx.y; rt * 64 < ne; rt += gridDim.y) {
        const int rank = rt * 64 + wave * 16 + fr;
        const int tok = (rank < ne) ? (tokslot[e * CAP + rank] >> 2) : 0;
        const bf16_t* ap = HN + (size_t)tok * D_ + fq * 8;
        f32x4 ag = (f32x4){0.f, 0.f, 0.f, 0.f}, al = ag;
        for (int k0 = 0; k0 < D_; k0 += 32) {
            const bf16x8 av = *(const bf16x8*)(ap + k0);
            ag = MFMA16(*(const bf16x8*)(Bg + k0), av, ag); al = MFMA16(*(const bf16x8*)(Bl + k0), av, al);
        }
        if (rank < ne) {
#pragma unroll
            for (int j = 0; j < 4; ++j) {
                const int acol = a0 + 4 * fq + j;
                float gate = ag[j] + bgu[e * 2048 + 2 * acol], lin = al[j] + bgu[e * 2048 + 2 * acol + 1];
                gate = fminf(gate, 7.f); lin = fminf(fmaxf(lin, -7.f), 7.f);
                const float glu = gate / (1.f + __expf(-1.702f * gate));
                ACT[(size_t)(pstart[e] + rank) * FF + acol] = (bf16_t)f2bf((lin + 1.f) * glu);
            }
        }
    }
}
__global__ void __launch_bounds__(256) k_down(const bf16_t* ACT, const bf16_t* WDT, const float* bd, const int* cnt, const int* pstart, const int* tokslot, bf16_t* Y) {
    const int wave = threadIdx.x >> 6, lane = threadIdx.x & 63, fr = lane & 15, fq = lane >> 4, e = blockIdx.z, ne = cnt[e];
    const int col0 = blockIdx.x * 64;
    const bf16_t* bp = WDT + ((size_t)e * D_ + col0 + fr) * FF + fq * 8;
    for (int rt = blockIdx.y; rt * 64 < ne; rt += gridDim.y) {
        const int rank = rt * 64 + wave * 16 + fr;
        const bf16_t* ap = ACT + (size_t)(pstart[e] + ((rank < ne) ? rank : 0)) * FF + fq * 8;
        f32x4 acc[4];
#pragma unroll
        for (int n = 0; n < 4; ++n) acc[n] = (f32x4){0.f, 0.f, 0.f, 0.f};
        for (int k0 = 0; k0 < FF; k0 += 32) {
            const bf16x8 av = *(const bf16x8*)(ap + k0);
#pragma unroll
            for (int n = 0; n < 4; ++n) acc[n] = MFMA16(*(const bf16x8*)(bp + (size_t)n * 16 * FF + k0), av, acc[n]);
        }
        if (rank < ne) {
            const int slot = tokslot[e * CAP + rank];
#pragma unroll
            for (int n = 0; n < 4; ++n)
#pragma unroll
                for (int j = 0; j < 4; ++j) { const int c = col0 + n * 16 + 4 * fq + j; Y[(size_t)slot * D_ + c] = (bf16_t)f2bf(acc[n][j] + bd[e * D_ + c]); }
        }
    }
}
__global__ void k_final(const float* X1, const bf16_t* Y, const float* wslot, const float* mod, const float* g_final, float* out) {
    const int gw = (blockIdx.x * blockDim.x + threadIdx.x) >> 6, lane = threadIdx.x & 63; if (gw >= T_) return;
    const int r = gw, b = r / SEQ;
    const float* gt2 = mod + b * NMOD + 5 * D_;
    float w[4];
#pragma unroll
    for (int k = 0; k < 4; ++k) w[k] = wslot[r * 4 + k];
    f32x4 v[4]; float ss = 0.f;
#pragma unroll
    for (int j = 0; j < 4; ++j) {
        const int c0 = 4 * lane + 256 * j;
        f32x4 f = (f32x4){0.f, 0.f, 0.f, 0.f};
#pragma unroll
        for (int k = 0; k < 4; ++k) {
            const u32x2 y = *(const u32x2*)(Y + (size_t)(r * 4 + k) * D_ + c0);
            f.x += w[k] * bf2f(y.x & 0xffffu); f.y += w[k] * bf2f(y.x >> 16); f.z += w[k] * bf2f(y.y & 0xffffu); f.w += w[k] * bf2f(y.y >> 16);
        }
        const f32x4 x1 = *(const f32x4*)(X1 + (size_t)r * D_ + c0); const f32x4 g = *(const f32x4*)(gt2 + c0);
        v[j] = x1 + g * f;
        ss += (v[j].x * v[j].x + v[j].y * v[j].y) + (v[j].z * v[j].z + v[j].w * v[j].w);
    }
    const float rs = 1.f / sqrtf(wave_sum(ss) * (1.f / D_) + EPS);
#pragma unroll
    for (int j = 0; j < 4; ++j) { const int c0 = 4 * lane + 256 * j; const f32x4 g = *(const f32x4*)(g_final + c0); *(f32x4*)(out + (size_t)r * D_ + c0) = v[j] * rs * g; }
}

extern "C" void kernel_launch(void* const* d_in, const int* in_sizes, int n_in, void* d_out, int out_size, void* d_ws, size_t ws_size, hipStream_t stream) {
    static int grid = 0;
    if (grid == 0) {
        if (n_in != 19 || in_sizes[0] != T_ * D_ || out_size != T_ * D_ || ws_size < WS_END) { fprintf(stderr, "kernel_launch: unexpected shapes / workspace (n_in %d, ws %zu)\n", n_in, ws_size); grid = -1; return; }
        int dev = 0, cus = 0, per_cu = 0;
        if (hipGetDevice(&dev) != hipSuccess || hipDeviceGetAttribute(&cus, hipDeviceAttributeMultiprocessorCount, dev) != hipSuccess) { grid = -1; return; }
        if (hipFuncSetAttribute((const void*)mega, hipFuncAttributeMaxDynamicSharedMemorySize, LDS_BYTES) != hipSuccess) { fprintf(stderr, "hipFuncSetAttribute failed\n"); grid = -1; return; }
        if (hipOccupancyMaxActiveBlocksPerMultiprocessor(&per_cu, (const void*)mega, 512, LDS_BYTES) != hipSuccess || per_cu < 1) { fprintf(stderr, "occupancy query: %d\n", per_cu); }
        (void)hipGetLastError();
        grid = cus;
        if (grid != 256) fprintf(stderr, "kernel_launch: grid %d (expected 256)\n", grid);
    }
    if (grid < 0) return;
    unsigned char* ws = (unsigned char*)d_ws;
    (void)hipMemsetAsync(ws + WS_CTL, 0, CTL_ZERO_BYTES, stream);
    Args a{};
    for (int i = 0; i < 19; ++i) a.in[i] = (const float*)d_in[i];
    a.out = (float*)d_out; a.ws = ws;
    const float* const* in = a.in;
    float* MOD = (float*)(ws + WS_MOD); float* ROPE = (float*)(ws + WS_ROPE);
    bf16_t* POOLWT = (bf16_t*)(ws + WS_POOLWT); bf16_t* WINT = (bf16_t*)(ws + WS_WINT); bf16_t* WOUTT = (bf16_t*)(ws + WS_WOUTT);
    int* TOKSLOT = (int*)(ws + WS_TOKSLOT); float* WSLOT = (float*)(ws + WS_WSLOT);
    bf16_t* WGUT = (bf16_t*)(ws + WS_WGUT); bf16_t* WDT = (bf16_t*)(ws + WS_WDT); bf16_t* XN = (bf16_t*)(ws + WS_XN); bf16_t* PROJ = (bf16_t*)(ws + WS_PROJ);
    float* KVT = (float*)(ws + WS_KVT); bf16_t* RT = (bf16_t*)(ws + WS_RT); bf16_t* MIXIN = (bf16_t*)(ws + WS_MIXIN); float* X1 = (float*)(ws + WS_X1);
    bf16_t* HN = (bf16_t*)(ws + WS_HN); bf16_t* ACT = (bf16_t*)(ws + WS_ACT); bf16_t* Y = (bf16_t*)(ws + WS_Y);
    bf16_t* QR = (bf16_t*)(ws + WS_QR); bf16_t* KR = (bf16_t*)(ws + WS_KR); float* SG = (float*)(ws + WS_SG); float* OG = (float*)(ws + WS_OG);
    float* H2F = (float*)(ws + WS_H2F); float* LG = (float*)(ws + WS_LOGITS); bf16_t* PP = (bf16_t*)(ws + WS_PP);
    int* CNT = (int*)(ws + WS_CTL) + CW_CNT; int* PSTART = (int*)(ws + WS_CTL) + CW_PSTART;

#define MEGA(lo, hi) do { a.ph_lo = (lo); a.ph_hi = (hi); hipLaunchKernelGGL(mega, dim3(grid), dim3(512), LDS_BYTES, stream, a); \
    if ((hi) - (lo) == 1 && (lo) != 7 && ((REPEAT_MASK >> (lo)) & 1)) { hipLaunchKernelGGL(mega, dim3(grid), dim3(512), LDS_BYTES, stream, a); hipLaunchKernelGGL(mega, dim3(grid), dim3(512), LDS_BYTES, stream, a); } } while (0)
#if ONE_LAUNCH
    MEGA(0, 11);
#else
    MEGA(0, 1);
    MEGA(1, 2);
#if SIMPLE_INPROJ
    hipLaunchKernelGGL(k_sgemm<EpiStoreBf16>, dim3(INC / 64, T_ / 64), dim3(256), 0, stream, XN, WINT, EpiStoreBf16{PROJ, INC, D_});
#else
    MEGA(2, 3);
#endif
#if SIMPLE_MIX
    hipLaunchKernelGGL(k_pool_p, dim3(T_ * 512 / 256), dim3(256), 0, stream, PROJ, PP);
    hipLaunchKernelGGL(k_pool_mm, dim3(T_ * 512 / 256), dim3(256), 0, stream, PP, POOLWT, in[7], in[8], MIXIN);
    hipLaunchKernelGGL(k_rot, dim3(T_ * 256 / 256), dim3(256), 0, stream, PROJ, ROPE, QR, KR);
    hipLaunchKernelGGL(k_kv, dim3(32 * 15), dim3(256), 0, stream, PROJ, KR, KVT);
    hipLaunchKernelGGL(k_scan, dim3(32 * 16384 / 256), dim3(256), 0, stream, KVT, RT);
    hipLaunchKernelGGL(k_S, dim3(512), dim3(256), 0, stream, QR, KR, SG);
    hipLaunchKernelGGL(k_o, dim3(512), dim3(256), 0, stream, PROJ, QR, SG, RT, OG);
    hipLaunchKernelGGL(k_gn, dim3(T_ * 4 * 64 / 256), dim3(256), 0, stream, PROJ, OG, in[9], MIXIN);
#else
    MEGA(3, 4);
    MEGA(4, 5);
    MEGA(5, 6);
#endif
#if SIMPLE_OUTPROJ
    hipLaunchKernelGGL(k_sgemm<EpiOutProj>, dim3(D_ / 64, T_ / 64), dim3(256), 0, stream, MIXIN, WOUTT, EpiOutProj{in[0], MOD, X1, D_, 0});
#else
    MEGA(6, 7);
#endif
#if SIMPLE_ROUTER
    hipLaunchKernelGGL(k_h2, dim3(T_ * 64 / 256), dim3(256), 0, stream, X1, MOD, in[11], HN, H2F);
    hipLaunchKernelGGL(k_logits, dim3(T_ * NE / 256), dim3(256), 0, stream, H2F, in[12], in[13], LG);
    hipLaunchKernelGGL(k_topk, dim3(T_ / 256), dim3(256), 0, stream, LG, CNT, TOKSLOT, WSLOT);
#else
    MEGA(7, 8);
#if (REPEAT_MASK >> 7) & 1
    (void)hipMemsetAsync(ws + WS_CTL, 0, 4096, stream); a.ph_lo = 7; a.ph_hi = 8; hipLaunchKernelGGL(mega, dim3(grid), dim3(512), LDS_BYTES, stream, a);
    (void)hipMemsetAsync(ws + WS_CTL, 0, 4096, stream); hipLaunchKernelGGL(mega, dim3(grid), dim3(512), LDS_BYTES, stream, a);
#endif
#endif
#if SIMPLE_GATEUP || SIMPLE_DOWN
    hipLaunchKernelGGL(k_offsets, dim3(1), dim3(64), 0, stream, CNT, PSTART);
#endif
#if SIMPLE_GATEUP
    hipLaunchKernelGGL(k_gateup, dim3(FF / 16, 40, NE), dim3(256), 0, stream, HN, WGUT, in[15], CNT, PSTART, TOKSLOT, ACT);
#else
    MEGA(8, 9);
#endif
#if SIMPLE_DOWN
    hipLaunchKernelGGL(k_down, dim3(D_ / 64, 40, NE), dim3(256), 0, stream, ACT, WDT, in[17], CNT, PSTART, TOKSLOT, Y);
#else
    MEGA(9, 10);
#endif
#if SIMPLE_FINAL
    hipLaunchKernelGGL(k_final, dim3(T_ * 64 / 256), dim3(256), 0, stream, X1, Y, WSLOT, MOD, in[18], (float*)d_out);
#else
    MEGA(10, 11);
#endif
#endif
}
```

```cpp
#include <hip/hip_runtime.h>
#include <cstdint>
#include <cstdio>

typedef unsigned short bf16_t;
typedef short bf16x8 __attribute__((ext_vector_type(8)));
typedef float f32x4 __attribute__((ext_vector_type(4)));
typedef unsigned u32x4 __attribute__((ext_vector_type(4)));
typedef unsigned u32x2 __attribute__((ext_vector_type(2)));
#define LAS __attribute__((address_space(3)))

#ifndef GU_F8
#define GU_F8 true
#endif
#ifndef DN_F8
#define DN_F8 true
#endif
#ifndef CONV_PRE
#define CONV_PRE 32
#endif
#ifndef EXTRA_BARRIERS
#define EXTRA_BARRIERS 0
#endif
#ifndef REPEAT_MASK
#define REPEAT_MASK 0
#endif
#ifndef ONE_LAUNCH
#define ONE_LAUNCH 1
#endif
#ifndef SIMPLE_MIX
#define SIMPLE_MIX 0
#endif
#ifndef SIMPLE_ROUTER
#define SIMPLE_ROUTER 0
#endif
#ifndef SIMPLE_FINAL
#define SIMPLE_FINAL 0
#endif
#ifndef SIMPLE_INPROJ
#define SIMPLE_INPROJ 0
#endif
#ifndef SIMPLE_OUTPROJ
#define SIMPLE_OUTPROJ 0
#endif
#ifndef SIMPLE_GATEUP
#define SIMPLE_GATEUP 0
#endif
#ifndef SIMPLE_DOWN
#define SIMPLE_DOWN 0
#endif
constexpr int T_ = 16384, D_ = 1024, NB = 8, SEQ = 2048, INC = 2560, NE = 32, FF = 1024, TK = 65536, NMOD = 6144;
constexpr int CAP = 16384;
constexpr int ACT_ROWS = TK + NE * 256;
constexpr float EPS = 1e-6f;

constexpr size_t MiB = 1u << 20;
constexpr size_t WS_CTL = 0, CTL_ZERO_BYTES = 1 * MiB;
constexpr size_t WS_MODP = 1 * MiB;
constexpr size_t WS_MOD = 3 * MiB;
constexpr size_t WS_ROPE = 4 * MiB;
constexpr size_t WS_POOLWT = 5 * MiB;
constexpr size_t WS_WINT = 6 * MiB;
constexpr size_t WS_WOUTT = 11 * MiB;
constexpr size_t WS_TOKSLOT = 13 * MiB;
constexpr size_t WS_WSLOT = 15 * MiB;
constexpr size_t WS_WGUT = 16 * MiB;
constexpr size_t WS_WDT = 144 * MiB;
constexpr size_t WS_XN = 208 * MiB;
constexpr size_t WS_PROJ = 240 * MiB;
constexpr size_t WS_KVT = 320 * MiB;
constexpr size_t WS_RT = 352 * MiB;
constexpr size_t WS_MIXIN = 368 * MiB;
constexpr size_t WS_X1 = 400 * MiB;
constexpr size_t WS_HN = 464 * MiB;
constexpr size_t WS_ACT = 496 * MiB;
constexpr size_t WS_Y = 640 * MiB;
constexpr size_t WS_QR = 768 * MiB;
constexpr size_t WS_KR = 784 * MiB;
constexpr size_t WS_SG = 800 * MiB;
constexpr size_t WS_OG = 832 * MiB;
constexpr size_t WS_H2F = 864 * MiB;
constexpr size_t WS_LOGITS = 928 * MiB;
constexpr size_t WS_PP = 930 * MiB;
constexpr size_t WS_END = 946 * MiB;
constexpr int CW_CNT = 64;
constexpr int CW_PSTART = 128;

#define MFMA16(a, b, c) __builtin_amdgcn_mfma_f32_16x16x32_bf16(a, b, c, 0, 0, 0)
__device__ __forceinline__ unsigned f2bf(float f) { unsigned u = __float_as_uint(f); return (u + 0x7fffu + ((u >> 16) & 1u)) >> 16; }
__device__ __forceinline__ unsigned pk2(float lo, float hi) { return f2bf(lo) | (f2bf(hi) << 16); }
__device__ __forceinline__ float bf2f(unsigned h) { return __uint_as_float(h << 16); }
__device__ __forceinline__ float wave_sum(float v) {
#pragma unroll
    for (int o = 1; o < 64; o <<= 1) v += __shfl_xor(v, o);
    return v;
}
__device__ __forceinline__ float silu_f(float v) { return v / (1.f + __expf(-v)); }
__device__ __forceinline__ float log2_gamma(int h) { return log2f(1.f - exp2f(-5.f - (float)h)); }

constexpr int NWAVES = 8;
constexpr float WSCALE = 64.f;
constexpr int SCALE_W = 121, SCALE_ONE = 127, SCALE_ACT = 125;
constexpr float ASCALE = 4.f;
typedef int i32x8 __attribute__((ext_vector_type(8)));
typedef int i32x4 __attribute__((ext_vector_type(4)));
constexpr int LDS_BYTES = 147456;

constexpr int RING_BYTES = 131072, LDSCTL_OFF = RING_BYTES;
constexpr int L_MISC = LDSCTL_OFF;
constexpr int L_CNT = LDSCTL_OFF + 256;
constexpr int L_PSTART = LDSCTL_OFF + 384;
constexpr int L_NT = LDSCTL_OFF + 640;
constexpr int L_TILES = LDSCTL_OFF + 768;
constexpr int L_ROWTAB = LDSCTL_OFF + 2048;
constexpr int MAX_UNITS = 12;
static_assert(L_ROWTAB + MAX_UNITS * 1024 <= LDS_BYTES, "LDS map");
constexpr int CW_BAR = 4096;

template <int MAPMODE, bool F8 = false>
__device__ __forceinline__ void transpose_item(const float* W, int K, int N, bf16_t* WT, LAS float* scr, int item, int lane) {
    const int nblk = N / 32, kb = item / nblk, nb = item % nblk, k0 = 64 * kb, n0 = 32 * nb;
    {
        float v[32];
        const float* wp = W + (size_t)(k0 + (lane >> 5)) * N + n0 + (lane & 31);
#pragma unroll
        for (int i = 0; i < 32; ++i) v[i] = wp[(size_t)(2 * i) * N];
        __builtin_amdgcn_sched_barrier(0);
#pragma unroll
        for (int i = 0; i < 32; ++i) scr[(2 * i + (lane >> 5)) * 33 + (lane & 31)] = v[i];
    }
    asm volatile("s_waitcnt lgkmcnt(0)" ::: "memory");
    const int c = lane & 7;
#pragma unroll
    for (int j = 0; j < 4; ++j) {
        const int nl = (lane >> 3) + 8 * j; const LAS float* s = scr + (8 * c) * 33 + nl;
        const int n = n0 + nl; int row = n;
        if (MAPMODE == 1) { const int a = n >> 1, bj = n & 1; row = 256 * (a >> 7) + 128 * bj + (a & 127); }
        if constexpr (F8) {
            int w0 = __builtin_amdgcn_cvt_pk_fp8_f32(s[0 * 33] * WSCALE, s[1 * 33] * WSCALE, 0, false); w0 = __builtin_amdgcn_cvt_pk_fp8_f32(s[2 * 33] * WSCALE, s[3 * 33] * WSCALE, w0, true);
            int w1 = __builtin_amdgcn_cvt_pk_fp8_f32(s[4 * 33] * WSCALE, s[5 * 33] * WSCALE, 0, false); w1 = __builtin_amdgcn_cvt_pk_fp8_f32(s[6 * 33] * WSCALE, s[7 * 33] * WSCALE, w1, true);
            u32x2 o; o.x = (unsigned)w0; o.y = (unsigned)w1;
            *(u32x2*)((unsigned char*)WT + (size_t)row * K + k0 + 8 * c) = o;
        } else {
            u32x4 o; o.x = pk2(s[0 * 33], s[1 * 33]); o.y = pk2(s[2 * 33], s[3 * 33]); o.z = pk2(s[4 * 33], s[5 * 33]); o.w = pk2(s[6 * 33], s[7 * 33]);
            *(u32x4*)(WT + (size_t)row * K + k0 + 8 * c) = o;
        }
    }
    asm volatile("s_waitcnt lgkmcnt(0)" ::: "memory");
}

struct Args {
    const float* in[19]; float* out; unsigned char* ws; int ph_lo, ph_hi;
};

__device__ __forceinline__ void phase_p0(const Args& a, LAS unsigned char* lds, int vb, int G) {
    const int tid = threadIdx.x, lane = tid & 63, wave = tid >> 6;
    unsigned char* ws = a.ws;
    if (vb < 256) {
        LAS float* cact = (LAS float*)lds;
        LAS float* part = (LAS float*)(lds + 4096);
        const int kc = vb & 7, cc = vb >> 3;
        const float* c = a.in[1];
        for (int i = tid; i < 8 * 128; i += 512) { const int b = i >> 7, k = i & 127; cact[i] = silu_f(c[b * D_ + kc * 128 + k]); }
        __syncthreads();
        const int cg = tid % 48, ks = tid / 48;
        if (ks < 10) {
            f32x4 acc[8];
#pragma unroll
            for (int b = 0; b < 8; ++b) acc[b] = (f32x4){0.f, 0.f, 0.f, 0.f};
            const float* w = a.in[2] + (size_t)(kc * 128) * NMOD + cc * 192 + cg * 4;
            for (int k = ks; k < 128; k += 10) {
                const f32x4 wv = *(const f32x4*)(w + (size_t)k * NMOD);
#pragma unroll
                for (int b = 0; b < 8; ++b) acc[b] += wv * cact[b * 128 + k];
            }
#pragma unroll
            for (int b = 0; b < 8; ++b) *(LAS f32x4*)(part + (ks * 8 + b) * 192 + cg * 4) = acc[b];
        }
        __syncthreads();
        float* modp = (float*)(ws + WS_MODP);
        for (int i = tid; i < 8 * 192; i += 512) {
            const int b = i / 192, col = i % 192; float s = 0.f;
#pragma unroll
            for (int q = 0; q < 10; ++q) s += part[(q * 8 + b) * 192 + col];
            modp[((size_t)kc * 8 + b) * NMOD + cc * 192 + col] = s;
        }
        __syncthreads();
    }
    {
        float* cosT = (float*)(ws + WS_ROPE); float* sinT = cosT + SEQ * 64;
        for (int i = vb * 512 + tid; i < SEQ * 64; i += G * 512) {
            const int pos = i >> 6, j = i & 63;
            const double inv = (double)(float)exp(-(double)j * (9.210340371976184 / 64.0));
            const double ang = (double)((float)pos * (float)inv);
            const double q = rint(ang * 0.6366197723675814);
            double r = fma(-q, 1.5707963267948966, ang); r = fma(-q, 6.123233995736766e-17, r);
            const double r2 = r * r;
            double s = -1.0 / 39916800.0; s = s * r2 + 1.0 / 362880.0; s = s * r2 - 1.0 / 5040.0; s = s * r2 + 1.0 / 120.0; s = s * r2 - 1.0 / 6.0; s = s * r2 + 1.0; s *= r;
            double co = 1.0 / 479001600.0; co = co * r2 - 1.0 / 3628800.0; co = co * r2 + 1.0 / 40320.0; co = co * r2 - 1.0 / 720.0; co = co * r2 + 1.0 / 24.0; co = co * r2 - 0.5; co = co * r2 + 1.0;
            const int n = ((int)q) & 3;
            const double sv = (n == 0) ? s : (n == 1) ? co : (n == 2) ? -s : -co;
            const double cv = (n == 0) ? co : (n == 1) ? -s : (n == 2) ? -co : s;
            cosT[i] = (float)cv; sinT[i] = (float)sv;
        }
    }
    {
        LAS float* scr = (LAS float*)(lds + wave * 16384);
        const int gw = vb * NWAVES + wave, NGW = G * NWAVES;
        constexpr int I_IN = (D_ / 64) * (INC / 32), I_OUT = (D_ / 64) * (D_ / 32), I_POOL = 4 * 2 * 4;
        constexpr int NITEMS = I_IN + I_OUT + I_POOL;
        for (int it = gw; it < NITEMS; it += NGW) {
            int r = it;
            if (r < I_IN) { transpose_item<0>(a.in[5], D_, INC, (bf16_t*)(ws + WS_WINT), scr, r, lane); continue; } r -= I_IN;
            if (r < I_OUT) { transpose_item<0>(a.in[10], D_, D_, (bf16_t*)(ws + WS_WOUTT), scr, r, lane); continue; } r -= I_OUT;
            { const int g = r / 8; transpose_item<0>(a.in[6] + g * 128 * 128, 128, 128, (bf16_t*)(ws + WS_POOLWT) + g * 128 * 128, scr, r % 8, lane); }
        }
    }
}

constexpr int MOE_ITEMS_GU = (D_ / 64) * (2 * FF / 32), MOE_ITEMS_DN = (FF / 64) * (D_ / 32);
constexpr int MOE_ITEMS = NE * (MOE_ITEMS_GU + MOE_ITEMS_DN), QCHUNKS = MOE_ITEMS / 8 / 8;
static_assert(QCHUNKS * 64 == MOE_ITEMS, "queue geometry");
constexpr int CW_Q = 1024, QGRAB = 4;
static_assert(QCHUNKS % QGRAB == 0, "queue grab");
struct MoeItem { const float* wp; unsigned char* dst; int K, N, k0, n0, mode; bool f8; };
__device__ __forceinline__ MoeItem moe_decode(const Args& a, int r, int lane) {
    MoeItem it; unsigned char* ws = a.ws; int item; const float* W;
    if (r < NE * MOE_ITEMS_GU) { const int e = r / MOE_ITEMS_GU; item = r % MOE_ITEMS_GU; W = a.in[14] + (size_t)e * D_ * 2 * FF; it.K = D_; it.N = 2 * FF; it.mode = 1; it.f8 = GU_F8; it.dst = ws + WS_WGUT + (size_t)e * 2 * FF * D_ * (GU_F8 ? 1 : 2); }
    else { r -= NE * MOE_ITEMS_GU; const int e = r / MOE_ITEMS_DN; item = r % MOE_ITEMS_DN; W = a.in[16] + (size_t)e * FF * D_; it.K = FF; it.N = D_; it.mode = 0; it.f8 = DN_F8; it.dst = ws + WS_WDT + (size_t)e * D_ * FF * (DN_F8 ? 1 : 2); }
    const int nblk = it.N / 32, kb = item / nblk, nb = item % nblk; it.k0 = 64 * kb; it.n0 = 32 * nb;
    it.wp = W + (size_t)(it.k0 + (lane >> 5)) * it.N + it.n0 + (lane & 31);
    return it;
}
__device__ __forceinline__ void moe_load(const MoeItem& it, float (&v)[32]) {
#pragma unroll
    for (int i = 0; i < 32; ++i) v[i] = __builtin_nontemporal_load(it.wp + (size_t)(2 * i) * it.N);
}
__device__ __forceinline__ void moe_finish(const MoeItem& it, const float (&v)[32], LAS float* scr, int lane) {
#pragma unroll
    for (int i = 0; i < 32; ++i) scr[(2 * i + (lane >> 5)) * 33 + (lane & 31)] = v[i];
    asm volatile("s_waitcnt lgkmcnt(0)" ::: "memory");
    const int c = lane & 7;
#pragma unroll
    for (int j = 0; j < 4; ++j) {
        const int nl = (lane >> 3) + 8 * j; const LAS float* s = scr + (8 * c) * 33 + nl;
        const int n = it.n0 + nl; int row = n;
        if (it.mode == 1) { const int aa = n >> 1, bj = n & 1; row = 256 * (aa >> 7) + 128 * bj + (aa & 127); }
        if (it.f8) {
            int w0 = __builtin_amdgcn_cvt_pk_fp8_f32(s[0 * 33] * WSCALE, s[1 * 33] * WSCALE, 0, false); w0 = __builtin_amdgcn_cvt_pk_fp8_f32(s[2 * 33] * WSCALE, s[3 * 33] * WSCALE, w0, true);
            int w1 = __builtin_amdgcn_cvt_pk_fp8_f32(s[4 * 33] * WSCALE, s[5 * 33] * WSCALE, 0, false); w1 = __builtin_amdgcn_cvt_pk_fp8_f32(s[6 * 33] * WSCALE, s[7 * 33] * WSCALE, w1, true);
            u32x2 o; o.x = (unsigned)w0; o.y = (unsigned)w1;
            *(u32x2*)(it.dst + (size_t)row * it.K + it.k0 + 8 * c) = o;
        } else {
            u32x4 o; o.x = pk2(s[0 * 33], s[1 * 33]); o.y = pk2(s[2 * 33], s[3 * 33]); o.z = pk2(s[4 * 33], s[5 * 33]); o.w = pk2(s[6 * 33], s[7 * 33]);
            *(u32x4*)((bf16_t*)it.dst + (size_t)row * it.K + it.k0 + 8 * c) = o;
        }
    }
    asm volatile("s_waitcnt lgkmcnt(0)" ::: "memory");
}
__device__ __forceinline__ void conv_chunks(const Args& a, LAS unsigned char* lds, int myq, int maxchunks) {
    const int tid = threadIdx.x, lane = tid & 63, wave = __builtin_amdgcn_readfirstlane(tid >> 6);
    LAS float* scr = (LAS float*)(lds + wave * 16384);
    volatile LAS int* slot = (volatile LAS int*)(lds + L_MISC) + 16;
    unsigned* heads = (unsigned*)(a.ws + WS_CTL) + CW_Q;
    int done = 0;
    static_assert(QGRAB == 4, "the pipelined loop below is written for four chunks per grab");
    for (int qq = 0; qq < 8 && done < maxchunks; ++qq) {
        const int q = (myq + qq) & 7;
        for (;;) {
            if (done >= maxchunks) break;
            if (tid == 0) *slot = (int)__hip_atomic_fetch_add(heads + 64 * q, (unsigned)QGRAB, __ATOMIC_RELAXED, __HIP_MEMORY_SCOPE_AGENT);
            __syncthreads();
            const int c = *slot;
            __syncthreads();
            if (c >= QCHUNKS) break;
            const int r0 = (q * QCHUNKS + c) * 8 + wave;
            float va[32], vb[32];
            MoeItem i0 = moe_decode(a, r0, lane), i1 = moe_decode(a, r0 + 8, lane), i2 = moe_decode(a, r0 + 16, lane), i3 = moe_decode(a, r0 + 24, lane);
            moe_load(i0, va); moe_load(i1, vb); __builtin_amdgcn_sched_barrier(0);
            moe_finish(i0, va, scr, lane); __builtin_amdgcn_sched_barrier(0);
            moe_load(i2, va); __builtin_amdgcn_sched_barrier(0);
            moe_finish(i1, vb, scr, lane); __builtin_amdgcn_sched_barrier(0);
            moe_load(i3, vb); __builtin_amdgcn_sched_barrier(0);
            moe_finish(i2, va, scr, lane); __builtin_amdgcn_sched_barrier(0);
            moe_finish(i3, vb, scr, lane);
            done += QGRAB;
        }
    }
    __syncthreads();
}

__device__ __forceinline__ void phase_p1(const Args& a, LAS unsigned char* lds, int vb, int G) {
    const int tid = threadIdx.x, lane = tid & 63, wave = tid >> 6;
    unsigned char* ws = a.ws;
    const float* modp = (const float*)(ws + WS_MODP); float* mod = (float*)(ws + WS_MOD);
    for (int i = vb * 512 + tid; i < NB * NMOD; i += G * 512) {
        const int col = i % NMOD; float s = a.in[3][col];
#pragma unroll
        for (int q = 0; q < 8; ++q) s += modp[(size_t)q * NB * NMOD + i];
        mod[i] = s;
    }
    const int RPB = T_ / G;
    const int row0 = vb * RPB, b = row0 / SEQ;
    LAS float* shs = (LAS float*)lds;
    LAS float* scs = shs + 1024;
    for (int i = tid; i < 2048; i += 512) {
        float s = a.in[3][i];
#pragma unroll
        for (int q = 0; q < 8; ++q) s += modp[(size_t)q * NB * NMOD + (size_t)b * NMOD + i];
        if (i < 1024) shs[i] = s; else scs[i - 1024] = (1.f + s) * a.in[4][i - 1024];
    }
    __syncthreads();
    bf16_t* XN = (bf16_t*)(ws + WS_XN);
    for (int r = row0 + wave; r < row0 + RPB; r += NWAVES) {
        const f32x4* xr = (const f32x4*)(a.in[0] + (size_t)r * D_) + lane;
        f32x4 v[4]; float ss = 0.f;
#pragma unroll
        for (int j = 0; j < 4; ++j) { v[j] = xr[64 * j]; ss += (v[j].x * v[j].x + v[j].y * v[j].y) + (v[j].z * v[j].z + v[j].w * v[j].w); }
        const float rs = 1.f / sqrtf(wave_sum(ss) * (1.f / D_) + EPS);
        unsigned long long* o8 = (unsigned long long*)(XN + (size_t)r * D_) + lane;
#pragma unroll
        for (int j = 0; j < 4; ++j) {
            const int c0 = 4 * lane + 256 * j;
            const float h0 = v[j].x * rs * scs[c0] + shs[c0], h1 = v[j].y * rs * scs[c0 + 1] + shs[c0 + 1], h2 = v[j].z * rs * scs[c0 + 2] + shs[c0 + 2], h3 = v[j].w * rs * scs[c0 + 3] + shs[c0 + 3];
            o8[64 * j] = (unsigned long long)pk2(h0, h1) | ((unsigned long long)pk2(h2, h3) << 32);
        }
    }
    __syncthreads();
}


namespace pg8 {
constexpr int BM = 256, BK = 64, HALF = 128, HTB = HALF * BK * 2, STAGE_BYTES = 8 * HTB, NXCD = 8, WGM = 8;
__host__ __device__ __forceinline__ int lds_byte(int r, int c) { const int st = (r >> 4) * 2 + (c >> 5), rr = r & 15, cc = c & 31, ob = rr * 64 + cc * 2; return st * 1024 + (ob ^ (((ob >> 9) & 1) << 5)); }
__host__ __device__ __forceinline__ void stage_rc(int b, int& R, int& C) { const int st = b / 1024, sb = b % 1024, swz = sb ^ (((sb >> 9) & 1) << 5); R = (st >> 1) * 16 + swz / 64; C = (st & 1) * 32 + (swz % 64) / 2; }
__host__ __device__ __forceinline__ int perm32(int rho) { const int n = rho >> 4, i = rho & 15; return 8 * (i >> 2) + 4 * n + (i & 3); }

struct Unit { int pm, pn, e, r0; };
struct Gemm { const bf16_t* A; const bf16_t* Bt; int N, K; size_t bstride; int sw, so; };

struct TileOrder {
    int nM, nN, nwg, G, c;
    __device__ __forceinline__ void init(int nM_, int nN_, int G_, int c_) { nM = nM_; nN = nN_; nwg = nM * nN; G = G_; c = c_; }
    __device__ __forceinline__ bool tile(int i, int& pm, int& pn) const {
        const long L = (long)i * G + c; if (L >= nwg) return false;
        int wgid = (int)L; { const int q = nwg / NXCD, r = nwg % NXCD, xcd = wgid % NXCD, off = wgid / NXCD; wgid = (xcd < r ? xcd * (q + 1) : r * (q + 1) + (xcd - r) * q) + off; }
        const int nig = WGM * nN, gid = wgid / nig, fm = gid * WGM, gsz = (nM - fm) < WGM ? (nM - fm) : WGM;
        pm = fm + ((wgid % nig) % gsz); pn = (wgid % nig) / gsz; return true;
    }
};
struct DenseOrder : TileOrder {
    __device__ __forceinline__ bool next(int i, Unit& u) const { int pm, pn; if (!tile(i, pm, pn)) return false; u.pm = pm; u.pn = pn; u.e = 0; u.r0 = pm * BM; return true; }
    __device__ __forceinline__ int arow(int, const Unit& u, int lr) const { return u.r0 + lr; }
};

__device__ __forceinline__ unsigned cvt_pk_bf16(float lo, float hi) { unsigned r; asm volatile("v_cvt_pk_bf16_f32 %0, %1, %2" : "=v"(r) : "v"(lo), "v"(hi)); return r; }

template <class Epi, class Sched, bool ALIGN_EPI, bool F8 = false>
__device__ __forceinline__ void gemm_phase(LAS unsigned char* lds, const Gemm g, const Sched& S, const Epi& E) {
    const int tid = threadIdx.x, wid = __builtin_amdgcn_readfirstlane(tid >> 6), lane = tid & 63, wr = wid >> 2, wc = wid & 3, fr = lane & 15, fq = lane >> 4;
    const int K = F8 ? g.K / 2 : g.K, nt = K / BK;
    unsigned voffB[2];
#pragma unroll
    for (int i = 0; i < 2; ++i) { int R, C; stage_rc(tid * 16 + i * 8192, R, C); const int Rb = Epi::PERM ? ((R & ~31) + perm32(R & 31)) : R; voffB[i] = (unsigned)(Rb * K + C) * 2u; }
    const size_t kstep = (size_t)(BK * 2);
    const size_t hstep = (size_t)HALF * K * 2;
    const size_t tstep = 2 * hstep;
    const unsigned ldsw = (unsigned)wid * 1024u;
    const int aoff = lds_byte(wr * 64 + fr, fq * 8), boff = lds_byte(wc * 32 + fr, fq * 8);
#define PG8_SA(b, h) (((b) * 2 + (h)) * HTB)
#define PG8_SB(b, h) ((4 + (b) * 2 + (h)) * HTB)
#define PG8_STAGE(bufoff, gbase, voff) do { _Pragma("unroll") for (int _i = 0; _i < 2; ++_i) \
        __builtin_amdgcn_global_load_lds((const unsigned*)((const char*)(gbase) + (voff)[_i]), (LAS unsigned*)(lds + (bufoff) + ldsw + _i * 8192), 16, 0, 0); } while (0)
#define PG8_LDA(dst, b, h) do { _Pragma("unroll") for (int m = 0; m < 4; ++m) _Pragma("unroll") for (int k = 0; k < 2; ++k) dst[m][k] = *(const LAS bf16x8*)(lds + PG8_SA(b, h) + aoff + m * 2048 + k * 1024); } while (0)
#define PG8_LDB(dst, b, h) do { _Pragma("unroll") for (int n = 0; n < 2; ++n) _Pragma("unroll") for (int k = 0; k < 2; ++k) dst[n][k] = *(const LAS bf16x8*)(lds + PG8_SB(b, h) + boff + n * 2048 + k * 1024); } while (0)
#define PG8_CAT(x) __builtin_shufflevector(__builtin_bit_cast(i32x4, x[0]), __builtin_bit_cast(i32x4, x[1]), 0, 1, 2, 3, 4, 5, 6, 7)
#define PG8_MMA(ai, bj, At, Bt) do { __builtin_amdgcn_s_setprio(1); _Pragma("unroll") for (int m = 0; m < 4; ++m) _Pragma("unroll") for (int n = 0; n < 2; ++n) { \
        if constexpr (F8) { asm volatile("v_mfma_scale_f32_16x16x128_f8f6f4 %0, %1, %2, %0, %3, %4 op_sel_hi:[0,0,0]" : "+v"(acc[ai][bj][m][n]) : "v"(PG8_CAT(Bt[n])), "v"(PG8_CAT(At[m])), "v"(f8sw), "v"(f8so)); } \
        else { _Pragma("unroll") for (int k = 0; k < 2; ++k) acc[ai][bj][m][n] = __builtin_amdgcn_mfma_f32_16x16x32_bf16(Bt[n][k], At[m][k], acc[ai][bj][m][n], 0, 0, 0); } } \
        __builtin_amdgcn_s_setprio(0); } while (0)
#define PG8_WAIT_V(n) asm volatile("s_waitcnt vmcnt(" #n ")" ::: "memory")
#define PG8_WAIT_L(n) asm volatile("s_waitcnt lgkmcnt(" #n ")" ::: "memory")
#define PG8_BAR __builtin_amdgcn_s_barrier()
#define PG8_SCHED __builtin_amdgcn_sched_barrier(0)
#define PG8_AOFF(dst, i_, u_) do { _Pragma("unroll") for (int _i = 0; _i < 2; ++_i) { int _R, _C; stage_rc(tid * 16 + _i * 8192, _R, _C); _Pragma("unroll") for (int _h = 0; _h < 2; ++_h) \
        dst[_h][_i] = ((unsigned)S.arow(i_, u_, _h * HALF + _R) * (unsigned)K + (unsigned)_C) * 2u; } } while (0)
    Unit cur, nxt; int ui = 0;
    if (!S.next(0, cur)) return;
    int f8sw = g.sw, f8so = g.so;
    if constexpr (F8) asm volatile("" : "+v"(f8sw), "+v"(f8so));
    f32x4 acc[2][2][4][2];
#pragma unroll
    for (int a = 0; a < 2; ++a)
#pragma unroll
        for (int b = 0; b < 2; ++b)
#pragma unroll
            for (int m = 0; m < 4; ++m)
#pragma unroll
                for (int n = 0; n < 2; ++n) acc[a][b][m][n] = (f32x4){0.f, 0.f, 0.f, 0.f};
    bf16x8 At[4][2], B0[2][2], B1[2][2];
    unsigned voffA[2][2], v2[2][2];
    PG8_AOFF(voffA, 0, cur);
    const char* const cA = (const char*)g.A;
    const char* cB = (const char*)g.Bt + (size_t)cur.e * g.bstride + (size_t)cur.pn * tstep;
    PG8_STAGE(PG8_SB(0, 0), cB, voffB); PG8_STAGE(PG8_SB(0, 1), cB + hstep, voffB); PG8_STAGE(PG8_SA(0, 0), cA, voffA[0]); PG8_STAGE(PG8_SA(0, 1), cA, voffA[1]);
    if (wr == 1) PG8_BAR;
    PG8_WAIT_V(2); PG8_BAR;
    PG8_STAGE(PG8_SB(1, 0), cB + kstep, voffB); PG8_STAGE(PG8_SA(1, 0), cA + kstep, voffA[0]); PG8_STAGE(PG8_SB(1, 1), cB + hstep + kstep, voffB);
    PG8_WAIT_V(6); PG8_BAR;
    for (;;) {
        const bool has_next = S.next(ui + 1, nxt);
        const char* nB = has_next ? (const char*)g.Bt + (size_t)nxt.e * g.bstride + (size_t)nxt.pn * tstep : cB;
#pragma unroll 1
        for (int t = 0; t < nt; t += 2) {
            const bool last = (t == nt - 2);
            const char* a1 = cA + (size_t)(t + 1) * kstep;
            const char* a2 = last ? cA : cA + (size_t)(t + 2) * kstep; const char* b2 = last ? nB : cB + (size_t)(t + 2) * kstep;
            const char* a3 = a2 + kstep; const char* b3 = b2 + kstep;
            if (last && has_next) { PG8_AOFF(v2, ui + 1, nxt); }
            else {
#pragma unroll
                for (int h = 0; h < 2; ++h)
#pragma unroll
                    for (int i = 0; i < 2; ++i) v2[h][i] = voffA[h][i];
            }
            PG8_LDB(B0, 0, 0); PG8_LDB(B1, 0, 1); PG8_SCHED; PG8_LDA(At, 0, 0); PG8_STAGE(PG8_SA(1, 1), a1, voffA[1]);
            PG8_WAIT_V(8); PG8_WAIT_L(0); PG8_BAR; PG8_MMA(0, 0, At, B0); PG8_MMA(0, 1, At, B1); PG8_BAR; PG8_SCHED;
            PG8_LDA(At, 0, 1); PG8_STAGE(PG8_SB(0, 0), b2, voffB); PG8_STAGE(PG8_SB(0, 1), b2 + hstep, voffB); PG8_STAGE(PG8_SA(0, 0), a2, v2[0]);
            PG8_WAIT_V(8); PG8_WAIT_L(0); PG8_BAR; PG8_MMA(1, 0, At, B0); PG8_MMA(1, 1, At, B1); PG8_BAR; PG8_SCHED;
            PG8_LDB(B0, 1, 0); PG8_LDB(B1, 1, 1); PG8_SCHED; PG8_LDA(At, 1, 0); PG8_STAGE(PG8_SA(0, 1), a2, v2[1]);
            PG8_WAIT_V(8); PG8_WAIT_L(0); PG8_BAR; PG8_MMA(0, 0, At, B0); PG8_MMA(0, 1, At, B1); PG8_BAR; PG8_SCHED;
            PG8_LDA(At, 1, 1); PG8_STAGE(PG8_SB(1, 0), b3, voffB); PG8_STAGE(PG8_SB(1, 1), b3 + hstep, voffB); PG8_STAGE(PG8_SA(1, 0), a3, v2[0]);
            PG8_WAIT_V(8); PG8_WAIT_L(0); PG8_BAR; PG8_MMA(1, 0, At, B0); PG8_MMA(1, 1, At, B1); PG8_BAR; PG8_SCHED;
        }
        if constexpr (ALIGN_EPI) { if (wr == 0) PG8_BAR; }
        if constexpr (F8) asm volatile("s_nop 15\n\ts_nop 15" ::: "memory");
        E(acc, cur, ui, wr, wc, fr, fq);
        if (!has_next) break;
#pragma unroll
        for (int a = 0; a < 2; ++a)
#pragma unroll
            for (int b = 0; b < 2; ++b)
#pragma unroll
                for (int m = 0; m < 4; ++m)
#pragma unroll
                    for (int n = 0; n < 2; ++n) acc[a][b][m][n] = (f32x4){0.f, 0.f, 0.f, 0.f};
        cur = nxt; cB = nB; ++ui;
#pragma unroll
        for (int h = 0; h < 2; ++h)
#pragma unroll
            for (int i = 0; i < 2; ++i) voffA[h][i] = v2[h][i];
        if constexpr (ALIGN_EPI) { if (wr == 1) PG8_BAR; }
    }
    PG8_WAIT_V(0);
    if constexpr (!ALIGN_EPI) { if (wr == 0) PG8_BAR; }
    PG8_BAR;
#undef PG8_SA
#undef PG8_SB
#undef PG8_STAGE
#undef PG8_LDA
#undef PG8_LDB
#undef PG8_MMA
#undef PG8_CAT
#undef PG8_WAIT_V
#undef PG8_WAIT_L
#undef PG8_BAR
#undef PG8_SCHED
#undef PG8_AOFF
}

struct EpiProj {
    static constexpr bool PERM = true;
    bf16_t* O;
    __device__ __forceinline__ void operator()(const f32x4 (&acc)[2][2][4][2], const Unit& u, int, int wr, int wc, int fr, int fq) const {
        const int row0 = u.r0 + wr * 64 + fr, col0 = u.pn * BM + wc * 32 + 8 * fq;
#pragma unroll
        for (int ai = 0; ai < 2; ++ai)
#pragma unroll
            for (int m = 0; m < 4; ++m) { bf16_t* rowp = O + (size_t)(row0 + ai * HALF + m * 16) * INC + col0;
#pragma unroll
                for (int bj = 0; bj < 2; ++bj) { const f32x4 v0 = acc[ai][bj][m][0], v1 = acc[ai][bj][m][1];
                    u32x4 w; w.x = cvt_pk_bf16(v0[0], v0[1]); w.y = cvt_pk_bf16(v0[2], v0[3]); w.z = cvt_pk_bf16(v1[0], v1[1]); w.w = cvt_pk_bf16(v1[2], v1[3]);
                    *(u32x4*)(rowp + bj * HALF) = w; } }
    }
};
struct EpiX1 {
    static constexpr bool PERM = false;
    const float* x; const float* mod; bf16_t* X1;
    __device__ __forceinline__ void operator()(const f32x4 (&acc)[2][2][4][2], const Unit& u, int, int wr, int wc, int fr, int fq) const {
        const int row0 = u.r0 + wr * 64 + fr, col0 = u.pn * BM + wc * 32 + 4 * fq, b = u.r0 / SEQ;
        f32x4 gv[2][2];
#pragma unroll
        for (int bj = 0; bj < 2; ++bj)
#pragma unroll
            for (int n = 0; n < 2; ++n) gv[bj][n] = *(const f32x4*)(mod + b * NMOD + 2 * D_ + col0 + bj * HALF + n * 16);
#pragma unroll
        for (int ai = 0; ai < 2; ++ai)
#pragma unroll
            for (int mp = 0; mp < 2; ++mp) {
                f32x4 xv[2][2][2];
#pragma unroll
                for (int mm = 0; mm < 2; ++mm)
#pragma unroll
                    for (int bj = 0; bj < 2; ++bj)
#pragma unroll
                        for (int n = 0; n < 2; ++n) xv[mm][bj][n] = *(const f32x4*)(x + (size_t)(row0 + ai * HALF + (2 * mp + mm) * 16) * D_ + col0 + bj * HALF + n * 16);
                __builtin_amdgcn_sched_barrier(0);
#pragma unroll
                for (int mm = 0; mm < 2; ++mm)
#pragma unroll
                    for (int bj = 0; bj < 2; ++bj)
#pragma unroll
                        for (int n = 0; n < 2; ++n) { const int m = 2 * mp + mm; const f32x4 o = xv[mm][bj][n] + gv[bj][n] * acc[ai][bj][m][n];
                            u32x2 w; w.x = cvt_pk_bf16(o[0], o[1]); w.y = cvt_pk_bf16(o[2], o[3]);
                            *(u32x2*)(X1 + (size_t)(row0 + ai * HALF + m * 16) * D_ + col0 + bj * HALF + n * 16) = w; }
                __builtin_amdgcn_sched_barrier(0);
            }
    }
};
}

struct GroupedOrder : pg8::TileOrder {
    LAS const int* tiles; LAS const int* rowtab; LAS const int* pstart; int mode;
    __device__ __forceinline__ bool next(int i, pg8::Unit& u) const { int pm, pn; if (!tile(i, pm, pn)) return false; const int t = tiles[pm]; u.pm = pm; u.pn = pn; u.e = t & 255; u.r0 = (t >> 8) * 256; return true; }
    __device__ __forceinline__ int arow(int i, const pg8::Unit& u, int lr) const { return mode == 0 ? rowtab[i * 256 + lr] : pstart[u.e] + u.r0 + lr; }
};
__device__ __forceinline__ void grouped_prepare(GroupedOrder& S, LAS unsigned char* lds, const unsigned char* ws, int nN, int G, int c, int mode) {
    const int tid = threadIdx.x;
    LAS int* cnt = (LAS int*)(lds + L_CNT); LAS int* pstart = (LAS int*)(lds + L_PSTART); LAS int* tiles = (LAS int*)(lds + L_TILES); LAS int* rowtab = (LAS int*)(lds + L_ROWTAB); LAS int* pNT = (LAS int*)(lds + L_NT);
    const int* gcnt = (const int*)(ws + WS_CTL) + CW_CNT;
    if (tid < NE) cnt[tid] = __hip_atomic_load(gcnt + tid, __ATOMIC_RELAXED, __HIP_MEMORY_SCOPE_AGENT);
    __syncthreads();
    if (tid == 0) { int s = 0, nt = 0; for (int e = 0; e < NE; ++e) { pstart[e] = s; const int k = (cnt[e] + 255) >> 8; for (int j = 0; j < k; ++j) tiles[nt++] = e | (j << 8); s += k * 256; } pstart[NE] = s; *pNT = nt; }
    __syncthreads();
    S.init(*pNT, nN, G, c); S.tiles = tiles; S.rowtab = rowtab; S.pstart = pstart; S.mode = mode;
    const int* tokslot = (const int*)(ws + WS_TOKSLOT);
    int rv[MAX_UNITS];
#pragma unroll
    for (int i = 0; i < MAX_UNITS; ++i) {
        pg8::Unit u; const bool ok = S.next(i, u); rv[i] = (mode == 0) ? 0 : -1;
        if (ok && tid < 256) { const int rank = u.r0 + tid; if (rank < cnt[u.e]) rv[i] = tokslot[u.e * CAP + rank]; }
    }
    __builtin_amdgcn_sched_barrier(0);
#pragma unroll
    for (int i = 0; i < MAX_UNITS; ++i) {
        pg8::Unit u; const bool ok = S.next(i, u);
        if (ok && tid < 256) { const int rank = u.r0 + tid; rowtab[i * 256 + tid] = (rank < cnt[u.e]) ? (mode == 0 ? (rv[i] >> 2) : rv[i]) : (mode == 0 ? 0 : -1); }
    }
    __syncthreads();
}
struct EpiGateUp {
    static constexpr bool PERM = true;
    bf16_t* ACT; const float* bgu; LAS const int* pstart;
    __device__ __forceinline__ void operator()(const f32x4 (&acc)[2][2][4][2], const pg8::Unit& u, int, int wr, int wc, int fr, int fq) const {
        const int a0 = u.pn * 128 + wc * 32 + 8 * fq;
        const int prow0 = pstart[u.e] + u.r0 + wr * 64 + fr;
        f32x4 bb[4];
#pragma unroll
        for (int q = 0; q < 4; ++q) bb[q] = *(const f32x4*)(bgu + (size_t)u.e * 2 * FF + 2 * a0 + 4 * q);
#pragma unroll
        for (int ai = 0; ai < 2; ++ai)
#pragma unroll
            for (int m = 0; m < 4; ++m) {
                float o[8];
#pragma unroll
                for (int n = 0; n < 2; ++n)
#pragma unroll
                    for (int j = 0; j < 4; ++j) {
                        const int q = n * 4 + j;
                        float gate = acc[ai][0][m][n][j] + bb[q >> 1][(q & 1) * 2], lin = acc[ai][1][m][n][j] + bb[q >> 1][(q & 1) * 2 + 1];
                        gate = fminf(gate, 7.f); lin = fminf(fmaxf(lin, -7.f), 7.f);
                        const float glu = gate * __builtin_amdgcn_rcpf(1.f + __expf(-1.702f * gate));
                        o[q] = (lin + 1.f) * glu;
                    }
                if constexpr (DN_F8) {
                    int w0 = __builtin_amdgcn_cvt_pk_fp8_f32(o[0] * ASCALE, o[1] * ASCALE, 0, false); w0 = __builtin_amdgcn_cvt_pk_fp8_f32(o[2] * ASCALE, o[3] * ASCALE, w0, true);
                    int w1 = __builtin_amdgcn_cvt_pk_fp8_f32(o[4] * ASCALE, o[5] * ASCALE, 0, false); w1 = __builtin_amdgcn_cvt_pk_fp8_f32(o[6] * ASCALE, o[7] * ASCALE, w1, true);
                    u32x2 w; w.x = (unsigned)w0; w.y = (unsigned)w1;
                    *(u32x2*)((unsigned char*)ACT + (size_t)(prow0 + ai * 128 + m * 16) * FF + a0) = w;
                } else {
                    u32x4 w; w.x = pg8::cvt_pk_bf16(o[0], o[1]); w.y = pg8::cvt_pk_bf16(o[2], o[3]); w.z = pg8::cvt_pk_bf16(o[4], o[5]); w.w = pg8::cvt_pk_bf16(o[6], o[7]);
                    *(u32x4*)(ACT + (size_t)(prow0 + ai * 128 + m * 16) * FF + a0) = w;
                }
            }
    }
};
struct EpiNone { static constexpr bool PERM = true; __device__ __forceinline__ void operator()(const f32x4 (&acc)[2][2][4][2], const pg8::Unit&, int, int, int, int, int) const { asm volatile("" :: "v"(acc[0][0][0][0]), "v"(acc[1][1][3][1])); } };
struct EpiDown {
    static constexpr bool PERM = true;
    bf16_t* Y; const float* bd; LAS const int* rowtab;
    __device__ __forceinline__ void operator()(const f32x4 (&acc)[2][2][4][2], const pg8::Unit& u, int ui, int wr, int wc, int fr, int fq) const {
        const int col0 = u.pn * 256 + wc * 32 + 8 * fq;
        f32x4 bv[2][2];
#pragma unroll
        for (int bj = 0; bj < 2; ++bj)
#pragma unroll
            for (int n = 0; n < 2; ++n) bv[bj][n] = *(const f32x4*)(bd + (size_t)u.e * D_ + col0 + bj * 128 + 4 * n);
#pragma unroll
        for (int ai = 0; ai < 2; ++ai)
#pragma unroll
            for (int m = 0; m < 4; ++m) {
                const int slot = rowtab[ui * 256 + ai * 128 + wr * 64 + m * 16 + fr];
                if (slot >= 0) {
#pragma unroll
                    for (int bj = 0; bj < 2; ++bj) { const f32x4 v0 = acc[ai][bj][m][0] + bv[bj][0], v1 = acc[ai][bj][m][1] + bv[bj][1];
                        u32x4 w; w.x = pg8::cvt_pk_bf16(v0[0], v0[1]); w.y = pg8::cvt_pk_bf16(v0[2], v0[3]); w.z = pg8::cvt_pk_bf16(v1[0], v1[1]); w.w = pg8::cvt_pk_bf16(v1[2], v1[3]);
                        *(u32x4*)(Y + (size_t)slot * D_ + col0 + bj * 128) = w; }
                }
            }
    }
};


#define XB_TMO      128
#define XB_XCNT(j)  (256  + 64 * (j))
#define XB_XSUB(j)  (1280 + 64 * (j))
#define XB_XGEN(j)  (2304 + 64 * (j))
#define XB_TOP      3328
#define XB_TOPGEN   3392
#define XCD_BAR_WORDS 3456
#define XB_SPIN_CAP (1u << 18)
__device__ __forceinline__ unsigned xb_ld(unsigned* p)              { return __hip_atomic_load(p, __ATOMIC_RELAXED, __HIP_MEMORY_SCOPE_AGENT); }
__device__ __forceinline__ unsigned xb_add(unsigned* p, unsigned v) { return __hip_atomic_fetch_add(p, v, __ATOMIC_RELAXED, __HIP_MEMORY_SCOPE_AGENT); }
__device__ __forceinline__ unsigned xb_xcc_id() { return (unsigned)__builtin_amdgcn_s_getreg((3 << 11) | 20) & 0xFu; }
#define XB_SPIN(cond, bar) do { unsigned _sp = 0; while (cond) { __builtin_amdgcn_s_sleep(1); \
    if ((++_sp & 255u) == 0u) { if (xb_ld(&(bar)[XB_TMO])) break; if (_sp > XB_SPIN_CAP) { atomicAdd(&(bar)[XB_TMO], 1u); break; } } } } while (0)
struct XcdBarrier { unsigned* bar; unsigned x; volatile LAS unsigned* st; };
__device__ __forceinline__ XcdBarrier xcd_barrier_post(unsigned* bar, volatile LAS unsigned* st) {
    XcdBarrier b; b.bar = bar; b.x = xb_xcc_id(); b.st = st;
    if (threadIdx.x == 0) (void)xb_add(&bar[XB_XCNT(b.x)], 1u);
    return b;
}
__device__ __forceinline__ void xcd_barrier_complete(unsigned* bar, unsigned x, unsigned& nloc, unsigned& nx) {
    const unsigned G = gridDim.x * gridDim.y * gridDim.z;
    unsigned sum, cnt, mine, sp = 0u;
    for (;;) {
        sum = 0u; cnt = 0u; mine = 0u;
#pragma unroll
        for (unsigned j = 0; j < 16; ++j) { const unsigned c = xb_ld(&bar[XB_XCNT(j)]); sum += c; cnt += (c > 0u) ? 1u : 0u; mine = (j == x) ? c : mine; }
        if (sum == G) break;
        __builtin_amdgcn_s_sleep(1);
        if ((++sp & 255u) == 0u) { if (xb_ld(&bar[XB_TMO])) break; if (sp > XB_SPIN_CAP) { atomicAdd(&bar[XB_TMO], 1u); break; } }
    }
    nloc = mine > 0u ? mine : 1u; nx = cnt > 0u ? cnt : 1u;
}
__device__ __forceinline__ void xcd_barrier(const XcdBarrier& b) {
    asm volatile("s_waitcnt vmcnt(0)" ::: "memory");
    __syncthreads();
    if (threadIdx.x == 0) {
        unsigned* bar = b.bar;
        __builtin_amdgcn_s_waitcnt(0);
        unsigned nloc = b.st[0], nx = b.st[1];
        if (nloc == 0u) { xcd_barrier_complete(bar, b.x, nloc, nx); b.st[0] = nloc; b.st[1] = nx; }
        const unsigned old = xb_add(&bar[XB_XSUB(b.x)], 1u);
        const unsigned gen = old / nloc;
        if (old + 1u == (gen + 1u) * nloc) {
            __builtin_amdgcn_fence(__ATOMIC_RELEASE, "agent");
            asm volatile("s_waitcnt vmcnt(0)" ::: "memory");
            const unsigned og = xb_add(&bar[XB_TOP], 1u);
            const unsigned tg = og / nx;
            if (og + 1u == (tg + 1u) * nx) xb_add(&bar[XB_TOPGEN], 1u);
            else XB_SPIN(xb_ld(&bar[XB_TOPGEN]) == tg, bar);
            __builtin_amdgcn_fence(__ATOMIC_ACQUIRE, "agent");
            xb_add(&bar[XB_XGEN(b.x)], 1u);
            asm volatile("s_waitcnt vmcnt(0)" ::: "memory");
        } else {
            XB_SPIN(xb_ld(&bar[XB_XGEN(b.x)]) == gen, bar);
            __builtin_amdgcn_fence(__ATOMIC_ACQUIRE, "agent");
            asm volatile("s_waitcnt vmcnt(0)" ::: "memory");
        }
    }
    __syncthreads();
}

constexpr int TS = 136;
__device__ __forceinline__ void unpack8(const u32x4 w, float (&o)[16], int base) {
#pragma unroll
    for (int m = 0; m < 4; ++m) { o[base + 2 * m] = bf2f(w[m] & 0xffffu); o[base + 2 * m + 1] = bf2f(w[m] >> 16); }
}
__device__ __forceinline__ void load_krot(const bf16_t* PROJ, const float* rope, int t, int pos, int h, int q, float (&o1)[16], float (&o2)[16]) {
    const bf16_t* kp = PROJ + (size_t)t * INC + 1024 + h * 128 + 16 * q;
    const u32x4 r0 = *(const u32x4*)kp, r1 = *(const u32x4*)(kp + 8), r2 = *(const u32x4*)(kp + 64), r3 = *(const u32x4*)(kp + 72);
    const float* cp = rope + pos * 64 + 16 * q; const float* sp = cp + SEQ * 64;
    f32x4 c4[4], s4[4];
#pragma unroll
    for (int i4 = 0; i4 < 4; ++i4) { c4[i4] = *(const f32x4*)(cp + 4 * i4); s4[i4] = *(const f32x4*)(sp + 4 * i4); }
    __builtin_amdgcn_sched_barrier(0);
    float k1[16], k2[16];
    unpack8(r0, k1, 0); unpack8(r1, k1, 8); unpack8(r2, k2, 0); unpack8(r3, k2, 8);
    const float sc = 0.08838834764831845f;
#pragma unroll
    for (int i4 = 0; i4 < 4; ++i4) {
#pragma unroll
        for (int r = 0; r < 4; ++r) { const int i = 4 * i4 + r; o1[i] = (k1[i] * c4[i4][r] - k2[i] * s4[i4][r]) * sc; o2[i] = (k2[i] * c4[i4][r] + k1[i] * s4[i4][r]) * sc; }
    }
}
__device__ __forceinline__ void load_v32(const bf16_t* PROJ, int t, int h, int q, unsigned short (&v)[32]) {
    const bf16_t* vp = PROJ + (size_t)t * INC + 1536 + h * 128 + 32 * q;
#pragma unroll
    for (int c = 0; c < 4; ++c) { const u32x4 w = *(const u32x4*)(vp + 8 * c);
#pragma unroll
        for (int m = 0; m < 4; ++m) { v[8 * c + 2 * m] = (unsigned short)(w[m] & 0xffffu); v[8 * c + 2 * m + 1] = (unsigned short)(w[m] >> 16); } }
}

template <int W>
__device__ __forceinline__ void pool_fill(const bf16_t* PROJ, LAS bf16_t* P, int t0, int pos0, int g, int tid) {
    const int cp = tid & 63, seg = tid >> 6;
    const int tb = t0 + 16 * seg, pb = pos0 + 16 * seg;
    float v0[15 + W], v1[15 + W];
    unsigned raw[15 + W];
#pragma unroll
    for (int idx = 0; idx < 15 + W; ++idx) {
        const int dp = idx - (W - 1);
        const bool ok = (pb + dp >= 0);
        raw[idx] = *(const unsigned*)(PROJ + (size_t)(tb + (ok ? dp : -pb)) * INC + g * 128 + 2 * cp);
    }
    __builtin_amdgcn_sched_barrier(0);
#pragma unroll
    for (int idx = 0; idx < 15 + W; ++idx) {
        const int dp = idx - (W - 1);
        const unsigned u = (pb + dp >= 0) ? raw[idx] : 0u;
        v0[idx] = bf2f(u & 0xffffu); v1[idx] = bf2f(u >> 16);
    }
#pragma unroll
    for (int k = 0; k < 16; ++k) {
        float s0 = 0.f, s1 = 0.f;
#pragma unroll
        for (int q = 0; q < W; ++q) { s0 += v0[k + q]; s1 += v1[k + q]; }
        const int pos = pb + k; const float inv = 1.f / (float)((pos + 1 < W) ? pos + 1 : W);
        *(LAS unsigned*)(P + (16 * seg + k) * TS + 2 * cp) = pk2(s0 * inv - v0[k + W - 1], s1 * inv - v1[k + W - 1]);
    }
}
__device__ __forceinline__ void pool_unit(const Args& a, LAS unsigned char* lds, int u) {
    const int tid = threadIdx.x, lane = tid & 63, wave = __builtin_amdgcn_readfirstlane(tid >> 6), fr = lane & 15, fq = lane >> 4;
    const int chunk = u >> 2, g = u & 3, t0 = chunk * 128, pos0 = t0 % SEQ;
    const bf16_t* PROJ = (const bf16_t*)(a.ws + WS_PROJ); const bf16_t* PWT = (const bf16_t*)(a.ws + WS_POOLWT); bf16_t* MIXIN = (bf16_t*)(a.ws + WS_MIXIN);
    LAS bf16_t* P = (LAS bf16_t*)lds;
    if (g == 0) pool_fill<2>(PROJ, P, t0, pos0, g, tid); else if (g == 1) pool_fill<4>(PROJ, P, t0, pos0, g, tid); else if (g == 2) pool_fill<8>(PROJ, P, t0, pos0, g, tid); else pool_fill<16>(PROJ, P, t0, pos0, g, tid);
    __syncthreads();
    f32x4 acc[8];
#pragma unroll
    for (int nt = 0; nt < 8; ++nt) acc[nt] = (f32x4){0.f, 0.f, 0.f, 0.f};
#pragma unroll
    for (int ks = 0; ks < 4; ++ks) {
        const bf16x8 af = *(const LAS bf16x8*)(P + (16 * wave + fr) * TS + 32 * ks + 8 * fq);
#pragma unroll
        for (int nt = 0; nt < 8; ++nt) { const bf16x8 bf = *(const bf16x8*)(PWT + (size_t)(g * 128 + 16 * nt + fr) * 128 + 32 * ks + 8 * fq); acc[nt] = MFMA16(bf, af, acc[nt]); }
    }
    const int t = t0 + 16 * wave + fr;
#pragma unroll
    for (int nt = 0; nt < 8; ++nt) {
        const int ch = g * 128 + 16 * nt + 4 * fq;
        const f32x4 pb = *(const f32x4*)(a.in[7] + ch), ps = *(const f32x4*)(a.in[8] + ch);
        const f32x4 o = (acc[nt] + pb) * ps;
        u32x2 w; w.x = pk2(o[0], o[1]); w.y = pk2(o[2], o[3]);
        *(u32x2*)(MIXIN + (size_t)t * D_ + ch) = w;
    }
    __syncthreads();
}
__device__ __forceinline__ void kv_unit(const Args& a, LAS unsigned char* lds, int u) {
    const int tid = threadIdx.x, lane = tid & 63, wave = __builtin_amdgcn_readfirstlane(tid >> 6), fr = lane & 15, fq = lane >> 4;
    const int bh = u / 15, n = u % 15, b = bh >> 2, h = bh & 3, t0 = b * SEQ + n * 128, pos0 = n * 128;
    const bf16_t* PROJ = (const bf16_t*)(a.ws + WS_PROJ); const float* rope = (const float*)(a.ws + WS_ROPE); float* KVT = (float*)(a.ws + WS_KVT);
    LAS bf16_t* Kt = (LAS bf16_t*)lds; LAS bf16_t* Vt = Kt + 128 * TS;
    const float l2g = log2_gamma(h);
    {
        const int j = tid >> 2, q = tid & 3;
        unsigned short v[32]; load_v32(PROJ, t0 + j, h, q, v);
        float o1[16], o2[16]; load_krot(PROJ, rope, t0 + j, pos0 + j, h, q, o1, o2);
        const float kd = exp2f((float)(127 - j) * l2g);
#pragma unroll
        for (int i = 0; i < 16; ++i) { Kt[(16 * q + i) * TS + j] = (bf16_t)f2bf(o1[i] * kd); Kt[(64 + 16 * q + i) * TS + j] = (bf16_t)f2bf(o2[i] * kd); }
#pragma unroll
        for (int i = 0; i < 32; ++i) Vt[(32 * q + i) * TS + j] = v[i];
    }
    __syncthreads();
    f32x4 acc[8];
#pragma unroll
    for (int dt = 0; dt < 8; ++dt) acc[dt] = (f32x4){0.f, 0.f, 0.f, 0.f};
#pragma unroll
    for (int ks = 0; ks < 4; ++ks) {
        const bf16x8 vf = *(const LAS bf16x8*)(Vt + (16 * wave + fr) * TS + 32 * ks + 8 * fq);
#pragma unroll
        for (int dt = 0; dt < 8; ++dt) { const bf16x8 kf = *(const LAS bf16x8*)(Kt + (16 * dt + fr) * TS + 32 * ks + 8 * fq); acc[dt] = MFMA16(kf, vf, acc[dt]); }
    }
    float* op = KVT + ((size_t)(bh * 15 + n) << 14) + (size_t)(16 * wave + fr) * 128 + 4 * fq;
#pragma unroll
    for (int dt = 0; dt < 8; ++dt) *(f32x4*)(op + 16 * dt) = acc[dt];
    __syncthreads();
}
__device__ __forceinline__ void phase_scan(const Args& a, int vb, int G) {
    const float* KVT = (const float*)(a.ws + WS_KVT); bf16_t* RT = (bf16_t*)(a.ws + WS_RT);
    for (int i = vb * 512 + threadIdx.x; i < 32 * 4096; i += G * 512) {
        const int bh = i >> 12, ed = (i & 4095) * 4, h = bh & 3;
        const float cd = exp2f(128.f * log2_gamma(h)); f32x4 R = (f32x4){0.f, 0.f, 0.f, 0.f};
        f32x4 kv[15];
#pragma unroll
        for (int n = 0; n < 15; ++n) kv[n] = *(const f32x4*)(KVT + ((size_t)(bh * 15 + n) << 14) + ed);
#pragma unroll
        for (int n = 0; n < 16; ++n) {
            u32x2 w; w.x = pk2(R[0], R[1]); w.y = pk2(R[2], R[3]);
            *(u32x2*)(RT + ((size_t)(bh * 16 + n) << 14) + ed) = w;
            if (n < 15) R = R * cd + kv[n];
        }
    }
}
__device__ __forceinline__ bf16x8 pack8(const float (&v)[8]) {
    u32x4 w; w.x = pk2(v[0], v[1]); w.y = pk2(v[2], v[3]); w.z = pk2(v[4], v[5]); w.w = pk2(v[6], v[7]);
    return __builtin_bit_cast(bf16x8, w);
}
__device__ __forceinline__ void ret_unit(const Args& a, LAS unsigned char* lds, int u) {
    const int tid = threadIdx.x, lane = tid & 63, wave = __builtin_amdgcn_readfirstlane(tid >> 6), fr = lane & 15, fq = lane >> 4;
    const int bh = u >> 4, n = u & 15, b = bh >> 2, h = bh & 3, t0 = b * SEQ + n * 128, pos0 = n * 128;
    const bf16_t* PROJ = (const bf16_t*)(a.ws + WS_PROJ); const float* rope = (const float*)(a.ws + WS_ROPE); const bf16_t* RT = (const bf16_t*)(a.ws + WS_RT); bf16_t* MIXIN = (bf16_t*)(a.ws + WS_MIXIN);
    LAS bf16_t* Kn = (LAS bf16_t*)lds; LAS bf16_t* Vt = Kn + 128 * TS; LAS bf16_t* Rt = Vt + 128 * TS;
    const float l2g = log2_gamma(h);
    const int j = tid >> 2, q = tid & 3;
    const int il = 16 * wave + fr, t = t0 + il, pos = pos0 + il;
    const bf16_t* kp = PROJ + (size_t)(t0 + j) * INC + 1024 + h * 128 + 16 * q;
    const u32x4 kr0 = *(const u32x4*)kp, kr1 = *(const u32x4*)(kp + 8), kr2 = *(const u32x4*)(kp + 64), kr3 = *(const u32x4*)(kp + 72);
    const float* kcp = rope + (pos0 + j) * 64 + 16 * q; const float* ksp = kcp + SEQ * 64;
    f32x4 kc[4], ks_[4];
#pragma unroll
    for (int i4 = 0; i4 < 4; ++i4) { kc[i4] = *(const f32x4*)(kcp + 4 * i4); ks_[i4] = *(const f32x4*)(ksp + 4 * i4); }
    const bf16_t* vp = PROJ + (size_t)(t0 + j) * INC + 1536 + h * 128 + 32 * q;
    u32x4 vr[4];
#pragma unroll
    for (int c = 0; c < 4; ++c) vr[c] = *(const u32x4*)(vp + 8 * c);
    u32x4 rr[4];
    if (n > 0) { const bf16_t* rp = RT + ((size_t)(bh * 16 + n) << 14) + j * 128 + 32 * q;
#pragma unroll
        for (int c = 0; c < 4; ++c) rr[c] = *(const u32x4*)(rp + 8 * c); }
    const bf16_t* qp = PROJ + (size_t)t * INC + 512 + h * 128 + 8 * fq;
    const u32x4 qr0 = *(const u32x4*)(qp), qr1 = *(const u32x4*)(qp + 32), qr2 = *(const u32x4*)(qp + 64), qr3 = *(const u32x4*)(qp + 96);
    f32x4 qc[2][2], qs[2][2];
#pragma unroll
    for (int ks = 0; ks < 2; ++ks) { const float* cp = rope + pos * 64 + 32 * ks + 8 * fq; const float* sp = cp + SEQ * 64;
#pragma unroll
        for (int i4 = 0; i4 < 2; ++i4) { qc[ks][i4] = *(const f32x4*)(cp + 4 * i4); qs[ks][i4] = *(const f32x4*)(sp + 4 * i4); } }
    u32x2 gw[8];
#pragma unroll
    for (int et = 0; et < 8; ++et) gw[et] = *(const u32x2*)(PROJ + (size_t)t * INC + 2048 + h * 128 + 16 * et + 4 * fq);
    __builtin_amdgcn_sched_barrier(0);
    {
        float k1[16], k2[16], o1[16], o2[16];
        unpack8(kr0, k1, 0); unpack8(kr1, k1, 8); unpack8(kr2, k2, 0); unpack8(kr3, k2, 8);
        const float sc = 0.08838834764831845f;
#pragma unroll
        for (int i4 = 0; i4 < 4; ++i4)
#pragma unroll
            for (int r = 0; r < 4; ++r) { const int i = 4 * i4 + r; o1[i] = (k1[i] * kc[i4][r] - k2[i] * ks_[i4][r]) * sc; o2[i] = (k2[i] * kc[i4][r] + k1[i] * ks_[i4][r]) * sc; }
        u32x4 w;
        w.x = pk2(o1[0], o1[1]); w.y = pk2(o1[2], o1[3]); w.z = pk2(o1[4], o1[5]); w.w = pk2(o1[6], o1[7]); *(LAS u32x4*)(Kn + j * TS + 16 * q) = w;
        w.x = pk2(o1[8], o1[9]); w.y = pk2(o1[10], o1[11]); w.z = pk2(o1[12], o1[13]); w.w = pk2(o1[14], o1[15]); *(LAS u32x4*)(Kn + j * TS + 16 * q + 8) = w;
        w.x = pk2(o2[0], o2[1]); w.y = pk2(o2[2], o2[3]); w.z = pk2(o2[4], o2[5]); w.w = pk2(o2[6], o2[7]); *(LAS u32x4*)(Kn + j * TS + 64 + 16 * q) = w;
        w.x = pk2(o2[8], o2[9]); w.y = pk2(o2[10], o2[11]); w.z = pk2(o2[12], o2[13]); w.w = pk2(o2[14], o2[15]); *(LAS u32x4*)(Kn + j * TS + 64 + 16 * q + 8) = w;
#pragma unroll
        for (int c = 0; c < 4; ++c)
#pragma unroll
            for (int m = 0; m < 4; ++m) { Vt[(32 * q + 8 * c + 2 * m) * TS + j] = (bf16_t)(vr[c][m] & 0xffffu); Vt[(32 * q + 8 * c + 2 * m + 1) * TS + j] = (bf16_t)(vr[c][m] >> 16); }
        if (n > 0) {
#pragma unroll
            for (int c = 0; c < 4; ++c) *(LAS u32x4*)(Rt + j * TS + 32 * q + 8 * c) = rr[c];
        }
    }
    bf16x8 qf[4];
    {
        float qa[16], qb[16];
        unpack8(qr0, qa, 0); unpack8(qr1, qa, 8); unpack8(qr2, qb, 0); unpack8(qr3, qb, 8);
#pragma unroll
        for (int ks = 0; ks < 2; ++ks) {
            float y1[8], y2[8];
#pragma unroll
            for (int i4 = 0; i4 < 2; ++i4)
#pragma unroll
                for (int r = 0; r < 4; ++r) { const int i = 4 * i4 + r; const float x1 = qa[8 * ks + i], x2 = qb[8 * ks + i]; y1[i] = x1 * qc[ks][i4][r] - x2 * qs[ks][i4][r]; y2[i] = x2 * qc[ks][i4][r] + x1 * qs[ks][i4][r]; }
            qf[ks] = pack8(y1); qf[ks + 2] = pack8(y2);
        }
    }
    __syncthreads();
    f32x4 acc[8];
#pragma unroll
    for (int et = 0; et < 8; ++et) acc[et] = (f32x4){0.f, 0.f, 0.f, 0.f};
    if (n > 0) {
#pragma unroll
        for (int ks = 0; ks < 4; ++ks)
#pragma unroll
            for (int et = 0; et < 8; ++et) acc[et] = MFMA16(*(const LAS bf16x8*)(Rt + (16 * et + fr) * TS + 32 * ks + 8 * fq), qf[ks], acc[et]);
        const float qd = exp2f((float)(il + 1) * l2g);
#pragma unroll
        for (int et = 0; et < 8; ++et) acc[et] *= qd;
    }
#pragma unroll
    for (int ks2 = 0; ks2 < 4; ++ks2) {
        if (2 * ks2 <= wave) {
            float sv[8];
#pragma unroll
            for (int tt = 0; tt < 2; ++tt) {
                const int jt = 2 * ks2 + tt;
                f32x4 sacc = (f32x4){0.f, 0.f, 0.f, 0.f};
                if (jt <= wave) {
#pragma unroll
                    for (int ks = 0; ks < 4; ++ks) sacc = MFMA16(*(const LAS bf16x8*)(Kn + (16 * jt + fr) * TS + 32 * ks + 8 * fq), qf[ks], sacc);
                }
#pragma unroll
                for (int r = 0; r < 4; ++r) { const int diff = il - (16 * jt + 4 * fq + r); sv[4 * tt + r] = (diff >= 0) ? sacc[r] * exp2f((float)diff * l2g) : 0.f; }
            }
            const bf16x8 sf = pack8(sv);
#pragma unroll
            for (int et = 0; et < 8; ++et) {
                const LAS bf16_t* vq = Vt + (16 * et + fr) * TS + 32 * ks2 + 4 * fq;
                const u32x2 lo = *(const LAS u32x2*)vq, hi = *(const LAS u32x2*)(vq + 16);
                u32x4 vw; vw.x = lo.x; vw.y = lo.y; vw.z = hi.x; vw.w = hi.y;
                acc[et] = MFMA16(__builtin_bit_cast(bf16x8, vw), sf, acc[et]);
            }
        }
    }
    float sm = 0.f;
#pragma unroll
    for (int et = 0; et < 8; ++et) sm += (acc[et][0] + acc[et][1]) + (acc[et][2] + acc[et][3]);
    sm += __shfl_xor(sm, 16); sm += __shfl_xor(sm, 32);
    const float mu = sm * (1.f / 128.f);
    float sq = 0.f;
#pragma unroll
    for (int et = 0; et < 8; ++et) { const f32x4 d = acc[et] - mu; sq += (d[0] * d[0] + d[1] * d[1]) + (d[2] * d[2] + d[3] * d[3]); }
    sq += __shfl_xor(sq, 16); sq += __shfl_xor(sq, 32);
    const float rs = 1.f / sqrtf(sq * (1.f / 128.f) + EPS);
#pragma unroll
    for (int et = 0; et < 8; ++et) {
        const int c = h * 128 + 16 * et + 4 * fq;
        const f32x4 gn = *(const f32x4*)(a.in[9] + c);
        const float g0 = bf2f(gw[et].x & 0xffffu), g1 = bf2f(gw[et].x >> 16), g2 = bf2f(gw[et].y & 0xffffu), g3 = bf2f(gw[et].y >> 16);
        const f32x4 d = (acc[et] - mu) * rs * gn;
        u32x2 w; w.x = pk2(silu_f(g0) * d[0], silu_f(g1) * d[1]); w.y = pk2(silu_f(g2) * d[2], silu_f(g3) * d[3]);
        *(u32x2*)(MIXIN + (size_t)t * D_ + 512 + c) = w;
    }
    __syncthreads();
}

constexpr int HST = 1026;
constexpr int R_H = 0, R_PART = 65792, R_LOGIT = R_PART + 16384, R_PE = R_LOGIT + 2048, R_PW = R_PE + 1024, R_PL = R_PW + 1024, R_HIST = R_PL + 1024, R_BASE = R_HIST + 128;
static_assert(16 * HST * 4 <= R_PART && R_BASE + 128 <= RING_BYTES, "router LDS map");
__device__ __forceinline__ void phase_router(const Args& a, LAS unsigned char* lds, int vb, int G) {
    const int tid = threadIdx.x, lane = tid & 63, wave = __builtin_amdgcn_readfirstlane(tid >> 6), fr = lane & 15, fq = lane >> 4;
    unsigned char* ws = a.ws;
    const bf16_t* X1 = (const bf16_t*)(ws + WS_X1); const float* mod = (const float*)(ws + WS_MOD); bf16_t* HN = (bf16_t*)(ws + WS_HN);
    LAS float* H = (LAS float*)(lds + R_H); LAS float* part = (LAS float*)(lds + R_PART); LAS float* logit = (LAS float*)(lds + R_LOGIT);
    LAS int* pe = (LAS int*)(lds + R_PE); LAS float* pw = (LAS float*)(lds + R_PW); LAS int* pl = (LAS int*)(lds + R_PL); LAS int* hist = (LAS int*)(lds + R_HIST); LAS int* base = (LAS int*)(lds + R_BASE);
    const int RPB = T_ / G, row0 = vb * RPB, b = row0 / SEQ;
    float wreg[32][2];
#pragma unroll
    for (int kk = 0; kk < 32; ++kk)
#pragma unroll
        for (int nt = 0; nt < 2; ++nt) wreg[kk][nt] = a.in[12][(size_t)(128 * wave + 4 * kk + fq) * NE + 16 * nt + fr];
    if (tid < NE) hist[tid] = 0;
    const float* sh = mod + b * NMOD + 3 * D_; const float* sc = mod + b * NMOD + 4 * D_;
    for (int sub = 0; sub < RPB / 16; ++sub) {
#pragma unroll
        for (int rr = 0; rr < 2; ++rr) {
            const int lr = 2 * wave + rr, r = row0 + sub * 16 + lr;
            const u32x2* xr = (const u32x2*)(X1 + (size_t)r * D_) + lane;
            f32x4 v[4]; float ss = 0.f;
#pragma unroll
            for (int j = 0; j < 4; ++j) { const u32x2 w = xr[64 * j]; v[j] = (f32x4){bf2f(w.x & 0xffffu), bf2f(w.x >> 16), bf2f(w.y & 0xffffu), bf2f(w.y >> 16)}; ss += (v[j].x * v[j].x + v[j].y * v[j].y) + (v[j].z * v[j].z + v[j].w * v[j].w); }
            const float rs = 1.f / sqrtf(wave_sum(ss) * (1.f / D_) + EPS);
#pragma unroll
            for (int j = 0; j < 4; ++j) {
                const int c0 = 4 * lane + 256 * j;
                const f32x4 g = *(const f32x4*)(a.in[11] + c0), s1 = *(const f32x4*)(sc + c0), s0 = *(const f32x4*)(sh + c0);
                const f32x4 hv = v[j] * rs * g * (1.f + s1) + s0;
                if constexpr (GU_F8) { int w8 = __builtin_amdgcn_cvt_pk_fp8_f32(hv[0], hv[1], 0, false); w8 = __builtin_amdgcn_cvt_pk_fp8_f32(hv[2], hv[3], w8, true); *(int*)((unsigned char*)HN + (size_t)r * D_ + c0) = w8; }
                else *(unsigned long long*)(HN + (size_t)r * D_ + c0) = (unsigned long long)pk2(hv[0], hv[1]) | ((unsigned long long)pk2(hv[2], hv[3]) << 32);
                LAS float* hp = H + lr * HST + c0; hp[0] = hv[0]; hp[1] = hv[1]; hp[2] = hv[2]; hp[3] = hv[3];
            }
        }
        __syncthreads();
        f32x4 lacc[2] = {(f32x4){0.f, 0.f, 0.f, 0.f}, (f32x4){0.f, 0.f, 0.f, 0.f}};
#pragma unroll
        for (int kk = 0; kk < 32; ++kk) {
            const float av = H[fr * HST + 128 * wave + 4 * kk + fq];
            lacc[0] = __builtin_amdgcn_mfma_f32_16x16x4f32(av, wreg[kk][0], lacc[0], 0, 0, 0);
            lacc[1] = __builtin_amdgcn_mfma_f32_16x16x4f32(av, wreg[kk][1], lacc[1], 0, 0, 0);
        }
#pragma unroll
        for (int nt = 0; nt < 2; ++nt)
#pragma unroll
            for (int r = 0; r < 4; ++r) part[(wave * 16 + 4 * fq + r) * 32 + 16 * nt + fr] = lacc[nt][r];
        __syncthreads();
        {
            const int tk = tid >> 5, e = tid & 31; float s = a.in[13][e];
#pragma unroll
            for (int w = 0; w < 8; ++w) s += part[(w * 16 + tk) * 32 + e];
            logit[tk * 32 + e] = s;
        }
        __syncthreads();
        if (tid < 16) {
            float v[NE];
#pragma unroll
            for (int e = 0; e < NE; ++e) v[e] = logit[tid * 32 + e];
            float tv[4]; int ti[4];
#pragma unroll
            for (int k = 0; k < 4; ++k) {
                float best = -INFINITY; int bi = 0;
#pragma unroll
                for (int e = 0; e < NE; ++e) if (v[e] > best) { best = v[e]; bi = e; }
                tv[k] = best; ti[k] = bi;
#pragma unroll
                for (int e = 0; e < NE; ++e) if (e == bi) v[e] = -INFINITY;
            }
            float ex[4], se = 0.f;
#pragma unroll
            for (int k = 0; k < 4; ++k) { ex[k] = __expf(tv[k] - tv[0]); se += ex[k]; }
            const float inv = 1.f / se;
#pragma unroll
            for (int k = 0; k < 4; ++k) { const int pi = (sub * 16 + tid) * 4 + k; pe[pi] = ti[k]; pw[pi] = ex[k] * inv; }
        }
        __syncthreads();
    }
    const int npair = RPB * 4;
    if (tid < npair) pl[tid] = atomicAdd((int*)(hist + pe[tid]), 1);
    __syncthreads();
    if (tid < NE) base[tid] = (int)__hip_atomic_fetch_add((int*)(ws + WS_CTL) + CW_CNT + tid, hist[tid], __ATOMIC_RELAXED, __HIP_MEMORY_SCOPE_AGENT);
    __syncthreads();
    if (tid < npair) {
        const int e = pe[tid], slot = row0 * 4 + tid;
        ((int*)(ws + WS_TOKSLOT))[e * CAP + base[e] + pl[tid]] = slot;
        ((float*)(ws + WS_WSLOT))[slot] = pw[tid];
    }
    __syncthreads();
}
__device__ __forceinline__ void phase_final(const Args& a, int vb, int G) {
    const int tid = threadIdx.x, lane = tid & 63, wave = tid >> 6;
    const bf16_t* X1 = (const bf16_t*)(a.ws + WS_X1); const bf16_t* Y = (const bf16_t*)(a.ws + WS_Y); const float* wslot = (const float*)(a.ws + WS_WSLOT); const float* mod = (const float*)(a.ws + WS_MOD);
    for (int r = vb * NWAVES + wave; r < T_; r += G * NWAVES) {
        const int b = r / SEQ; const float* gt2 = mod + b * NMOD + 5 * D_;
        float w[4];
#pragma unroll
        for (int k = 0; k < 4; ++k) w[k] = wslot[r * 4 + k];
        f32x4 v[4]; float ss = 0.f;
#pragma unroll
        for (int j = 0; j < 4; ++j) {
            const int c0 = 4 * lane + 256 * j;
            f32x4 f = (f32x4){0.f, 0.f, 0.f, 0.f};
#pragma unroll
            for (int k = 0; k < 4; ++k) {
                const u32x2 y = *(const u32x2*)(Y + (size_t)(r * 4 + k) * D_ + c0);
                f.x += w[k] * bf2f(y.x & 0xffffu); f.y += w[k] * bf2f(y.x >> 16); f.z += w[k] * bf2f(y.y & 0xffffu); f.w += w[k] * bf2f(y.y >> 16);
            }
            const u32x2 xw = *(const u32x2*)(X1 + (size_t)r * D_ + c0); const f32x4 x1 = (f32x4){bf2f(xw.x & 0xffffu), bf2f(xw.x >> 16), bf2f(xw.y & 0xffffu), bf2f(xw.y >> 16)}; const f32x4 g = *(const f32x4*)(gt2 + c0);
            v[j] = x1 + g * f;
            ss += (v[j].x * v[j].x + v[j].y * v[j].y) + (v[j].z * v[j].z + v[j].w * v[j].w);
        }
        const float rs = 1.f / sqrtf(wave_sum(ss) * (1.f / D_) + EPS);
#pragma unroll
        for (int j = 0; j < 4; ++j) { const int c0 = 4 * lane + 256 * j; const f32x4 g = *(const f32x4*)(a.in[18] + c0); *(f32x4*)(a.out + (size_t)r * D_ + c0) = v[j] * rs * g; }
    }
}

__global__ void __launch_bounds__(512, 2) mega(Args a) {
    extern __shared__ __attribute__((aligned(16))) unsigned char lds_raw[];
    LAS unsigned char* lds = (LAS unsigned char*)lds_raw;
    const int G = gridDim.x, bx = blockIdx.x;
    const int vb = (G % 8 == 0) ? (bx % 8) * (G / 8) + bx / 8 : bx;
    unsigned char* ws = a.ws;
    for (int u = threadIdx.x; u < (LDS_BYTES - LDSCTL_OFF) / 4; u += 512) ((LAS unsigned*)(lds + LDSCTL_OFF))[u] = 0u;
    __syncthreads();
    const bool multi = (a.ph_hi - a.ph_lo) > 1;
    XcdBarrier bar; bar.bar = (unsigned*)(ws + WS_CTL) + CW_BAR; bar.x = 0; bar.st = nullptr;
    if (multi) bar = xcd_barrier_post((unsigned*)(ws + WS_CTL) + CW_BAR, (volatile LAS unsigned*)(lds + L_MISC) + 8);
#define SEAM(k) do { if (IN(k) && IN((k) + 1)) xcd_barrier(bar); } while (0)
#define IN(k) (a.ph_lo <= (k) && (k) < a.ph_hi)
    if (IN(0)) phase_p0(a, lds, vb, G);
    SEAM(0);
    if (IN(1)) phase_p1(a, lds, vb, G);
    SEAM(1);
    if (IN(2)) {
        pg8::Gemm g{(const bf16_t*)(ws + WS_XN), (const bf16_t*)(ws + WS_WINT), INC, D_, 0, 127, 127};
        pg8::DenseOrder S; S.init(T_ / 256, INC / 256, G, bx);
        pg8::EpiProj E{(bf16_t*)(ws + WS_PROJ)};
        conv_chunks(a, lds, bx & 7, (bx >= 128) ? CONV_PRE : 0);
        pg8::gemm_phase<pg8::EpiProj, pg8::DenseOrder, true>(lds, g, S, E);
        conv_chunks(a, lds, bx & 7, 1 << 30);
    }
    SEAM(2);
    if (IN(3)) { for (int L = vb; L < 512 + 480; L += G) { if (L < 512) pool_unit(a, lds, L); else kv_unit(a, lds, L - 512); } }
    SEAM(3);
    if (IN(4)) phase_scan(a, vb, G);
    SEAM(4);
#if EXTRA_BARRIERS
    if (multi) { for (int xb = 0; xb < EXTRA_BARRIERS; ++xb) xcd_barrier(bar); }
#endif
    if (IN(5)) { for (int L = vb; L < 512; L += G) ret_unit(a, lds, L); }
    SEAM(5);
    if (IN(6)) {
        pg8::Gemm g{(const bf16_t*)(ws + WS_MIXIN), (const bf16_t*)(ws + WS_WOUTT), D_, D_, 0, 127, 127};
        pg8::DenseOrder S; S.init(T_ / 256, D_ / 256, G, bx);
        pg8::EpiX1 E{a.in[0], (const float*)(ws + WS_MOD), (bf16_t*)(ws + WS_X1)};
        pg8::gemm_phase<pg8::EpiX1, pg8::DenseOrder, true>(lds, g, S, E);
    }
    SEAM(6);
    if (IN(7)) phase_router(a, lds, vb, G);
    SEAM(7);
    if (IN(8)) {
        GroupedOrder S; grouped_prepare(S, lds, ws, 2 * FF / 256, G, bx, 0);
        pg8::Gemm g{(const bf16_t*)(ws + WS_HN), (const bf16_t*)(ws + WS_WGUT), 2 * FF, D_, (size_t)2 * FF * D_ * (GU_F8 ? 1 : 2), SCALE_W, SCALE_ONE};
        EpiGateUp E{(bf16_t*)(ws + WS_ACT), a.in[15], (LAS const int*)(lds + L_PSTART)};
        pg8::gemm_phase<EpiGateUp, GroupedOrder, true, GU_F8>(lds, g, S, E);
    }
    SEAM(8);
    if (IN(9)) {
        GroupedOrder S; grouped_prepare(S, lds, ws, D_ / 256, G, bx, 1);
        pg8::Gemm g{(const bf16_t*)(ws + WS_ACT), (const bf16_t*)(ws + WS_WDT), D_, FF, (size_t)D_ * FF * (DN_F8 ? 1 : 2), SCALE_W, SCALE_ACT};
        EpiDown E{(bf16_t*)(ws + WS_Y), a.in[17], (LAS const int*)(lds + L_ROWTAB)};
        pg8::gemm_phase<EpiDown, GroupedOrder, true, DN_F8>(lds, g, S, E);
    }
    SEAM(9);
    if (IN(10)) phase_final(a, vb, G);
#if REPEAT_MASK & 196608
    if (IN(16)) { if (bx >= 128) conv_chunks(a, lds, bx & 7, 1 << 30); }
    if (IN(17)) { conv_chunks(a, lds, bx & 7, 1 << 30); }
#endif
#if REPEAT_MASK & 24576
    if (IN(13)) { for (int L = vb; L < 512; L += G) pool_unit(a, lds, L); }
    if (IN(14)) { for (int L = vb; L < 480; L += G) kv_unit(a, lds, L); }
#endif
#if REPEAT_MASK & 6144
    if (IN(11)) {
        GroupedOrder S; grouped_prepare(S, lds, ws, 2 * FF / 256, G, bx, 0);
        pg8::Gemm g{(const bf16_t*)(ws + WS_HN), (const bf16_t*)(ws + WS_WGUT), 2 * FF, D_, (size_t)2 * FF * D_ * (GU_F8 ? 1 : 2), SCALE_W, SCALE_ONE};
        EpiNone E;
        pg8::gemm_phase<EpiNone, GroupedOrder, true, GU_F8>(lds, g, S, E);
    }
    if (IN(12)) {
        GroupedOrder S; grouped_prepare(S, lds, ws, D_ / 256, G, bx, 1);
        pg8::Gemm g{(const bf16_t*)(ws + WS_ACT), (const bf16_t*)(ws + WS_WDT), D_, FF, (size_t)D_ * FF * (DN_F8 ? 1 : 2), SCALE_W, SCALE_ACT};
        EpiNone E;
        pg8::gemm_phase<EpiNone, GroupedOrder, true, DN_F8>(lds, g, S, E);
    }
#endif
#undef SEAM
#undef IN
}

extern "C" void kernel_launch(void* const* d_in, const int* in_sizes, int n_in, void* d_out, int out_size, void* d_ws, size_t ws_size, hipStream_t stream) {
    static int grid = 0;
    if (grid == 0) {
        if (n_in != 19 || in_sizes[0] != T_ * D_ || out_size != T_ * D_ || ws_size < WS_END) { fprintf(stderr, "kernel_launch: unexpected shapes / workspace (n_in %d, ws %zu)\n", n_in, ws_size); grid = -1; return; }
        int dev = 0, cus = 0, per_cu = 0;
        if (hipGetDevice(&dev) != hipSuccess || hipDeviceGetAttribute(&cus, hipDeviceAttributeMultiprocessorCount, dev) != hipSuccess) { grid = -1; return; }
        if (hipFuncSetAttribute((const void*)mega, hipFuncAttributeMaxDynamicSharedMemorySize, LDS_BYTES) != hipSuccess) { fprintf(stderr, "hipFuncSetAttribute failed\n"); grid = -1; return; }
        if (hipOccupancyMaxActiveBlocksPerMultiprocessor(&per_cu, (const void*)mega, 512, LDS_BYTES) != hipSuccess || per_cu < 1) { fprintf(stderr, "occupancy query: %d\n", per_cu); }
        (void)hipGetLastError();
        grid = cus;
        if (grid != 256) fprintf(stderr, "kernel_launch: grid %d (expected 256)\n", grid);
    }
    if (grid < 0) return;
    unsigned char* ws = (unsigned char*)d_ws;
    (void)hipMemsetAsync(ws + WS_CTL, 0, CTL_ZERO_BYTES, stream);
    Args a{};
    for (int i = 0; i < 19; ++i) a.in[i] = (const float*)d_in[i];
    a.out = (float*)d_out; a.ws = ws;
#define MEGA(lo, hi) do { a.ph_lo = (lo); a.ph_hi = (hi); hipLaunchKernelGGL(mega, dim3(grid), dim3(512), LDS_BYTES, stream, a); \
    if ((hi) - (lo) == 1 && (lo) != 7 && ((REPEAT_MASK >> (lo)) & 1)) { hipLaunchKernelGGL(mega, dim3(grid), dim3(512), LDS_BYTES, stream, a); hipLaunchKernelGGL(mega, dim3(grid), dim3(512), LDS_BYTES, stream, a); } } while (0)
#if ONE_LAUNCH
    MEGA(0, 11);
#else
    for (int ph = 0; ph < 11; ++ph) {
        MEGA(ph, ph + 1);
        if (ph == 2 && ((REPEAT_MASK >> 15) & 1)) {
            (void)hipMemsetAsync(ws + WS_CTL + 4096, 0, 4096, stream); a.ph_lo = 2; a.ph_hi = 3; hipLaunchKernelGGL(mega, dim3(grid), dim3(512), LDS_BYTES, stream, a);
            (void)hipMemsetAsync(ws + WS_CTL + 4096, 0, 4096, stream); hipLaunchKernelGGL(mega, dim3(grid), dim3(512), LDS_BYTES, stream, a);
        }
        if (ph == 7 && ((REPEAT_MASK >> 7) & 1)) {
            (void)hipMemsetAsync(ws + WS_CTL, 0, 4096, stream); a.ph_lo = 7; a.ph_hi = 8; hipLaunchKernelGGL(mega, dim3(grid), dim3(512), LDS_BYTES, stream, a);
            (void)hipMemsetAsync(ws + WS_CTL, 0, 4096, stream); hipLaunchKernelGGL(mega, dim3(grid), dim3(512), LDS_BYTES, stream, a);
        }
    }
#if REPEAT_MASK & 65536
    (void)hipMemsetAsync(ws + WS_CTL + 4096, 0, 4096, stream); MEGA(16, 17);
#endif
#if REPEAT_MASK & 131072
    (void)hipMemsetAsync(ws + WS_CTL + 4096, 0, 4096, stream); MEGA(17, 18);
#endif
#if REPEAT_MASK & 2048
    MEGA(11, 12);
#endif
#if REPEAT_MASK & 4096
    MEGA(12, 13);
#endif
#if REPEAT_MASK & 8192
    MEGA(13, 14);
#endif
#if REPEAT_MASK & 16384
    MEGA(14, 15);
#endif
#endif
}
```

```cpp
#include <hip/hip_runtime.h>
#include <cstdint>
#include <cstdio>

typedef unsigned short bf16_t;
typedef short bf16x8 __attribute__((ext_vector_type(8)));
typedef float f32x4 __attribute__((ext_vector_type(4)));
typedef unsigned u32x4 __attribute__((ext_vector_type(4)));
typedef unsigned u32x2 __attribute__((ext_vector_type(2)));
#define LAS __attribute__((address_space(3)))

#ifndef GU_F8
#define GU_F8 true
#endif
#ifndef DN_F8
#define DN_F8 true
#endif
#ifndef GWGM
#define GWGM 2
#endif
#ifndef CONV_PRE
#define CONV_PRE 32
#endif
#ifndef TSPROBE
#define TSPROBE -1
#endif
#ifndef EXTRA_BARRIERS
#define EXTRA_BARRIERS 0
#endif
#ifndef REPEAT_MASK
#define REPEAT_MASK 0
#endif
#ifndef ONE_LAUNCH
#define ONE_LAUNCH 1
#endif
#ifndef SIMPLE_MIX
#define SIMPLE_MIX 0
#endif
#ifndef SIMPLE_ROUTER
#define SIMPLE_ROUTER 0
#endif
#ifndef SIMPLE_FINAL
#define SIMPLE_FINAL 0
#endif
#ifndef SIMPLE_INPROJ
#define SIMPLE_INPROJ 0
#endif
#ifndef SIMPLE_OUTPROJ
#define SIMPLE_OUTPROJ 0
#endif
#ifndef SIMPLE_GATEUP
#define SIMPLE_GATEUP 0
#endif
#ifndef SIMPLE_DOWN
#define SIMPLE_DOWN 0
#endif
constexpr int T_ = 16384, D_ = 1024, NB = 8, SEQ = 2048, INC = 2560, NE = 32, FF = 1024, TK = 65536, NMOD = 6144;
constexpr int CAP = 16384;
constexpr int ACT_ROWS = TK + NE * 256;
constexpr float EPS = 1e-6f;

constexpr size_t MiB = 1u << 20;
constexpr size_t WS_CTL = 0, CTL_ZERO_BYTES = 32768;
constexpr size_t WS_MODP = 1 * MiB;
constexpr size_t WS_MOD = 3 * MiB;
constexpr size_t WS_ROPE = 4 * MiB;
constexpr size_t WS_POOLWT = 5 * MiB;
constexpr size_t WS_WINT = 6 * MiB;
constexpr size_t WS_WOUTT = 11 * MiB;
constexpr size_t WS_TOKSLOT = 13 * MiB;
constexpr size_t WS_WSLOT = 15 * MiB;
constexpr size_t WS_WGUT = 16 * MiB;
constexpr size_t WS_WDT = 144 * MiB;
constexpr size_t WS_XN = 208 * MiB;
constexpr size_t WS_PROJ = 240 * MiB;
constexpr size_t WS_KVT = 320 * MiB;
constexpr size_t WS_RT = 352 * MiB;
constexpr size_t WS_MIXIN = 368 * MiB;
constexpr size_t WS_X1 = 400 * MiB;
constexpr size_t WS_HN = 464 * MiB;
constexpr size_t WS_ACT = 496 * MiB;
constexpr size_t WS_Y = 640 * MiB;
constexpr size_t WS_QR = 768 * MiB;
constexpr size_t WS_KR = 784 * MiB;
constexpr size_t WS_SG = 800 * MiB;
constexpr size_t WS_OG = 832 * MiB;
constexpr size_t WS_H2F = 864 * MiB;
constexpr size_t WS_LOGITS = 928 * MiB;
constexpr size_t WS_PP = 930 * MiB;
constexpr size_t WS_END = 946 * MiB;
constexpr int CW_CNT = 64;
constexpr int CW_PSTART = 128;

#define MFMA16(a, b, c) __builtin_amdgcn_mfma_f32_16x16x32_bf16(a, b, c, 0, 0, 0)
typedef float f32x2_t __attribute__((ext_vector_type(2)));
typedef __bf16 bf16x2_t __attribute__((ext_vector_type(2)));
__device__ __forceinline__ unsigned pk2(float lo, float hi) { const f32x2_t v = {lo, hi}; const bf16x2_t b = __builtin_convertvector(v, bf16x2_t); return __builtin_bit_cast(unsigned, b); }
__device__ __forceinline__ unsigned f2bf(float f) { return pk2(f, 0.f) & 0xffffu; }
__device__ __forceinline__ float bf2f(unsigned h) { return __uint_as_float(h << 16); }
__device__ __forceinline__ float wave_sum(float v) {
#pragma unroll
    for (int o = 1; o < 64; o <<= 1) v += __shfl_xor(v, o);
    return v;
}
__device__ __forceinline__ float silu_f(float v) { return v * __builtin_amdgcn_rcpf(1.f + __builtin_amdgcn_exp2f(-1.4426950408889634f * v)); }
__device__ __forceinline__ float log2_gamma(int h) { return h == 0 ? -0.04580368961312479f : h == 1 ? -0.02272007650008353f : h == 2 ? -0.011315313227834146f : -0.005646563141142062f; }
__device__ __forceinline__ float fexp2(float x) { return __builtin_amdgcn_exp2f(x); }
__device__ __forceinline__ float frsq(float x) { return __builtin_amdgcn_rsqf(x); }

constexpr int NWAVES = 8;
constexpr float WSCALE = 64.f;
constexpr int SCALE_W = 121, SCALE_ONE = 127, SCALE_ACT = 125;
constexpr float ASCALE = 4.f;
typedef int i32x8 __attribute__((ext_vector_type(8)));
typedef int i32x4 __attribute__((ext_vector_type(4)));
constexpr int LDS_BYTES = 163840;

constexpr int RING_BYTES = 131072, LDSCTL_OFF = RING_BYTES;
constexpr int L_MISC = LDSCTL_OFF;
constexpr int L_CNT = LDSCTL_OFF + 256;
constexpr int L_PSTART = LDSCTL_OFF + 384;
constexpr int L_NT = LDSCTL_OFF + 640;
constexpr int L_TILES = LDSCTL_OFF + 768;
constexpr int L_ROWTAB = LDSCTL_OFF + 2048;
constexpr int MAX_UNITS = 12;
constexpr int L_BIAS = L_ROWTAB + MAX_UNITS * 1024;
static_assert(L_BIAS + MAX_UNITS * 1024 <= LDS_BYTES, "LDS map");
constexpr int CW_BAR = 4096;

template <int MAPMODE, bool F8 = false>
__device__ __forceinline__ void transpose_item(const float* W, int K, int N, bf16_t* WT, LAS float* scr, int item, int lane) {
    const int nblk = N / 32, kb = item / nblk, nb = item % nblk, k0 = 64 * kb, n0 = 32 * nb;
    {
        float v[32];
        const float* wp = W + (size_t)(k0 + (lane >> 5)) * N + n0 + (lane & 31);
#pragma unroll
        for (int i = 0; i < 32; ++i) v[i] = wp[(size_t)(2 * i) * N];
        __builtin_amdgcn_sched_barrier(0);
#pragma unroll
        for (int i = 0; i < 32; ++i) scr[(2 * i + (lane >> 5)) * 33 + (lane & 31)] = v[i];
    }
    asm volatile("s_waitcnt lgkmcnt(0)" ::: "memory");
    const int c = lane & 7;
#pragma unroll
    for (int j = 0; j < 4; ++j) {
        const int nl = (lane >> 3) + 8 * j; const LAS float* s = scr + (8 * c) * 33 + nl;
        const int n = n0 + nl; int row = n;
        if (MAPMODE == 1) { const int a = n >> 1, bj = n & 1; row = 256 * (a >> 7) + 128 * bj + (a & 127); }
        if constexpr (F8) {
            int w0 = __builtin_amdgcn_cvt_pk_fp8_f32(s[0 * 33] * WSCALE, s[1 * 33] * WSCALE, 0, false); w0 = __builtin_amdgcn_cvt_pk_fp8_f32(s[2 * 33] * WSCALE, s[3 * 33] * WSCALE, w0, true);
            int w1 = __builtin_amdgcn_cvt_pk_fp8_f32(s[4 * 33] * WSCALE, s[5 * 33] * WSCALE, 0, false); w1 = __builtin_amdgcn_cvt_pk_fp8_f32(s[6 * 33] * WSCALE, s[7 * 33] * WSCALE, w1, true);
            u32x2 o; o.x = (unsigned)w0; o.y = (unsigned)w1;
            *(u32x2*)((unsigned char*)WT + (size_t)row * K + k0 + 8 * c) = o;
        } else {
            u32x4 o; o.x = pk2(s[0 * 33], s[1 * 33]); o.y = pk2(s[2 * 33], s[3 * 33]); o.z = pk2(s[4 * 33], s[5 * 33]); o.w = pk2(s[6 * 33], s[7 * 33]);
            *(u32x4*)(WT + (size_t)row * K + k0 + 8 * c) = o;
        }
    }
    asm volatile("s_waitcnt lgkmcnt(0)" ::: "memory");
}

struct Args {
    const float* in[19]; float* out; unsigned char* ws; int ph_lo, ph_hi;
};

__device__ __forceinline__ void phase_p0(const Args& a, LAS unsigned char* lds, int vb, int G) {
    const int tid = threadIdx.x, lane = tid & 63, wave = tid >> 6;
    unsigned char* ws = a.ws;
    if (vb < 256) {
        LAS float* cact = (LAS float*)lds;
        LAS float* part = (LAS float*)(lds + 4096);
        const int kc = vb & 7, cc = vb >> 3;
        const float* c = a.in[1];
        for (int i = tid; i < 8 * 128; i += 512) { const int b = i >> 7, k = i & 127; cact[i] = silu_f(c[b * D_ + kc * 128 + k]); }
        __syncthreads();
        const int cg = tid % 48, ks = tid / 48;
        if (ks < 10) {
            f32x4 acc[8];
#pragma unroll
            for (int b = 0; b < 8; ++b) acc[b] = (f32x4){0.f, 0.f, 0.f, 0.f};
            const float* w = a.in[2] + (size_t)(kc * 128) * NMOD + cc * 192 + cg * 4;
            f32x4 wv[13];
#pragma unroll
            for (int i = 0; i < 13; ++i) { const int k = ks + 10 * i; wv[i] = (k < 128) ? __builtin_nontemporal_load((const f32x4*)(w + (size_t)k * NMOD)) : (f32x4){0.f, 0.f, 0.f, 0.f}; }
            __builtin_amdgcn_sched_barrier(0);
#pragma unroll
            for (int i = 0; i < 13; ++i) { const int k = ks + 10 * i;
                if (k < 128) {
#pragma unroll
                    for (int b = 0; b < 8; ++b) acc[b] += wv[i] * cact[b * 128 + k]; } }
#pragma unroll
            for (int b = 0; b < 8; ++b) *(LAS f32x4*)(part + (ks * 8 + b) * 192 + cg * 4) = acc[b];
        }
        __syncthreads();
        float* modp = (float*)(ws + WS_MODP);
        for (int i = tid; i < 8 * 192; i += 512) {
            const int b = i / 192, col = i % 192; float s = 0.f;
#pragma unroll
            for (int q = 0; q < 10; ++q) s += part[(q * 8 + b) * 192 + col];
            modp[((size_t)kc * 8 + b) * NMOD + cc * 192 + col] = s;
        }
        __syncthreads();
    }
    {
        float* cosT = (float*)(ws + WS_ROPE); float* sinT = cosT + SEQ * 64;
        for (int i = vb * 512 + tid; i < SEQ * 64; i += G * 512) {
            const int pos = i >> 6, j = i & 63;
            const double inv = (double)(float)exp(-(double)j * (9.210340371976184 / 64.0));
            const double ang = (double)((float)pos * (float)inv);
            const double q = rint(ang * 0.6366197723675814);
            double r = fma(-q, 1.5707963267948966, ang); r = fma(-q, 6.123233995736766e-17, r);
            const double r2 = r * r;
            double s = -1.0 / 39916800.0; s = s * r2 + 1.0 / 362880.0; s = s * r2 - 1.0 / 5040.0; s = s * r2 + 1.0 / 120.0; s = s * r2 - 1.0 / 6.0; s = s * r2 + 1.0; s *= r;
            double co = 1.0 / 479001600.0; co = co * r2 - 1.0 / 3628800.0; co = co * r2 + 1.0 / 40320.0; co = co * r2 - 1.0 / 720.0; co = co * r2 + 1.0 / 24.0; co = co * r2 - 0.5; co = co * r2 + 1.0;
            const int n = ((int)q) & 3;
            const double sv = (n == 0) ? s : (n == 1) ? co : (n == 2) ? -s : -co;
            const double cv = (n == 0) ? co : (n == 1) ? -s : (n == 2) ? -co : s;
            cosT[i] = (float)cv; sinT[i] = (float)sv;
        }
    }
    {
        LAS float* scr = (LAS float*)(lds + wave * 16384);
        const int gw = vb * NWAVES + wave, NGW = G * NWAVES;
        constexpr int I_IN = (D_ / 64) * (INC / 32), I_OUT = (D_ / 64) * (D_ / 32), I_POOL = 4 * 2 * 4;
        constexpr int NITEMS = I_IN + I_OUT + I_POOL;
        for (int it = gw; it < NITEMS; it += NGW) {
            int r = it;
            if (r < I_IN) { transpose_item<0>(a.in[5], D_, INC, (bf16_t*)(ws + WS_WINT), scr, r, lane); continue; } r -= I_IN;
            if (r < I_OUT) { transpose_item<0>(a.in[10], D_, D_, (bf16_t*)(ws + WS_WOUTT), scr, r, lane); continue; } r -= I_OUT;
            { const int g = r / 8; transpose_item<0>(a.in[6] + g * 128 * 128, 128, 128, (bf16_t*)(ws + WS_POOLWT) + g * 128 * 128, scr, r % 8, lane); }
        }
    }
}

constexpr int MOE_ITEMS_GU = (D_ / 64) * (2 * FF / 32), MOE_ITEMS_DN = (FF / 64) * (D_ / 32);
constexpr int MOE_ITEMS = NE * (MOE_ITEMS_GU + MOE_ITEMS_DN), QCHUNKS = MOE_ITEMS / 8 / 8;
static_assert(QCHUNKS * 64 == MOE_ITEMS, "queue geometry");
constexpr int CW_Q = 1024, QGRAB = 4;
static_assert(QCHUNKS % QGRAB == 0, "queue grab");
struct MoeItem { const float* wp; unsigned char* dst; int K, N, k0, n0, mode; bool f8; };
__device__ __forceinline__ MoeItem moe_decode(const Args& a, int r, int lane) {
    MoeItem it; unsigned char* ws = a.ws; int item; const float* W;
    if (r < NE * MOE_ITEMS_GU) { const int e = r / MOE_ITEMS_GU; item = r % MOE_ITEMS_GU; W = a.in[14] + (size_t)e * D_ * 2 * FF; it.K = D_; it.N = 2 * FF; it.mode = 1; it.f8 = GU_F8; it.dst = ws + WS_WGUT + (size_t)e * 2 * FF * D_ * (GU_F8 ? 1 : 2); }
    else { r -= NE * MOE_ITEMS_GU; const int e = r / MOE_ITEMS_DN; item = r % MOE_ITEMS_DN; W = a.in[16] + (size_t)e * FF * D_; it.K = FF; it.N = D_; it.mode = 0; it.f8 = DN_F8; it.dst = ws + WS_WDT + (size_t)e * D_ * FF * (DN_F8 ? 1 : 2); }
    const int nblk = it.N / 32, kb = item / nblk, nb = item % nblk; it.k0 = 64 * kb; it.n0 = 32 * nb;
    it.wp = W + (size_t)(it.k0 + (lane >> 5)) * it.N + it.n0 + (lane & 31);
    return it;
}
__device__ __forceinline__ void moe_load(const MoeItem& it, float (&v)[32]) {
#pragma unroll
    for (int i = 0; i < 32; ++i) v[i] = __builtin_nontemporal_load(it.wp + (size_t)(2 * i) * it.N);
}
__device__ __forceinline__ void moe_finish(const MoeItem& it, const float (&v)[32], LAS float* scr, int lane) {
#pragma unroll
    for (int i = 0; i < 32; ++i) scr[(2 * i + (lane >> 5)) * 33 + (lane & 31)] = v[i];
    asm volatile("s_waitcnt lgkmcnt(0)" ::: "memory");
    const int c = lane & 7;
#pragma unroll
    for (int j = 0; j < 4; ++j) {
        const int nl = (lane >> 3) + 8 * j; const LAS float* s = scr + (8 * c) * 33 + nl;
        const int n = it.n0 + nl; int row = n;
        if (it.mode == 1) { const int aa = n >> 1, bj = n & 1; row = 256 * (aa >> 7) + 128 * bj + (aa & 127); }
        if (it.f8) {
            int w0 = __builtin_amdgcn_cvt_pk_fp8_f32(s[0 * 33] * WSCALE, s[1 * 33] * WSCALE, 0, false); w0 = __builtin_amdgcn_cvt_pk_fp8_f32(s[2 * 33] * WSCALE, s[3 * 33] * WSCALE, w0, true);
            int w1 = __builtin_amdgcn_cvt_pk_fp8_f32(s[4 * 33] * WSCALE, s[5 * 33] * WSCALE, 0, false); w1 = __builtin_amdgcn_cvt_pk_fp8_f32(s[6 * 33] * WSCALE, s[7 * 33] * WSCALE, w1, true);
            u32x2 o; o.x = (unsigned)w0; o.y = (unsigned)w1;
            *(u32x2*)(it.dst + (size_t)row * it.K + it.k0 + 8 * c) = o;
        } else {
            u32x4 o; o.x = pk2(s[0 * 33], s[1 * 33]); o.y = pk2(s[2 * 33], s[3 * 33]); o.z = pk2(s[4 * 33], s[5 * 33]); o.w = pk2(s[6 * 33], s[7 * 33]);
            *(u32x4*)((bf16_t*)it.dst + (size_t)row * it.K + it.k0 + 8 * c) = o;
        }
    }
    asm volatile("s_waitcnt lgkmcnt(0)" ::: "memory");
}
__device__ __forceinline__ void conv_chunks(const Args& a, LAS unsigned char* lds, int myq, int maxchunks) {
    const int tid = threadIdx.x, lane = tid & 63, wave = __builtin_amdgcn_readfirstlane(tid >> 6);
    LAS float* scr = (LAS float*)(lds + wave * 16384);
    volatile LAS int* slot = (volatile LAS int*)(lds + L_MISC) + 16;
    unsigned* heads = (unsigned*)(a.ws + WS_CTL) + CW_Q;
    int done = 0;
    static_assert(QGRAB == 4, "the pipelined loop below is written for four chunks per grab");
    for (int qq = 0; qq < 8 && done < maxchunks; ++qq) {
        const int q = (myq + qq) & 7;
        for (;;) {
            if (done >= maxchunks) break;
            if (tid == 0) *slot = (int)__hip_atomic_fetch_add(heads + 64 * q, (unsigned)QGRAB, __ATOMIC_RELAXED, __HIP_MEMORY_SCOPE_AGENT);
            __syncthreads();
            const int c = *slot;
            __syncthreads();
            if (c >= QCHUNKS) break;
            const int r0 = (q * QCHUNKS + c) * 8 + wave;
            float va[32], vb[32];
            MoeItem i0 = moe_decode(a, r0, lane), i1 = moe_decode(a, r0 + 8, lane), i2 = moe_decode(a, r0 + 16, lane), i3 = moe_decode(a, r0 + 24, lane);
            moe_load(i0, va); moe_load(i1, vb); __builtin_amdgcn_sched_barrier(0);
            moe_finish(i0, va, scr, lane); __builtin_amdgcn_sched_barrier(0);
            moe_load(i2, va); __builtin_amdgcn_sched_barrier(0);
            moe_finish(i1, vb, scr, lane); __builtin_amdgcn_sched_barrier(0);
            moe_load(i3, vb); __builtin_amdgcn_sched_barrier(0);
            moe_finish(i2, va, scr, lane); __builtin_amdgcn_sched_barrier(0);
            moe_finish(i3, vb, scr, lane);
            done += QGRAB;
        }
    }
    __syncthreads();
}

__device__ __forceinline__ void phase_p1(const Args& a, LAS unsigned char* lds, int vb, int G) {
    const int tid = threadIdx.x, lane = tid & 63, wave = tid >> 6;
    unsigned char* ws = a.ws;
    const float* modp = (const float*)(ws + WS_MODP); float* mod = (float*)(ws + WS_MOD);
    for (int i = vb * 512 + tid; i < NB * NMOD; i += G * 512) {
        const int col = i % NMOD; float s = a.in[3][col];
#pragma unroll
        for (int q = 0; q < 8; ++q) s += modp[(size_t)q * NB * NMOD + i];
        mod[i] = s;
    }
    const int RPB = T_ / G;
    const int row0 = vb * RPB, b = row0 / SEQ;
    LAS float* shs = (LAS float*)lds;
    LAS float* scs = shs + 1024;
    {
        float pv[4][9];
#pragma unroll
        for (int it = 0; it < 4; ++it) { const int i = tid + 512 * it; pv[it][8] = a.in[3][i];
#pragma unroll
            for (int q = 0; q < 8; ++q) pv[it][q] = modp[(size_t)q * NB * NMOD + (size_t)b * NMOD + i]; }
        __builtin_amdgcn_sched_barrier(0);
#pragma unroll
        for (int it = 0; it < 4; ++it) { const int i = tid + 512 * it; float sv = pv[it][8];
#pragma unroll
            for (int q = 0; q < 8; ++q) sv += pv[it][q];
            if (i < 1024) shs[i] = sv; else scs[i - 1024] = (1.f + sv) * a.in[4][i - 1024]; }
    }
    __syncthreads();
    bf16_t* XN = (bf16_t*)(ws + WS_XN);
    for (int rb = row0 + wave * (RPB / NWAVES); rb < row0 + (wave + 1) * (RPB / NWAVES); rb += 4) {
        f32x4 v[4][4];
#pragma unroll
        for (int q = 0; q < 4; ++q)
#pragma unroll
            for (int j = 0; j < 4; ++j) v[q][j] = __builtin_nontemporal_load((const f32x4*)(a.in[0] + (size_t)(rb + q) * D_) + lane + 64 * j);
        __builtin_amdgcn_sched_barrier(0);
#pragma unroll
        for (int q = 0; q < 4; ++q) {
            float ss = 0.f;
#pragma unroll
            for (int j = 0; j < 4; ++j) ss += (v[q][j].x * v[q][j].x + v[q][j].y * v[q][j].y) + (v[q][j].z * v[q][j].z + v[q][j].w * v[q][j].w);
            const float rs = frsq(wave_sum(ss) * (1.f / D_) + EPS);
            unsigned long long* o8 = (unsigned long long*)(XN + (size_t)(rb + q) * D_) + lane;
#pragma unroll
            for (int j = 0; j < 4; ++j) {
                const int c0 = 4 * lane + 256 * j;
                const f32x4 hv = v[q][j] * rs * *(const LAS f32x4*)(scs + c0) + *(const LAS f32x4*)(shs + c0);
                o8[64 * j] = (unsigned long long)pk2(hv[0], hv[1]) | ((unsigned long long)pk2(hv[2], hv[3]) << 32);
            }
        }
    }
    __syncthreads();
}

namespace pg8 {
constexpr int BM = 256, BK = 64, HALF = 128, HTB = HALF * BK * 2, STAGE_BYTES = 8 * HTB, NXCD = 8, WGM = 8;
__host__ __device__ __forceinline__ int lds_byte(int r, int c) { const int st = (r >> 4) * 2 + (c >> 5), rr = r & 15, cc = c & 31, ob = rr * 64 + cc * 2; return st * 1024 + (ob ^ (((ob >> 9) & 1) << 5)); }
__host__ __device__ __forceinline__ void stage_rc(int b, int& R, int& C) { const int st = b / 1024, sb = b % 1024, swz = sb ^ (((sb >> 9) & 1) << 5); R = (st >> 1) * 16 + swz / 64; C = (st & 1) * 32 + (swz % 64) / 2; }
__host__ __device__ __forceinline__ int perm32(int rho) { const int n = rho >> 4, i = rho & 15; return 8 * (i >> 2) + 4 * n + (i & 3); }

struct Unit { int pm, pn, e, r0; };
struct Gemm { const bf16_t* A; const bf16_t* Bt; int N, K; size_t bstride; int sw, so; };

struct TileOrder {
    int nM, nN, nwg, G, c, wgm;
    __device__ __forceinline__ void init(int nM_, int nN_, int G_, int c_, int wgm_ = WGM) { nM = nM_; nN = nN_; nwg = nM * nN; G = G_; c = c_; wgm = wgm_; }
    __device__ __forceinline__ bool tile(int i, int& pm, int& pn) const {
        const long L = (long)i * G + c; if (L >= nwg) return false;
        int wgid = (int)L; { const int q = nwg / NXCD, r = nwg % NXCD, xcd = wgid % NXCD, off = wgid / NXCD; wgid = (xcd < r ? xcd * (q + 1) : r * (q + 1) + (xcd - r) * q) + off; }
        const int nig = wgm * nN, gid = wgid / nig, fm = gid * wgm, gsz = (nM - fm) < wgm ? (nM - fm) : wgm;
        pm = fm + ((wgid % nig) % gsz); pn = (wgid % nig) / gsz; return true;
    }
};
struct DenseOrder : TileOrder {
    __device__ __forceinline__ bool next(int i, Unit& u) const { int pm, pn; if (!tile(i, pm, pn)) return false; u.pm = pm; u.pn = pn; u.e = 0; u.r0 = pm * BM; return true; }
    __device__ __forceinline__ int arow(int, const Unit& u, int lr) const { return u.r0 + lr; }
};

__device__ __forceinline__ unsigned cvt_pk_bf16(float lo, float hi) { unsigned r; asm volatile("v_cvt_pk_bf16_f32 %0, %1, %2" : "=v"(r) : "v"(lo), "v"(hi)); return r; }

template <class Epi, class Sched, bool ALIGN_EPI, bool F8 = false>
__device__ __forceinline__ void gemm_phase(LAS unsigned char* lds, const Gemm g, const Sched& S, const Epi& E) {
    const int tid = threadIdx.x, wid = __builtin_amdgcn_readfirstlane(tid >> 6), lane = tid & 63, wr = wid >> 2, wc = wid & 3, fr = lane & 15, fq = lane >> 4;
    const int K = F8 ? g.K / 2 : g.K, nt = K / BK;
    unsigned voffB[2];
#pragma unroll
    for (int i = 0; i < 2; ++i) { int R, C; stage_rc(tid * 16 + i * 8192, R, C); const int Rb = Epi::PERM ? ((R & ~31) + perm32(R & 31)) : R; voffB[i] = (unsigned)(Rb * K + C) * 2u; }
    const size_t kstep = (size_t)(BK * 2);
    const size_t hstep = (size_t)HALF * K * 2;
    const size_t tstep = 2 * hstep;
    const unsigned ldsw = (unsigned)wid * 1024u;
    const int aoff = lds_byte(wr * 64 + fr, fq * 8), boff = lds_byte(wc * 32 + fr, fq * 8);
#define PG8_SA(b, h) (((b) * 2 + (h)) * HTB)
#define PG8_SB(b, h) ((4 + (b) * 2 + (h)) * HTB)
#define PG8_STAGE(bufoff, gbase, voff) do { _Pragma("unroll") for (int _i = 0; _i < 2; ++_i) \
        __builtin_amdgcn_global_load_lds((const unsigned*)((const char*)(gbase) + (voff)[_i]), (LAS unsigned*)(lds + (bufoff) + ldsw + _i * 8192), 16, 0, 0); } while (0)
#define PG8_LDA(dst, b, h) do { _Pragma("unroll") for (int m = 0; m < 4; ++m) _Pragma("unroll") for (int k = 0; k < 2; ++k) dst[m][k] = *(const LAS bf16x8*)(lds + PG8_SA(b, h) + aoff + m * 2048 + k * 1024); } while (0)
#define PG8_LDB(dst, b, h) do { _Pragma("unroll") for (int n = 0; n < 2; ++n) _Pragma("unroll") for (int k = 0; k < 2; ++k) dst[n][k] = *(const LAS bf16x8*)(lds + PG8_SB(b, h) + boff + n * 2048 + k * 1024); } while (0)
#define PG8_CAT(x) __builtin_shufflevector(__builtin_bit_cast(i32x4, x[0]), __builtin_bit_cast(i32x4, x[1]), 0, 1, 2, 3, 4, 5, 6, 7)
#define PG8_MMA(ai, bj, At, Bt) do { __builtin_amdgcn_s_setprio(1); _Pragma("unroll") for (int m = 0; m < 4; ++m) _Pragma("unroll") for (int n = 0; n < 2; ++n) { \
        if constexpr (F8) { asm volatile("v_mfma_scale_f32_16x16x128_f8f6f4 %0, %1, %2, %0, %3, %4 op_sel_hi:[0,0,0]" : "+v"(acc[ai][bj][m][n]) : "v"(PG8_CAT(Bt[n])), "v"(PG8_CAT(At[m])), "v"(f8sw), "v"(f8so)); } \
        else { _Pragma("unroll") for (int k = 0; k < 2; ++k) acc[ai][bj][m][n] = __builtin_amdgcn_mfma_f32_16x16x32_bf16(Bt[n][k], At[m][k], acc[ai][bj][m][n], 0, 0, 0); } } \
        __builtin_amdgcn_s_setprio(0); } while (0)
#define PG8_WAIT_V(n) asm volatile("s_waitcnt vmcnt(" #n ")" ::: "memory")
#define PG8_WAIT_L(n) asm volatile("s_waitcnt lgkmcnt(" #n ")" ::: "memory")
#define PG8_BAR __builtin_amdgcn_s_barrier()
#define PG8_SCHED __builtin_amdgcn_sched_barrier(0)
#define PG8_AOFF(dst, i_, u_) do { _Pragma("unroll") for (int _i = 0; _i < 2; ++_i) { int _R, _C; stage_rc(tid * 16 + _i * 8192, _R, _C); _Pragma("unroll") for (int _h = 0; _h < 2; ++_h) \
        dst[_h][_i] = ((unsigned)S.arow(i_, u_, _h * HALF + _R) * (unsigned)K + (unsigned)_C) * 2u; } } while (0)
    Unit cur, nxt; int ui = 0;
    if (!S.next(0, cur)) return;
    int f8sw = g.sw, f8so = g.so;
    if constexpr (F8) asm volatile("" : "+v"(f8sw), "+v"(f8so));
    f32x4 acc[2][2][4][2];
#pragma unroll
    for (int a = 0; a < 2; ++a)
#pragma unroll
        for (int b = 0; b < 2; ++b)
#pragma unroll
            for (int m = 0; m < 4; ++m)
#pragma unroll
                for (int n = 0; n < 2; ++n) acc[a][b][m][n] = (f32x4){0.f, 0.f, 0.f, 0.f};
    bf16x8 At[4][2], B0[2][2], B1[2][2];
    unsigned voffA[2][2], v2[2][2];
    PG8_AOFF(voffA, 0, cur);
    const char* const cA = (const char*)g.A;
    const char* cB = (const char*)g.Bt + (size_t)cur.e * g.bstride + (size_t)cur.pn * tstep;
    PG8_STAGE(PG8_SB(0, 0), cB, voffB); PG8_STAGE(PG8_SB(0, 1), cB + hstep, voffB); PG8_STAGE(PG8_SA(0, 0), cA, voffA[0]); PG8_STAGE(PG8_SA(0, 1), cA, voffA[1]);
    if (wr == 1) PG8_BAR;
    PG8_WAIT_V(2); PG8_BAR;
    PG8_STAGE(PG8_SB(1, 0), cB + kstep, voffB); PG8_STAGE(PG8_SA(1, 0), cA + kstep, voffA[0]); PG8_STAGE(PG8_SB(1, 1), cB + hstep + kstep, voffB);
    PG8_WAIT_V(6); PG8_BAR;
    for (;;) {
        const bool has_next = S.next(ui + 1, nxt);
        const char* nB = has_next ? (const char*)g.Bt + (size_t)nxt.e * g.bstride + (size_t)nxt.pn * tstep : cB;
#pragma unroll 1
        for (int t = 0; t < nt; t += 2) {
            const bool last = (t == nt - 2);
            const char* a1 = cA + (size_t)(t + 1) * kstep;
            const char* a2 = last ? cA : cA + (size_t)(t + 2) * kstep; const char* b2 = last ? nB : cB + (size_t)(t + 2) * kstep;
            const char* a3 = a2 + kstep; const char* b3 = b2 + kstep;
            if (last && has_next) { PG8_AOFF(v2, ui + 1, nxt); }
            else {
#pragma unroll
                for (int h = 0; h < 2; ++h)
#pragma unroll
                    for (int i = 0; i < 2; ++i) v2[h][i] = voffA[h][i];
            }
            PG8_LDB(B0, 0, 0); PG8_LDB(B1, 0, 1); PG8_SCHED; PG8_LDA(At, 0, 0); PG8_STAGE(PG8_SA(1, 1), a1, voffA[1]);
            PG8_WAIT_V(8); PG8_WAIT_L(0); PG8_BAR; PG8_MMA(0, 0, At, B0); PG8_MMA(0, 1, At, B1); PG8_BAR; PG8_SCHED;
            PG8_LDA(At, 0, 1); PG8_STAGE(PG8_SB(0, 0), b2, voffB); PG8_STAGE(PG8_SB(0, 1), b2 + hstep, voffB); PG8_STAGE(PG8_SA(0, 0), a2, v2[0]);
            PG8_WAIT_V(8); PG8_WAIT_L(0); PG8_BAR; PG8_MMA(1, 0, At, B0); PG8_MMA(1, 1, At, B1); PG8_BAR; PG8_SCHED;
            PG8_LDB(B0, 1, 0); PG8_LDB(B1, 1, 1); PG8_SCHED; PG8_LDA(At, 1, 0); PG8_STAGE(PG8_SA(0, 1), a2, v2[1]);
            PG8_WAIT_V(8); PG8_WAIT_L(0); PG8_BAR; PG8_MMA(0, 0, At, B0); PG8_MMA(0, 1, At, B1); PG8_BAR; PG8_SCHED;
            PG8_LDA(At, 1, 1); PG8_STAGE(PG8_SB(1, 0), b3, voffB); PG8_STAGE(PG8_SB(1, 1), b3 + hstep, voffB); PG8_STAGE(PG8_SA(1, 0), a3, v2[0]);
            PG8_WAIT_V(8); PG8_WAIT_L(0); PG8_BAR; PG8_MMA(1, 0, At, B0); PG8_MMA(1, 1, At, B1); PG8_BAR; PG8_SCHED;
        }
        if constexpr (ALIGN_EPI) { if (wr == 0) PG8_BAR; }
        if constexpr (F8) asm volatile("s_nop 15\n\ts_nop 15" ::: "memory");
        E(acc, cur, ui, wr, wc, fr, fq);
        if (!has_next) break;
#pragma unroll
        for (int a = 0; a < 2; ++a)
#pragma unroll
            for (int b = 0; b < 2; ++b)
#pragma unroll
                for (int m = 0; m < 4; ++m)
#pragma unroll
                    for (int n = 0; n < 2; ++n) acc[a][b][m][n] = (f32x4){0.f, 0.f, 0.f, 0.f};
        cur = nxt; cB = nB; ++ui;
#pragma unroll
        for (int h = 0; h < 2; ++h)
#pragma unroll
            for (int i = 0; i < 2; ++i) voffA[h][i] = v2[h][i];
        if constexpr (ALIGN_EPI) { if (wr == 1) PG8_BAR; }
    }
    PG8_WAIT_V(0);
    if constexpr (!ALIGN_EPI) { if (wr == 0) PG8_BAR; }
    PG8_BAR;
#undef PG8_SA
#undef PG8_SB
#undef PG8_STAGE
#undef PG8_LDA
#undef PG8_LDB
#undef PG8_MMA
#undef PG8_CAT
#undef PG8_WAIT_V
#undef PG8_WAIT_L
#undef PG8_BAR
#undef PG8_SCHED
#undef PG8_AOFF
}

struct EpiProj {
    static constexpr bool PERM = true;
    bf16_t* O;
    __device__ __forceinline__ void operator()(const f32x4 (&acc)[2][2][4][2], const Unit& u, int, int wr, int wc, int fr, int fq) const {
        const int row0 = u.r0 + wr * 64 + fr, col0 = u.pn * BM + wc * 32 + 8 * fq;
#pragma unroll
        for (int ai = 0; ai < 2; ++ai)
#pragma unroll
            for (int m = 0; m < 4; ++m) { bf16_t* rowp = O + (size_t)(row0 + ai * HALF + m * 16) * INC + col0;
#pragma unroll
                for (int bj = 0; bj < 2; ++bj) { const f32x4 v0 = acc[ai][bj][m][0], v1 = acc[ai][bj][m][1];
                    u32x4 w; w.x = cvt_pk_bf16(v0[0], v0[1]); w.y = cvt_pk_bf16(v0[2], v0[3]); w.z = cvt_pk_bf16(v1[0], v1[1]); w.w = cvt_pk_bf16(v1[2], v1[3]);
                    *(u32x4*)(rowp + bj * HALF) = w; } }
    }
};
struct EpiX1 {
    static constexpr bool PERM = false;
    const float* x; const float* mod; bf16_t* X1;
    __device__ __forceinline__ void operator()(const f32x4 (&acc)[2][2][4][2], const Unit& u, int, int wr, int wc, int fr, int fq) const {
        const int row0 = u.r0 + wr * 64 + fr, col0 = u.pn * BM + wc * 32 + 4 * fq, b = u.r0 / SEQ;
        f32x4 gv[2][2];
#pragma unroll
        for (int bj = 0; bj < 2; ++bj)
#pragma unroll
            for (int n = 0; n < 2; ++n) gv[bj][n] = *(const f32x4*)(mod + b * NMOD + 2 * D_ + col0 + bj * HALF + n * 16);
#pragma unroll
        for (int ai = 0; ai < 2; ++ai) {
            f32x4 xv[4][2][2];
#pragma unroll
            for (int m = 0; m < 4; ++m)
#pragma unroll
                for (int bj = 0; bj < 2; ++bj)
#pragma unroll
                    for (int n = 0; n < 2; ++n) xv[m][bj][n] = __builtin_nontemporal_load((const f32x4*)(x + (size_t)(row0 + ai * HALF + m * 16) * D_ + col0 + bj * HALF + n * 16));
            __builtin_amdgcn_sched_barrier(0);
#pragma unroll
            for (int m = 0; m < 4; ++m)
#pragma unroll
                for (int bj = 0; bj < 2; ++bj)
#pragma unroll
                    for (int n = 0; n < 2; ++n) { const f32x4 o = xv[m][bj][n] + gv[bj][n] * acc[ai][bj][m][n];
                        u32x2 w; w.x = cvt_pk_bf16(o[0], o[1]); w.y = cvt_pk_bf16(o[2], o[3]);
                        *(u32x2*)(X1 + (size_t)(row0 + ai * HALF + m * 16) * D_ + col0 + bj * HALF + n * 16) = w; }
            __builtin_amdgcn_sched_barrier(0);
        }
    }
};
}

struct GroupedOrder : pg8::TileOrder {
    LAS const int* tiles; LAS const int* rowtab; LAS const int* pstart; int mode;
    __device__ __forceinline__ bool next(int i, pg8::Unit& u) const { int pm, pn; if (!tile(i, pm, pn)) return false; const int t = tiles[pm]; u.pm = pm; u.pn = pn; u.e = t & 255; u.r0 = (t >> 8) * 256; return true; }
    __device__ __forceinline__ int arow(int i, const pg8::Unit& u, int lr) const { return mode == 0 ? rowtab[i * 256 + lr] : pstart[u.e] + u.r0 + lr; }
};
__device__ __forceinline__ void grouped_prepare(GroupedOrder& S, LAS unsigned char* lds, const unsigned char* ws, int nN, int G, int c, int mode, const float* bias) {
    const int tid = threadIdx.x;
    LAS int* cnt = (LAS int*)(lds + L_CNT); LAS int* pstart = (LAS int*)(lds + L_PSTART); LAS int* tiles = (LAS int*)(lds + L_TILES); LAS int* rowtab = (LAS int*)(lds + L_ROWTAB); LAS int* pNT = (LAS int*)(lds + L_NT);
    const int* gcnt = (const int*)(ws + WS_CTL) + CW_CNT;
    if (tid < NE) cnt[tid] = __hip_atomic_load(gcnt + tid, __ATOMIC_RELAXED, __HIP_MEMORY_SCOPE_AGENT);
    __syncthreads();
    if (tid < 64) {
        const int k = (tid < NE) ? ((cnt[tid] + 255) >> 8) : 0; int inc = k;
#pragma unroll
        for (int o = 1; o < 32; o <<= 1) { const int v = __shfl_up(inc, o); if ((tid & 63) >= o) inc += v; }
        const int first = inc - k;
        if (tid < NE) { pstart[tid] = first * 256; for (int j = 0; j < k; ++j) tiles[first + j] = tid | (j << 8); }
        if (tid == NE - 1) { pstart[NE] = inc * 256; *pNT = inc; }
    }
    __syncthreads();
    S.init(*pNT, nN, G, c, GWGM); S.tiles = tiles; S.rowtab = rowtab; S.pstart = pstart; S.mode = mode;
    const int* tokslot = (const int*)(ws + WS_TOKSLOT);
    int rv[MAX_UNITS];
    LAS float* btab = (LAS float*)(lds + L_BIAS);
#pragma unroll
    for (int i = 0; i < MAX_UNITS; ++i) {
        pg8::Unit u; const bool ok = S.next(i, u); rv[i] = (mode == 0) ? 0 : -1;
        if (ok && tid < 256) { const int rank = u.r0 + tid; if (rank < cnt[u.e]) rv[i] = tokslot[u.e * CAP + rank]; }
        if (ok && tid >= 256) rv[i] = __float_as_int(bias[(size_t)u.e * (nN * 256) + u.pn * 256 + (tid - 256)]);
    }
    __builtin_amdgcn_sched_barrier(0);
#pragma unroll
    for (int i = 0; i < MAX_UNITS; ++i) {
        pg8::Unit u; const bool ok = S.next(i, u);
        if (ok && tid < 256) { const int rank = u.r0 + tid; rowtab[i * 256 + tid] = (rank < cnt[u.e]) ? (mode == 0 ? (rv[i] >> 2) : rv[i]) : (mode == 0 ? 0 : -1); }
        if (ok && tid >= 256) btab[i * 256 + (tid - 256)] = __int_as_float(rv[i]);
    }
    __syncthreads();
}
struct EpiGateUp {
    static constexpr bool PERM = true;
    bf16_t* ACT; LAS const float* btab; LAS const int* pstart;
    __device__ __forceinline__ void operator()(const f32x4 (&acc)[2][2][4][2], const pg8::Unit& u, int ui, int wr, int wc, int fr, int fq) const {
        typedef float f32x2 __attribute__((ext_vector_type(2)));
        const int a0 = u.pn * 128 + wc * 32 + 8 * fq;
        const int prow0 = pstart[u.e] + u.r0 + wr * 64 + fr;
        f32x2 bg[4], bl[4];
#pragma unroll
        for (int q = 0; q < 4; ++q) { const f32x4 b = *(const LAS f32x4*)(btab + ui * 256 + 2 * (a0 - u.pn * 128) + 4 * q); bg[q] = (f32x2){b[0], b[2]}; bl[q] = (f32x2){b[1], b[3]}; }
        constexpr float OS = DN_F8 ? ASCALE : 1.f;
#pragma unroll
        for (int ai = 0; ai < 2; ++ai)
#pragma unroll
            for (int m = 0; m < 4; ++m) {
                f32x2 o[4];
#pragma unroll
                for (int n = 0; n < 2; ++n)
#pragma unroll
                    for (int jp = 0; jp < 2; ++jp) {
                        const int q = n * 2 + jp;
                        f32x2 gate = (f32x2){acc[ai][0][m][n][2 * jp], acc[ai][0][m][n][2 * jp + 1]} + bg[q];
                        f32x2 lin = (f32x2){acc[ai][1][m][n][2 * jp], acc[ai][1][m][n][2 * jp + 1]} + bl[q];
                        gate.x = fminf(gate.x, 7.f); gate.y = fminf(gate.y, 7.f);
                        lin.x = __builtin_amdgcn_fmed3f(lin.x, -7.f, 7.f); lin.y = __builtin_amdgcn_fmed3f(lin.y, -7.f, 7.f);
                        const f32x2 t = gate * (-1.702f * 1.4426950408889634f);
                        f32x2 d; d.x = __builtin_amdgcn_exp2f(t.x); d.y = __builtin_amdgcn_exp2f(t.y);
                        d = d + 1.0f;
                        f32x2 r; r.x = __builtin_amdgcn_rcpf(d.x); r.y = __builtin_amdgcn_rcpf(d.y);
                        o[q] = (lin * OS + OS) * (gate * r);
                    }
                if constexpr (DN_F8) {
                    int w0 = __builtin_amdgcn_cvt_pk_fp8_f32(o[0].x, o[0].y, 0, false); w0 = __builtin_amdgcn_cvt_pk_fp8_f32(o[1].x, o[1].y, w0, true);
                    int w1 = __builtin_amdgcn_cvt_pk_fp8_f32(o[2].x, o[2].y, 0, false); w1 = __builtin_amdgcn_cvt_pk_fp8_f32(o[3].x, o[3].y, w1, true);
                    u32x2 w; w.x = (unsigned)w0; w.y = (unsigned)w1;
                    *(u32x2*)((unsigned char*)ACT + (size_t)(prow0 + ai * 128 + m * 16) * FF + a0) = w;
                } else {
                    u32x4 w; w.x = pg8::cvt_pk_bf16(o[0].x, o[0].y); w.y = pg8::cvt_pk_bf16(o[1].x, o[1].y); w.z = pg8::cvt_pk_bf16(o[2].x, o[2].y); w.w = pg8::cvt_pk_bf16(o[3].x, o[3].y);
                    *(u32x4*)(ACT + (size_t)(prow0 + ai * 128 + m * 16) * FF + a0) = w;
                }
            }
    }
};
struct EpiNone { static constexpr bool PERM = true; __device__ __forceinline__ void operator()(const f32x4 (&acc)[2][2][4][2], const pg8::Unit&, int, int, int, int, int) const { asm volatile("" :: "v"(acc[0][0][0][0]), "v"(acc[1][1][3][1])); } };
struct EpiDown {
    static constexpr bool PERM = true;
    bf16_t* Y; LAS const float* btab; LAS const int* rowtab;
    __device__ __forceinline__ void operator()(const f32x4 (&acc)[2][2][4][2], const pg8::Unit& u, int ui, int wr, int wc, int fr, int fq) const {
        const int col0 = u.pn * 256 + wc * 32 + 8 * fq;
        f32x4 bv[2][2];
#pragma unroll
        for (int bj = 0; bj < 2; ++bj)
#pragma unroll
            for (int n = 0; n < 2; ++n) bv[bj][n] = *(const LAS f32x4*)(btab + ui * 256 + (col0 - u.pn * 256) + bj * 128 + 4 * n);
#pragma unroll
        for (int ai = 0; ai < 2; ++ai)
#pragma unroll
            for (int m = 0; m < 4; ++m) {
                const int slot = rowtab[ui * 256 + ai * 128 + wr * 64 + m * 16 + fr];
                if (slot >= 0) {
#pragma unroll
                    for (int bj = 0; bj < 2; ++bj) { const f32x4 v0 = acc[ai][bj][m][0] + bv[bj][0], v1 = acc[ai][bj][m][1] + bv[bj][1];
                        u32x4 w; w.x = pg8::cvt_pk_bf16(v0[0], v0[1]); w.y = pg8::cvt_pk_bf16(v0[2], v0[3]); w.z = pg8::cvt_pk_bf16(v1[0], v1[1]); w.w = pg8::cvt_pk_bf16(v1[2], v1[3]);
                        *(u32x4*)(Y + (size_t)slot * D_ + col0 + bj * 128) = w; }
                }
            }
    }
};


#define XB_TMO      128
#define XB_XCNT(j)  (256  + 64 * (j))
#define XB_XSUB(j)  (1280 + 64 * (j))
#define XB_XGEN(j)  (2304 + 64 * (j))
#define XB_TOP      3328
#define XB_TOPGEN   3392
#define XCD_BAR_WORDS 3456
#define XB_SPIN_CAP (1u << 18)
__device__ __forceinline__ unsigned xb_ld(unsigned* p)              { return __hip_atomic_load(p, __ATOMIC_RELAXED, __HIP_MEMORY_SCOPE_AGENT); }
__device__ __forceinline__ unsigned xb_add(unsigned* p, unsigned v) { return __hip_atomic_fetch_add(p, v, __ATOMIC_RELAXED, __HIP_MEMORY_SCOPE_AGENT); }
__device__ __forceinline__ unsigned xb_xcc_id() { return (unsigned)__builtin_amdgcn_s_getreg((3 << 11) | 20) & 0xFu; }
#define XB_SPIN(cond, bar) do { unsigned _sp = 0; while (cond) { __builtin_amdgcn_s_sleep(1); \
    if ((++_sp & 255u) == 0u) { if (xb_ld(&(bar)[XB_TMO])) break; if (_sp > XB_SPIN_CAP) { atomicAdd(&(bar)[XB_TMO], 1u); break; } } } } while (0)
struct XcdBarrier { unsigned* bar; unsigned x; volatile LAS unsigned* st; };
__device__ __forceinline__ XcdBarrier xcd_barrier_post(unsigned* bar, volatile LAS unsigned* st) {
    XcdBarrier b; b.bar = bar; b.x = xb_xcc_id(); b.st = st;
    if (threadIdx.x == 0) (void)xb_add(&bar[XB_XCNT(b.x)], 1u);
    return b;
}
__device__ __forceinline__ void xcd_barrier_complete(unsigned* bar, unsigned x, unsigned& nloc, unsigned& nx) {
    const unsigned G = gridDim.x * gridDim.y * gridDim.z;
    unsigned sum, cnt, mine, sp = 0u;
    for (;;) {
        sum = 0u; cnt = 0u; mine = 0u;
#pragma unroll
        for (unsigned j = 0; j < 16; ++j) { const unsigned c = xb_ld(&bar[XB_XCNT(j)]); sum += c; cnt += (c > 0u) ? 1u : 0u; mine = (j == x) ? c : mine; }
        if (sum == G) break;
        __builtin_amdgcn_s_sleep(1);
        if ((++sp & 255u) == 0u) { if (xb_ld(&bar[XB_TMO])) break; if (sp > XB_SPIN_CAP) { atomicAdd(&bar[XB_TMO], 1u); break; } }
    }
    nloc = mine > 0u ? mine : 1u; nx = cnt > 0u ? cnt : 1u;
}
__device__ __forceinline__ void xcd_barrier(const XcdBarrier& b) {
    asm volatile("s_waitcnt vmcnt(0)" ::: "memory");
    __syncthreads();
    if (threadIdx.x == 0) {
        unsigned* bar = b.bar;
        __builtin_amdgcn_s_waitcnt(0);
        unsigned nloc = b.st[0], nx = b.st[1];
        if (nloc == 0u) { xcd_barrier_complete(bar, b.x, nloc, nx); b.st[0] = nloc; b.st[1] = nx; }
        const unsigned old = xb_add(&bar[XB_XSUB(b.x)], 1u);
        const unsigned gen = old / nloc;
        if (old + 1u == (gen + 1u) * nloc) {
            __builtin_amdgcn_fence(__ATOMIC_RELEASE, "agent");
            asm volatile("s_waitcnt vmcnt(0)" ::: "memory");
            const unsigned og = xb_add(&bar[XB_TOP], 1u);
            const unsigned tg = og / nx;
            if (og + 1u == (tg + 1u) * nx) xb_add(&bar[XB_TOPGEN], 1u);
            else XB_SPIN(xb_ld(&bar[XB_TOPGEN]) == tg, bar);
            __builtin_amdgcn_fence(__ATOMIC_ACQUIRE, "agent");
            xb_add(&bar[XB_XGEN(b.x)], 1u);
            asm volatile("s_waitcnt vmcnt(0)" ::: "memory");
        } else {
            XB_SPIN(xb_ld(&bar[XB_XGEN(b.x)]) == gen, bar);
            __builtin_amdgcn_fence(__ATOMIC_ACQUIRE, "agent");
            asm volatile("s_waitcnt vmcnt(0)" ::: "memory");
        }
    }
    __syncthreads();
}

typedef short s16x4 __attribute__((ext_vector_type(4)));
__device__ __forceinline__ s16x4 ds_tr16(const LAS bf16_t* p) { return __builtin_amdgcn_ds_read_tr16_b64_v4i16((LAS s16x4*)p); }
__device__ __forceinline__ bf16x8 cat4(const s16x4 a, const s16x4 b) { return __builtin_shufflevector(a, b, 0, 1, 2, 3, 4, 5, 6, 7); }
constexpr int TS = 136;
__device__ __forceinline__ void unpack8(const u32x4 w, float (&o)[16], int base) {
#pragma unroll
    for (int m = 0; m < 4; ++m) { o[base + 2 * m] = bf2f(w[m] & 0xffffu); o[base + 2 * m + 1] = bf2f(w[m] >> 16); }
}
__device__ __forceinline__ void load_krot(const bf16_t* PROJ, const float* rope, int t, int pos, int h, int q, float (&o1)[16], float (&o2)[16]) {
    const bf16_t* kp = PROJ + (size_t)t * INC + 1024 + h * 128 + 16 * q;
    const u32x4 r0 = *(const u32x4*)kp, r1 = *(const u32x4*)(kp + 8), r2 = *(const u32x4*)(kp + 64), r3 = *(const u32x4*)(kp + 72);
    const float* cp = rope + pos * 64 + 16 * q; const float* sp = cp + SEQ * 64;
    f32x4 c4[4], s4[4];
#pragma unroll
    for (int i4 = 0; i4 < 4; ++i4) { c4[i4] = *(const f32x4*)(cp + 4 * i4); s4[i4] = *(const f32x4*)(sp + 4 * i4); }
    __builtin_amdgcn_sched_barrier(0);
    float k1[16], k2[16];
    unpack8(r0, k1, 0); unpack8(r1, k1, 8); unpack8(r2, k2, 0); unpack8(r3, k2, 8);
    const float sc = 0.08838834764831845f;
#pragma unroll
    for (int i4 = 0; i4 < 4; ++i4) {
#pragma unroll
        for (int r = 0; r < 4; ++r) { const int i = 4 * i4 + r; o1[i] = (k1[i] * c4[i4][r] - k2[i] * s4[i4][r]) * sc; o2[i] = (k2[i] * c4[i4][r] + k1[i] * s4[i4][r]) * sc; }
    }
}
__device__ __forceinline__ void load_v32(const bf16_t* PROJ, int t, int h, int q, unsigned short (&v)[32]) {
    const bf16_t* vp = PROJ + (size_t)t * INC + 1536 + h * 128 + 32 * q;
#pragma unroll
    for (int c = 0; c < 4; ++c) { const u32x4 w = *(const u32x4*)(vp + 8 * c);
#pragma unroll
        for (int m = 0; m < 4; ++m) { v[8 * c + 2 * m] = (unsigned short)(w[m] & 0xffffu); v[8 * c + 2 * m + 1] = (unsigned short)(w[m] >> 16); } }
}

template <int W>
__device__ __forceinline__ void pool_fill(const bf16_t* PROJ, LAS bf16_t* P, int t0, int pos0, int g, int tid) {
    const int cp = tid & 63, seg = tid >> 6;
    const int tb = t0 + 16 * seg, pb = pos0 + 16 * seg;
    float v0[15 + W], v1[15 + W];
    unsigned raw[15 + W];
#pragma unroll
    for (int idx = 0; idx < 15 + W; ++idx) {
        const int dp = idx - (W - 1);
        const bool ok = (pb + dp >= 0);
        raw[idx] = *(const unsigned*)(PROJ + (size_t)(tb + (ok ? dp : -pb)) * INC + g * 128 + 2 * cp);
    }
    __builtin_amdgcn_sched_barrier(0);
#pragma unroll
    for (int idx = 0; idx < 15 + W; ++idx) {
        const int dp = idx - (W - 1);
        const unsigned u = (pb + dp >= 0) ? raw[idx] : 0u;
        v0[idx] = bf2f(u & 0xffffu); v1[idx] = bf2f(u >> 16);
    }
#pragma unroll
    for (int k = 0; k < 16; ++k) {
        float s0 = 0.f, s1 = 0.f;
#pragma unroll
        for (int q = 0; q < W; ++q) { s0 += v0[k + q]; s1 += v1[k + q]; }
        const int pos = pb + k; const float inv = 1.f / (float)((pos + 1 < W) ? pos + 1 : W);
        *(LAS unsigned*)(P + (16 * seg + k) * TS + 2 * cp) = pk2(s0 * inv - v0[k + W - 1], s1 * inv - v1[k + W - 1]);
    }
}
__device__ __forceinline__ void pool_unit(const Args& a, LAS unsigned char* lds, int u) {
    const int tid = threadIdx.x, lane = tid & 63, wave = __builtin_amdgcn_readfirstlane(tid >> 6), fr = lane & 15, fq = lane >> 4;
    const int chunk = u >> 2, g = u & 3, t0 = chunk * 128, pos0 = t0 % SEQ;
    const bf16_t* PROJ = (const bf16_t*)(a.ws + WS_PROJ); const bf16_t* PWT = (const bf16_t*)(a.ws + WS_POOLWT); bf16_t* MIXIN = (bf16_t*)(a.ws + WS_MIXIN);
    LAS bf16_t* P = (LAS bf16_t*)lds;
    if (g == 0) pool_fill<2>(PROJ, P, t0, pos0, g, tid); else if (g == 1) pool_fill<4>(PROJ, P, t0, pos0, g, tid); else if (g == 2) pool_fill<8>(PROJ, P, t0, pos0, g, tid); else pool_fill<16>(PROJ, P, t0, pos0, g, tid);
    __syncthreads();
    f32x4 acc[8];
#pragma unroll
    for (int nt = 0; nt < 8; ++nt) acc[nt] = (f32x4){0.f, 0.f, 0.f, 0.f};
#pragma unroll
    for (int ks = 0; ks < 4; ++ks) {
        const bf16x8 af = *(const LAS bf16x8*)(P + (16 * wave + fr) * TS + 32 * ks + 8 * fq);
#pragma unroll
        for (int nt = 0; nt < 8; ++nt) { const bf16x8 bf = *(const bf16x8*)(PWT + (size_t)(g * 128 + 16 * nt + fr) * 128 + 32 * ks + 8 * fq); acc[nt] = MFMA16(bf, af, acc[nt]); }
    }
    const int t = t0 + 16 * wave + fr;
#pragma unroll
    for (int nt = 0; nt < 8; ++nt) {
        const int ch = g * 128 + 16 * nt + 4 * fq;
        const f32x4 pb = *(const f32x4*)(a.in[7] + ch), ps = *(const f32x4*)(a.in[8] + ch);
        const f32x4 o = (acc[nt] + pb) * ps;
        u32x2 w; w.x = pk2(o[0], o[1]); w.y = pk2(o[2], o[3]);
        *(u32x2*)(MIXIN + (size_t)t * D_ + ch) = w;
    }
    __syncthreads();
}
__device__ __forceinline__ void kv_unit(const Args& a, LAS unsigned char* lds, int u) {
    const int tid = threadIdx.x, lane = tid & 63, wave = __builtin_amdgcn_readfirstlane(tid >> 6), fr = lane & 15, fq = lane >> 4;
    const int bh = u / 15, n = u % 15, b = bh >> 2, h = bh & 3, t0 = b * SEQ + n * 128, pos0 = n * 128;
    const bf16_t* PROJ = (const bf16_t*)(a.ws + WS_PROJ); const float* rope = (const float*)(a.ws + WS_ROPE); float* KVT = (float*)(a.ws + WS_KVT);
    LAS bf16_t* Kn = (LAS bf16_t*)lds; LAS bf16_t* Vn = Kn + 128 * TS;
    const float l2g = log2_gamma(h);
    {
        const int j = tid >> 2, q = tid & 3;
        const bf16_t* vp = PROJ + (size_t)(t0 + j) * INC + 1536 + h * 128 + 32 * q;
        u32x4 vr[4];
#pragma unroll
        for (int c = 0; c < 4; ++c) vr[c] = *(const u32x4*)(vp + 8 * c);
        float o1[16], o2[16]; load_krot(PROJ, rope, t0 + j, pos0 + j, h, q, o1, o2);
        const float kd = fexp2((float)(127 - j) * l2g);
        u32x4 w;
        w.x = pk2(o1[0] * kd, o1[1] * kd); w.y = pk2(o1[2] * kd, o1[3] * kd); w.z = pk2(o1[4] * kd, o1[5] * kd); w.w = pk2(o1[6] * kd, o1[7] * kd); *(LAS u32x4*)(Kn + j * TS + 16 * q) = w;
        w.x = pk2(o1[8] * kd, o1[9] * kd); w.y = pk2(o1[10] * kd, o1[11] * kd); w.z = pk2(o1[12] * kd, o1[13] * kd); w.w = pk2(o1[14] * kd, o1[15] * kd); *(LAS u32x4*)(Kn + j * TS + 16 * q + 8) = w;
        w.x = pk2(o2[0] * kd, o2[1] * kd); w.y = pk2(o2[2] * kd, o2[3] * kd); w.z = pk2(o2[4] * kd, o2[5] * kd); w.w = pk2(o2[6] * kd, o2[7] * kd); *(LAS u32x4*)(Kn + j * TS + 64 + 16 * q) = w;
        w.x = pk2(o2[8] * kd, o2[9] * kd); w.y = pk2(o2[10] * kd, o2[11] * kd); w.z = pk2(o2[12] * kd, o2[13] * kd); w.w = pk2(o2[14] * kd, o2[15] * kd); *(LAS u32x4*)(Kn + j * TS + 64 + 16 * q + 8) = w;
#pragma unroll
        for (int c = 0; c < 4; ++c) *(LAS u32x4*)(Vn + j * TS + 32 * q + 8 * c) = vr[c];
    }
    __syncthreads();
    f32x4 acc[8];
#pragma unroll
    for (int dt = 0; dt < 8; ++dt) acc[dt] = (f32x4){0.f, 0.f, 0.f, 0.f};
#pragma unroll
    for (int ks = 0; ks < 4; ++ks) {
        const int jr = 32 * ks + 4 * fq + (fr >> 2), cc = 4 * (fr & 3);
        const LAS bf16_t* vq = Vn + jr * TS + 16 * wave + cc;
        const bf16x8 vf = cat4(ds_tr16(vq), ds_tr16(vq + 16 * TS));
#pragma unroll
        for (int dt = 0; dt < 8; ++dt) { const LAS bf16_t* kq = Kn + jr * TS + 16 * dt + cc; acc[dt] = MFMA16(cat4(ds_tr16(kq), ds_tr16(kq + 16 * TS)), vf, acc[dt]); }
    }
    float* op = KVT + ((size_t)(bh * 15 + n) << 14) + (size_t)(16 * wave + fr) * 128 + 4 * fq;
#pragma unroll
    for (int dt = 0; dt < 8; ++dt) *(f32x4*)(op + 16 * dt) = acc[dt];
    __syncthreads();
}
__device__ __forceinline__ void phase_scan(const Args& a, int vb, int G) {
    const float* KVT = (const float*)(a.ws + WS_KVT); bf16_t* RT = (bf16_t*)(a.ws + WS_RT);
    for (int i = vb * 512 + threadIdx.x; i < 32 * 4096; i += G * 512) {
        const int bh = i >> 12, ed = (i & 4095) * 4, h = bh & 3;
        const float cd = fexp2(128.f * log2_gamma(h)); f32x4 R = (f32x4){0.f, 0.f, 0.f, 0.f};
        f32x4 kv[15];
#pragma unroll
        for (int n = 0; n < 15; ++n) kv[n] = *(const f32x4*)(KVT + ((size_t)(bh * 15 + n) << 14) + ed);
#pragma unroll
        for (int n = 0; n < 16; ++n) {
            u32x2 w; w.x = pk2(R[0], R[1]); w.y = pk2(R[2], R[3]);
            *(u32x2*)(RT + ((size_t)(bh * 16 + n) << 14) + ed) = w;
            if (n < 15) R = R * cd + kv[n];
        }
    }
}
__device__ __forceinline__ bf16x8 pack8(const float (&v)[8]) {
    u32x4 w; w.x = pk2(v[0], v[1]); w.y = pk2(v[2], v[3]); w.z = pk2(v[4], v[5]); w.w = pk2(v[6], v[7]);
    return __builtin_bit_cast(bf16x8, w);
}
#define TS_SUB(k) do { if (TSPROBE >= 100 && blockIdx.x == 0 && threadIdx.x == 0) { volatile LAS unsigned long long* tsl = (volatile LAS unsigned long long*)(lds + L_MISC + 128); if ((k) + 100 == TSPROBE && tsl[0] == 0) tsl[0] = __builtin_amdgcn_s_memrealtime(); if ((k) + 99 == TSPROBE && tsl[1] == 0) tsl[1] = __builtin_amdgcn_s_memrealtime(); } } while (0)
__device__ __forceinline__ void ret_unit(const Args& a, LAS unsigned char* lds, int u) {
    const int tid = threadIdx.x, lane = tid & 63, wave = __builtin_amdgcn_readfirstlane(tid >> 6), fr = lane & 15, fq = lane >> 4;
    const int bh = u >> 4, n = u & 15, b = bh >> 2, h = bh & 3, t0 = b * SEQ + n * 128, pos0 = n * 128;
    const bf16_t* PROJ = (const bf16_t*)(a.ws + WS_PROJ); const float* rope = (const float*)(a.ws + WS_ROPE); const bf16_t* RT = (const bf16_t*)(a.ws + WS_RT); bf16_t* MIXIN = (bf16_t*)(a.ws + WS_MIXIN);
    LAS bf16_t* Kn = (LAS bf16_t*)lds; LAS bf16_t* Vt = Kn + 128 * TS; LAS bf16_t* Rt = Vt + 128 * TS;
    const float l2g = log2_gamma(h);
    TS_SUB(0);
    const int j = tid >> 2, q = tid & 3;
    const int il = 16 * wave + fr, t = t0 + il, pos = pos0 + il;
    const bf16_t* kp = PROJ + (size_t)(t0 + j) * INC + 1024 + h * 128 + 16 * q;
    const u32x4 kr0 = *(const u32x4*)kp, kr1 = *(const u32x4*)(kp + 8), kr2 = *(const u32x4*)(kp + 64), kr3 = *(const u32x4*)(kp + 72);
    const float* kcp = rope + (pos0 + j) * 64 + 16 * q; const float* ksp = kcp + SEQ * 64;
    f32x4 kc[4], ks_[4];
#pragma unroll
    for (int i4 = 0; i4 < 4; ++i4) { kc[i4] = *(const f32x4*)(kcp + 4 * i4); ks_[i4] = *(const f32x4*)(ksp + 4 * i4); }
    const bf16_t* vp = PROJ + (size_t)(t0 + j) * INC + 1536 + h * 128 + 32 * q;
    u32x4 vr[4];
#pragma unroll
    for (int c = 0; c < 4; ++c) vr[c] = *(const u32x4*)(vp + 8 * c);
    u32x4 rr[4];
    if (n > 0) { const bf16_t* rp = RT + ((size_t)(bh * 16 + n) << 14) + j * 128 + 32 * q;
#pragma unroll
        for (int c = 0; c < 4; ++c) rr[c] = *(const u32x4*)(rp + 8 * c); }
    const bf16_t* qp = PROJ + (size_t)t * INC + 512 + h * 128 + 8 * fq;
    const u32x4 qr0 = *(const u32x4*)(qp), qr1 = *(const u32x4*)(qp + 32), qr2 = *(const u32x4*)(qp + 64), qr3 = *(const u32x4*)(qp + 96);
    f32x4 qc[2][2], qs[2][2];
#pragma unroll
    for (int ks = 0; ks < 2; ++ks) { const float* cp = rope + pos * 64 + 32 * ks + 8 * fq; const float* sp = cp + SEQ * 64;
#pragma unroll
        for (int i4 = 0; i4 < 2; ++i4) { qc[ks][i4] = *(const f32x4*)(cp + 4 * i4); qs[ks][i4] = *(const f32x4*)(sp + 4 * i4); } }
    u32x2 gw[8];
#pragma unroll
    for (int et = 0; et < 8; ++et) gw[et] = *(const u32x2*)(PROJ + (size_t)t * INC + 2048 + h * 128 + 16 * et + 4 * fq);
    __builtin_amdgcn_sched_barrier(0);
    asm volatile("s_waitcnt vmcnt(0)" ::: "memory"); TS_SUB(1);
    {
        float k1[16], k2[16], o1[16], o2[16];
        unpack8(kr0, k1, 0); unpack8(kr1, k1, 8); unpack8(kr2, k2, 0); unpack8(kr3, k2, 8);
        const float sc = 0.08838834764831845f;
#pragma unroll
        for (int i4 = 0; i4 < 4; ++i4)
#pragma unroll
            for (int r = 0; r < 4; ++r) { const int i = 4 * i4 + r; o1[i] = (k1[i] * kc[i4][r] - k2[i] * ks_[i4][r]) * sc; o2[i] = (k2[i] * kc[i4][r] + k1[i] * ks_[i4][r]) * sc; }
        u32x4 w;
        w.x = pk2(o1[0], o1[1]); w.y = pk2(o1[2], o1[3]); w.z = pk2(o1[4], o1[5]); w.w = pk2(o1[6], o1[7]); *(LAS u32x4*)(Kn + j * TS + 16 * q) = w;
        w.x = pk2(o1[8], o1[9]); w.y = pk2(o1[10], o1[11]); w.z = pk2(o1[12], o1[13]); w.w = pk2(o1[14], o1[15]); *(LAS u32x4*)(Kn + j * TS + 16 * q + 8) = w;
        w.x = pk2(o2[0], o2[1]); w.y = pk2(o2[2], o2[3]); w.z = pk2(o2[4], o2[5]); w.w = pk2(o2[6], o2[7]); *(LAS u32x4*)(Kn + j * TS + 64 + 16 * q) = w;
        w.x = pk2(o2[8], o2[9]); w.y = pk2(o2[10], o2[11]); w.z = pk2(o2[12], o2[13]); w.w = pk2(o2[14], o2[15]); *(LAS u32x4*)(Kn + j * TS + 64 + 16 * q + 8) = w;
#pragma unroll
        for (int c = 0; c < 4; ++c) *(LAS u32x4*)(Vt + j * TS + 32 * q + 8 * c) = vr[c];
        if (n > 0) {
#pragma unroll
            for (int c = 0; c < 4; ++c) *(LAS u32x4*)(Rt + j * TS + 32 * q + 8 * c) = rr[c];
        }
    }
    bf16x8 qf[4];
    {
        float qa[16], qb[16];
        unpack8(qr0, qa, 0); unpack8(qr1, qa, 8); unpack8(qr2, qb, 0); unpack8(qr3, qb, 8);
#pragma unroll
        for (int ks = 0; ks < 2; ++ks) {
            float y1[8], y2[8];
#pragma unroll
            for (int i4 = 0; i4 < 2; ++i4)
#pragma unroll
                for (int r = 0; r < 4; ++r) { const int i = 4 * i4 + r; const float x1 = qa[8 * ks + i], x2 = qb[8 * ks + i]; y1[i] = x1 * qc[ks][i4][r] - x2 * qs[ks][i4][r]; y2[i] = x2 * qc[ks][i4][r] + x1 * qs[ks][i4][r]; }
            qf[ks] = pack8(y1); qf[ks + 2] = pack8(y2);
        }
    }
    __syncthreads();
    TS_SUB(2);
    f32x4 acc[8];
#pragma unroll
    for (int et = 0; et < 8; ++et) acc[et] = (f32x4){0.f, 0.f, 0.f, 0.f};
    if (n > 0) {
#pragma unroll
        for (int ks = 0; ks < 4; ++ks)
#pragma unroll
            for (int et = 0; et < 8; ++et) acc[et] = MFMA16(*(const LAS bf16x8*)(Rt + (16 * et + fr) * TS + 32 * ks + 8 * fq), qf[ks], acc[et]);
        const float qd = fexp2((float)(il + 1) * l2g);
#pragma unroll
        for (int et = 0; et < 8; ++et) acc[et] *= qd;
    }
#pragma unroll
    for (int ks2 = 0; ks2 < 4; ++ks2) {
        if (2 * ks2 <= wave) {
            float sv[8];
#pragma unroll
            for (int tt = 0; tt < 2; ++tt) {
                const int jt = 2 * ks2 + tt;
                f32x4 sacc = (f32x4){0.f, 0.f, 0.f, 0.f};
                if (jt <= wave) {
#pragma unroll
                    for (int ks = 0; ks < 4; ++ks) sacc = MFMA16(*(const LAS bf16x8*)(Kn + (16 * jt + fr) * TS + 32 * ks + 8 * fq), qf[ks], sacc);
                }
#pragma unroll
                for (int r = 0; r < 4; ++r) { const int diff = il - (16 * jt + 4 * fq + r); sv[4 * tt + r] = (diff >= 0) ? sacc[r] * fexp2((float)diff * l2g) : 0.f; }
            }
            const bf16x8 sf = pack8(sv);
#pragma unroll
            for (int et = 0; et < 8; ++et) {
                const LAS bf16_t* vq = Vt + (32 * ks2 + 4 * fq + (fr >> 2)) * TS + 16 * et + 4 * (fr & 3);
                acc[et] = MFMA16(cat4(ds_tr16(vq), ds_tr16(vq + 16 * TS)), sf, acc[et]);
            }
        }
    }
    TS_SUB(3);
    float sm = 0.f;
#pragma unroll
    for (int et = 0; et < 8; ++et) sm += (acc[et][0] + acc[et][1]) + (acc[et][2] + acc[et][3]);
    sm += __shfl_xor(sm, 16); sm += __shfl_xor(sm, 32);
    const float mu = sm * (1.f / 128.f);
    float sq = 0.f;
#pragma unroll
    for (int et = 0; et < 8; ++et) { const f32x4 d = acc[et] - mu; sq += (d[0] * d[0] + d[1] * d[1]) + (d[2] * d[2] + d[3] * d[3]); }
    sq += __shfl_xor(sq, 16); sq += __shfl_xor(sq, 32);
    const float rs = frsq(sq * (1.f / 128.f) + EPS);
#pragma unroll
    for (int et = 0; et < 8; ++et) {
        const int c = h * 128 + 16 * et + 4 * fq;
        const f32x4 gn = *(const f32x4*)(a.in[9] + c);
        const float g0 = bf2f(gw[et].x & 0xffffu), g1 = bf2f(gw[et].x >> 16), g2 = bf2f(gw[et].y & 0xffffu), g3 = bf2f(gw[et].y >> 16);
        const f32x4 d = (acc[et] - mu) * rs * gn;
        u32x2 w; w.x = pk2(silu_f(g0) * d[0], silu_f(g1) * d[1]); w.y = pk2(silu_f(g2) * d[2], silu_f(g3) * d[3]);
        *(u32x2*)(MIXIN + (size_t)t * D_ + 512 + c) = w;
    }
    __syncthreads();
    TS_SUB(4);
}

constexpr int HST = 1026;
constexpr int R_H = 0, R_PART = 65792, R_LOGIT = R_PART + 16384, R_PE = R_LOGIT + 2048, R_PW = R_PE + 1024, R_PL = R_PW + 1024, R_HIST = R_PL + 1024, R_BASE = R_HIST + 128;
static_assert(16 * HST * 4 <= R_PART && R_BASE + 128 <= RING_BYTES, "router LDS map");
__device__ __forceinline__ void phase_router(const Args& a, LAS unsigned char* lds, int vb, int G) {
    const int tid = threadIdx.x, lane = tid & 63, wave = __builtin_amdgcn_readfirstlane(tid >> 6), fr = lane & 15, fq = lane >> 4;
    unsigned char* ws = a.ws;
    const bf16_t* X1 = (const bf16_t*)(ws + WS_X1); const float* mod = (const float*)(ws + WS_MOD); bf16_t* HN = (bf16_t*)(ws + WS_HN);
    LAS float* H = (LAS float*)(lds + R_H); LAS float* part = (LAS float*)(lds + R_PART);
    LAS int* pe = (LAS int*)(lds + R_PE); LAS float* pw = (LAS float*)(lds + R_PW); LAS int* pl = (LAS int*)(lds + R_PL); LAS int* hist = (LAS int*)(lds + R_HIST); LAS int* base = (LAS int*)(lds + R_BASE);
    const int RPB = T_ / G, row0 = vb * RPB, b = row0 / SEQ;
    u32x2 xr[2][4];
#pragma unroll
    for (int rr = 0; rr < 2; ++rr)
#pragma unroll
        for (int j = 0; j < 4; ++j) xr[rr][j] = ((const u32x2*)(X1 + (size_t)(row0 + 2 * wave + rr) * D_) + lane)[64 * j];
    float wreg[32][2];
#pragma unroll
    for (int kk = 0; kk < 32; ++kk)
#pragma unroll
        for (int nt = 0; nt < 2; ++nt) wreg[kk][nt] = a.in[12][(size_t)(128 * wave + 4 * kk + fq) * NE + 16 * nt + fr];
    if (tid < NE) hist[tid] = 0;
    const float* sh = mod + b * NMOD + 3 * D_; const float* sc = mod + b * NMOD + 4 * D_;
    f32x4 gs[4], s0[4];
#pragma unroll
    for (int j = 0; j < 4; ++j) { const int c0 = 4 * lane + 256 * j; gs[j] = *(const f32x4*)(a.in[11] + c0) * (1.f + *(const f32x4*)(sc + c0)); s0[j] = *(const f32x4*)(sh + c0); }
    const float brt = a.in[13][tid & 31];
    for (int sub = 0; sub < RPB / 16; ++sub) {
        f32x4 v[2][4];
#pragma unroll
        for (int rr = 0; rr < 2; ++rr)
#pragma unroll
            for (int j = 0; j < 4; ++j) { const u32x2 w = xr[rr][j]; v[rr][j] = (f32x4){bf2f(w.x & 0xffffu), bf2f(w.x >> 16), bf2f(w.y & 0xffffu), bf2f(w.y >> 16)}; }
        if (sub + 1 < RPB / 16) {
#pragma unroll
            for (int rr = 0; rr < 2; ++rr)
#pragma unroll
                for (int j = 0; j < 4; ++j) xr[rr][j] = ((const u32x2*)(X1 + (size_t)(row0 + (sub + 1) * 16 + 2 * wave + rr) * D_) + lane)[64 * j];
        }
#pragma unroll
        for (int rr = 0; rr < 2; ++rr) {
            const int lr = 2 * wave + rr, r = row0 + sub * 16 + lr;
            float ss = 0.f;
#pragma unroll
            for (int j = 0; j < 4; ++j) ss += (v[rr][j].x * v[rr][j].x + v[rr][j].y * v[rr][j].y) + (v[rr][j].z * v[rr][j].z + v[rr][j].w * v[rr][j].w);
            const float rs = frsq(wave_sum(ss) * (1.f / D_) + EPS);
#pragma unroll
            for (int j = 0; j < 4; ++j) {
                const int c0 = 4 * lane + 256 * j;
                const f32x4 hv = v[rr][j] * rs * gs[j] + s0[j];
                if constexpr (GU_F8) { int w8 = __builtin_amdgcn_cvt_pk_fp8_f32(hv[0], hv[1], 0, false); w8 = __builtin_amdgcn_cvt_pk_fp8_f32(hv[2], hv[3], w8, true); *(int*)((unsigned char*)HN + (size_t)r * D_ + c0) = w8; }
                else *(unsigned long long*)(HN + (size_t)r * D_ + c0) = (unsigned long long)pk2(hv[0], hv[1]) | ((unsigned long long)pk2(hv[2], hv[3]) << 32);
                LAS float* hp = H + lr * HST + c0; hp[0] = hv[0]; hp[1] = hv[1]; hp[2] = hv[2]; hp[3] = hv[3];
            }
        }
        __syncthreads();
        f32x4 lacc[2] = {(f32x4){0.f, 0.f, 0.f, 0.f}, (f32x4){0.f, 0.f, 0.f, 0.f}};
#pragma unroll
        for (int kk = 0; kk < 32; ++kk) {
            const float av = H[fr * HST + 128 * wave + 4 * kk + fq];
            lacc[0] = __builtin_amdgcn_mfma_f32_16x16x4f32(av, wreg[kk][0], lacc[0], 0, 0, 0);
            lacc[1] = __builtin_amdgcn_mfma_f32_16x16x4f32(av, wreg[kk][1], lacc[1], 0, 0, 0);
        }
#pragma unroll
        for (int nt = 0; nt < 2; ++nt)
#pragma unroll
            for (int r = 0; r < 4; ++r) part[(wave * 16 + 4 * fq + r) * 32 + 16 * nt + fr] = lacc[nt][r];
        __syncthreads();
        {
            const int tk = tid >> 5, e = tid & 31; float lg = brt;
#pragma unroll
            for (int w = 0; w < 8; ++w) lg += part[(w * 16 + tk) * 32 + e];
            float tv[4]; int ti[4];
#pragma unroll
            for (int k = 0; k < 4; ++k) {
                float bv = lg; int bi = e;
#pragma unroll
                for (int o = 1; o < 32; o <<= 1) { const float ov = __shfl_xor(bv, o); const int oi = __shfl_xor(bi, o); if (ov > bv || (ov == bv && oi < bi)) { bv = ov; bi = oi; } }
                tv[k] = bv; ti[k] = bi; if (e == bi) lg = -INFINITY;
            }
            if (e < 4) {
                float se = 0.f, ex[4];
#pragma unroll
                for (int k = 0; k < 4; ++k) { ex[k] = fexp2((tv[k] - tv[0]) * 1.4426950408889634f); se += ex[k]; }
                const float mine = (e == 0) ? ex[0] : (e == 1) ? ex[1] : (e == 2) ? ex[2] : ex[3];
                const int me = (e == 0) ? ti[0] : (e == 1) ? ti[1] : (e == 2) ? ti[2] : ti[3];
                const int pi = (sub * 16 + tk) * 4 + e; pe[pi] = me; pw[pi] = mine * __builtin_amdgcn_rcpf(se);
            }
        }
    }
    __syncthreads();
    const int npair = RPB * 4;
    if (tid < npair) pl[tid] = atomicAdd((int*)(hist + pe[tid]), 1);
    __syncthreads();
    if (tid < NE) base[tid] = (int)__hip_atomic_fetch_add((int*)(ws + WS_CTL) + CW_CNT + tid, hist[tid], __ATOMIC_RELAXED, __HIP_MEMORY_SCOPE_AGENT);
    __syncthreads();
    if (tid < npair) {
        const int e = pe[tid], slot = row0 * 4 + tid;
        ((int*)(ws + WS_TOKSLOT))[e * CAP + base[e] + pl[tid]] = slot;
        ((float*)(ws + WS_WSLOT))[slot] = pw[tid];
    }
    __syncthreads();
}
__device__ __forceinline__ void phase_final(const Args& a, int vb, int G) {
    const int tid = threadIdx.x, lane = tid & 63, wave = tid >> 6;
    const bf16_t* X1 = (const bf16_t*)(a.ws + WS_X1); const bf16_t* Y = (const bf16_t*)(a.ws + WS_Y); const float* wslot = (const float*)(a.ws + WS_WSLOT); const float* mod = (const float*)(a.ws + WS_MOD);
    for (int r = vb * NWAVES + wave; r < T_; r += G * NWAVES) {
        const int b = r / SEQ; const float* gt2 = mod + b * NMOD + 5 * D_;
        float w[4];
#pragma unroll
        for (int k = 0; k < 4; ++k) w[k] = wslot[r * 4 + k];
        f32x4 v[4]; float ss = 0.f;
#pragma unroll
        for (int j = 0; j < 4; ++j) {
            const int c0 = 4 * lane + 256 * j;
            f32x4 f = (f32x4){0.f, 0.f, 0.f, 0.f};
#pragma unroll
            for (int k = 0; k < 4; ++k) {
                const u32x2 y = __builtin_nontemporal_load((const u32x2*)(Y + (size_t)(r * 4 + k) * D_ + c0));
                f.x += w[k] * bf2f(y.x & 0xffffu); f.y += w[k] * bf2f(y.x >> 16); f.z += w[k] * bf2f(y.y & 0xffffu); f.w += w[k] * bf2f(y.y >> 16);
            }
            const u32x2 xw = *(const u32x2*)(X1 + (size_t)r * D_ + c0); const f32x4 x1 = (f32x4){bf2f(xw.x & 0xffffu), bf2f(xw.x >> 16), bf2f(xw.y & 0xffffu), bf2f(xw.y >> 16)}; const f32x4 g = *(const f32x4*)(gt2 + c0);
            v[j] = x1 + g * f;
            ss += (v[j].x * v[j].x + v[j].y * v[j].y) + (v[j].z * v[j].z + v[j].w * v[j].w);
        }
        const float rs = frsq(wave_sum(ss) * (1.f / D_) + EPS);
#pragma unroll
        for (int j = 0; j < 4; ++j) { const int c0 = 4 * lane + 256 * j; const f32x4 g = *(const f32x4*)(a.in[18] + c0); __builtin_nontemporal_store(v[j] * rs * g, (f32x4*)(a.out + (size_t)r * D_ + c0)); }
    }
}

__global__ void __launch_bounds__(512, 2) mega(Args a) {
    extern __shared__ __attribute__((aligned(16))) unsigned char lds_raw[];
    LAS unsigned char* lds = (LAS unsigned char*)lds_raw;
    const int G = gridDim.x, bx = blockIdx.x;
    const int vb = (G % 8 == 0) ? (bx % 8) * (G / 8) + bx / 8 : bx;
    unsigned char* ws = a.ws;
    for (int u = threadIdx.x; u < (LDS_BYTES - LDSCTL_OFF) / 4; u += 512) ((LAS unsigned*)(lds + LDSCTL_OFF))[u] = 0u;
    __syncthreads();
    const bool multi = (a.ph_hi - a.ph_lo) > 1;
    XcdBarrier bar; bar.bar = (unsigned*)(ws + WS_CTL) + CW_BAR; bar.x = 0; bar.st = nullptr;
    if (multi) bar = xcd_barrier_post((unsigned*)(ws + WS_CTL) + CW_BAR, (volatile LAS unsigned*)(lds + L_MISC) + 8);
#define TS_MARK(k) do { if (TSPROBE >= 0 && bx == 0 && threadIdx.x == 0) { volatile LAS unsigned long long* tsl = (volatile LAS unsigned long long*)(lds + L_MISC + 128); if ((k) == TSPROBE) tsl[0] = __builtin_amdgcn_s_memrealtime(); if ((k) == TSPROBE + 1) tsl[1] = __builtin_amdgcn_s_memrealtime(); } } while (0)
#define SEAM(k) do { if (IN(k) && IN((k) + 1)) xcd_barrier(bar); TS_MARK((k) + 1); } while (0)
    TS_MARK(0);
#define IN(k) (a.ph_lo <= (k) && (k) < a.ph_hi)
    if (IN(0)) phase_p0(a, lds, vb, G);
    SEAM(0);
    if (IN(1)) phase_p1(a, lds, vb, G);
    SEAM(1);
    if (IN(2)) {
        pg8::Gemm g{(const bf16_t*)(ws + WS_XN), (const bf16_t*)(ws + WS_WINT), INC, D_, 0, 127, 127};
        pg8::DenseOrder S; S.init(T_ / 256, INC / 256, G, bx);
        pg8::EpiProj E{(bf16_t*)(ws + WS_PROJ)};
        conv_chunks(a, lds, bx & 7, (bx >= 128) ? CONV_PRE : 0);
        pg8::gemm_phase<pg8::EpiProj, pg8::DenseOrder, true>(lds, g, S, E);
        conv_chunks(a, lds, bx & 7, 1 << 30);
    }
    SEAM(2);
    if (IN(3)) { for (int L = vb; L < 512 + 480; L += G) { if (L < 512) pool_unit(a, lds, L); else kv_unit(a, lds, L - 512); } }
    SEAM(3);
    if (IN(4)) phase_scan(a, vb, G);
    SEAM(4);
#if EXTRA_BARRIERS
    if (multi) { for (int xb = 0; xb < EXTRA_BARRIERS; ++xb) xcd_barrier(bar); }
#endif
    if (IN(5)) { for (int L = vb; L < 512; L += G) ret_unit(a, lds, L); }
    SEAM(5);
    if (IN(6)) {
        pg8::Gemm g{(const bf16_t*)(ws + WS_MIXIN), (const bf16_t*)(ws + WS_WOUTT), D_, D_, 0, 127, 127};
        pg8::DenseOrder S; S.init(T_ / 256, D_ / 256, G, bx);
        pg8::EpiX1 E{a.in[0], (const float*)(ws + WS_MOD), (bf16_t*)(ws + WS_X1)};
        pg8::gemm_phase<pg8::EpiX1, pg8::DenseOrder, true>(lds, g, S, E);
    }
    SEAM(6);
    if (IN(7)) phase_router(a, lds, vb, G);
    SEAM(7);
    if (IN(8)) {
        GroupedOrder S; grouped_prepare(S, lds, ws, 2 * FF / 256, G, bx, 0, a.in[15]);
        pg8::Gemm g{(const bf16_t*)(ws + WS_HN), (const bf16_t*)(ws + WS_WGUT), 2 * FF, D_, (size_t)2 * FF * D_ * (GU_F8 ? 1 : 2), SCALE_W, SCALE_ONE};
        EpiGateUp E{(bf16_t*)(ws + WS_ACT), (LAS const float*)(lds + L_BIAS), (LAS const int*)(lds + L_PSTART)};
        pg8::gemm_phase<EpiGateUp, GroupedOrder, true, GU_F8>(lds, g, S, E);
    }
    SEAM(8);
    if (IN(9)) {
        GroupedOrder S; grouped_prepare(S, lds, ws, D_ / 256, G, bx, 1, a.in[17]);
        pg8::Gemm g{(const bf16_t*)(ws + WS_ACT), (const bf16_t*)(ws + WS_WDT), D_, FF, (size_t)D_ * FF * (DN_F8 ? 1 : 2), SCALE_W, SCALE_ACT};
        EpiDown E{(bf16_t*)(ws + WS_Y), (LAS const float*)(lds + L_BIAS), (LAS const int*)(lds + L_ROWTAB)};
        pg8::gemm_phase<EpiDown, GroupedOrder, true, DN_F8>(lds, g, S, E);
    }
    SEAM(9);
    if (IN(10)) phase_final(a, vb, G);
    TS_MARK(11);
    if (TSPROBE >= 0 && bx == 0 && threadIdx.x == 0) { volatile LAS unsigned long long* tsl = (volatile LAS unsigned long long*)(lds + L_MISC + 128); const unsigned long long d = (tsl[1] - tsl[0]) * 10ull, t0 = __builtin_amdgcn_s_memrealtime(); while (__builtin_amdgcn_s_memrealtime() - t0 < d) __builtin_amdgcn_s_sleep(8); }
#if REPEAT_MASK & 1572864
    if (IN(19)) { pg8::Gemm g{(const bf16_t*)(ws + WS_XN), (const bf16_t*)(ws + WS_WINT), INC, D_, 0, 127, 127}; pg8::DenseOrder S; S.init(T_ / 256, INC / 256, G, bx); EpiNone E; pg8::gemm_phase<EpiNone, pg8::DenseOrder, true>(lds, g, S, E); }
    if (IN(20)) { pg8::Gemm g{(const bf16_t*)(ws + WS_XN), (const bf16_t*)(ws + WS_WINT), INC, 2 * D_, 0, 127, 127}; pg8::DenseOrder S; S.init(T_ / 256, INC / 256, G, bx); EpiNone E; pg8::gemm_phase<EpiNone, pg8::DenseOrder, true, true>(lds, g, S, E); }
#endif
#if REPEAT_MASK & 196608
    if (IN(16)) { if (bx >= 128) conv_chunks(a, lds, bx & 7, 1 << 30); }
    if (IN(17)) { conv_chunks(a, lds, bx & 7, 1 << 30); }
#endif
#if REPEAT_MASK & 24576
    if (IN(13)) { for (int L = vb; L < 512; L += G) pool_unit(a, lds, L); }
    if (IN(14)) { for (int L = vb; L < 480; L += G) kv_unit(a, lds, L); }
#endif
#if REPEAT_MASK & 6144
    if (IN(11)) {
        GroupedOrder S; grouped_prepare(S, lds, ws, 2 * FF / 256, G, bx, 0, a.in[15]);
        pg8::Gemm g{(const bf16_t*)(ws + WS_HN), (const bf16_t*)(ws + WS_WGUT), 2 * FF, D_, (size_t)2 * FF * D_ * (GU_F8 ? 1 : 2), SCALE_W, SCALE_ONE};
        EpiNone E;
        pg8::gemm_phase<EpiNone, GroupedOrder, true, GU_F8>(lds, g, S, E);
    }
    if (IN(12)) {
        GroupedOrder S; grouped_prepare(S, lds, ws, D_ / 256, G, bx, 1, a.in[17]);
        pg8::Gemm g{(const bf16_t*)(ws + WS_ACT), (const bf16_t*)(ws + WS_WDT), D_, FF, (size_t)D_ * FF * (DN_F8 ? 1 : 2), SCALE_W, SCALE_ACT};
        EpiNone E;
        pg8::gemm_phase<EpiNone, GroupedOrder, true, DN_F8>(lds, g, S, E);
    }
#endif
#undef SEAM
#undef IN
}

extern "C" void kernel_launch(void* const* d_in, const int* in_sizes, int n_in, void* d_out, int out_size, void* d_ws, size_t ws_size, hipStream_t stream) {
    static int grid = 0;
    if (grid == 0) {
        if (n_in != 19 || in_sizes[0] != T_ * D_ || out_size != T_ * D_ || ws_size < WS_END) { fprintf(stderr, "kernel_launch: unexpected shapes / workspace (n_in %d, ws %zu)\n", n_in, ws_size); grid = -1; return; }
        int dev = 0, cus = 0, per_cu = 0;
        if (hipGetDevice(&dev) != hipSuccess || hipDeviceGetAttribute(&cus, hipDeviceAttributeMultiprocessorCount, dev) != hipSuccess) { grid = -1; return; }
        if (hipFuncSetAttribute((const void*)mega, hipFuncAttributeMaxDynamicSharedMemorySize, LDS_BYTES) != hipSuccess) { fprintf(stderr, "hipFuncSetAttribute failed\n"); grid = -1; return; }
        if (hipOccupancyMaxActiveBlocksPerMultiprocessor(&per_cu, (const void*)mega, 512, LDS_BYTES) != hipSuccess || per_cu < 1) { fprintf(stderr, "occupancy query: %d\n", per_cu); }
        (void)hipGetLastError();
        grid = cus;
        if (grid != 256) fprintf(stderr, "kernel_launch: grid %d (expected 256)\n", grid);
    }
    if (grid < 0) return;
    unsigned char* ws = (unsigned char*)d_ws;
    (void)hipMemsetAsync(ws + WS_CTL, 0, CTL_ZERO_BYTES, stream);
    Args a{};
    for (int i = 0; i < 19; ++i) a.in[i] = (const float*)d_in[i];
    a.out = (float*)d_out; a.ws = ws;
#define MEGA(lo, hi) do { a.ph_lo = (lo); a.ph_hi = (hi); hipLaunchKernelGGL(mega, dim3(grid), dim3(512), LDS_BYTES, stream, a); \
    if ((hi) - (lo) == 1 && (lo) != 7 && ((REPEAT_MASK >> (lo)) & 1)) { hipLaunchKernelGGL(mega, dim3(grid), dim3(512), LDS_BYTES, stream, a); hipLaunchKernelGGL(mega, dim3(grid), dim3(512), LDS_BYTES, stream, a); } } while (0)
#if ONE_LAUNCH
    MEGA(0, 11);
#else
    for (int ph = 0; ph < 11; ++ph) {
        MEGA(ph, ph + 1);
        if (ph == 2 && ((REPEAT_MASK >> 15) & 1)) {
            (void)hipMemsetAsync(ws + WS_CTL + 4096, 0, 4096, stream); a.ph_lo = 2; a.ph_hi = 3; hipLaunchKernelGGL(mega, dim3(grid), dim3(512), LDS_BYTES, stream, a);
            (void)hipMemsetAsync(ws + WS_CTL + 4096, 0, 4096, stream); hipLaunchKernelGGL(mega, dim3(grid), dim3(512), LDS_BYTES, stream, a);
        }
        if (ph == 7 && ((REPEAT_MASK >> 7) & 1)) {
            (void)hipMemsetAsync(ws + WS_CTL, 0, 4096, stream); a.ph_lo = 7; a.ph_hi = 8; hipLaunchKernelGGL(mega, dim3(grid), dim3(512), LDS_BYTES, stream, a);
            (void)hipMemsetAsync(ws + WS_CTL, 0, 4096, stream); hipLaunchKernelGGL(mega, dim3(grid), dim3(512), LDS_BYTES, stream, a);
        }
    }
#if REPEAT_MASK & 524288
    MEGA(19, 20);
#endif
#if REPEAT_MASK & 1048576
    MEGA(20, 21);
#endif
#if REPEAT_MASK & 262144
    for (int z = 0; z < 20; ++z) MEGA(30, 31);
#endif
#if REPEAT_MASK & 65536
    (void)hipMemsetAsync(ws + WS_CTL + 4096, 0, 4096, stream); MEGA(16, 17);
#endif
#if REPEAT_MASK & 131072
    (void)hipMemsetAsync(ws + WS_CTL + 4096, 0, 4096, stream); MEGA(17, 18);
#endif
#if REPEAT_MASK & 2048
    MEGA(11, 12);
#endif
#if REPEAT_MASK & 4096
    MEGA(12, 13);
#endif
#if REPEAT_MASK & 8192
    MEGA(13, 14);
#endif
#if REPEAT_MASK & 16384
    MEGA(14, 15);
#endif
#endif
}
```

```cpp
#include <hip/hip_runtime.h>
#include <cstdint>
#include <cstdio>

typedef unsigned short bf16_t;
typedef short bf16x8 __attribute__((ext_vector_type(8)));
typedef float f32x4 __attribute__((ext_vector_type(4)));
typedef unsigned u32x4 __attribute__((ext_vector_type(4)));
typedef unsigned u32x2 __attribute__((ext_vector_type(2)));
#define LAS __attribute__((address_space(3)))

#ifndef GU_F8
#define GU_F8 true
#endif
#ifndef DN_F8
#define DN_F8 true
#endif
#ifndef Y_F8
#define Y_F8 true
#endif
#ifndef DWGM
#define DWGM 8
#endif
#ifndef PAIR_HALVES
#define PAIR_HALVES 0
#endif
#ifndef GWGM
#define GWGM 2
#endif
#ifndef P2_SPLIT
#define P2_SPLIT 1
#endif
#ifndef GEMM_CUS
#define GEMM_CUS 128
#endif
#ifndef CONV_PRE
#define CONV_PRE 24
#endif
#ifndef TSPROBE
#define TSPROBE -1
#endif
#ifndef TSBLOCK
#define TSBLOCK 0
#endif
#ifndef EXTRA_BARRIERS
#define EXTRA_BARRIERS 0
#endif
#ifndef REPEAT_MASK
#define REPEAT_MASK 0
#endif
#ifndef ONE_LAUNCH
#define ONE_LAUNCH 1
#endif
#ifndef SIMPLE_MIX
#define SIMPLE_MIX 0
#endif
#ifndef SIMPLE_ROUTER
#define SIMPLE_ROUTER 0
#endif
#ifndef SIMPLE_FINAL
#define SIMPLE_FINAL 0
#endif
#ifndef SIMPLE_INPROJ
#define SIMPLE_INPROJ 0
#endif
#ifndef SIMPLE_OUTPROJ
#define SIMPLE_OUTPROJ 0
#endif
#ifndef SIMPLE_GATEUP
#define SIMPLE_GATEUP 0
#endif
#ifndef SIMPLE_DOWN
#define SIMPLE_DOWN 0
#endif
constexpr int T_ = 16384, D_ = 1024, NB = 8, SEQ = 2048, INC = 2560, NE = 32, FF = 1024, TK = 65536, NMOD = 6144;
constexpr int CAP = 16384;
constexpr int ACT_ROWS = TK + NE * 256;
constexpr float EPS = 1e-6f;

constexpr size_t MiB = 1u << 20;
constexpr size_t WS_CTL = 0, CTL_ZERO_BYTES = 32768;
constexpr size_t WS_MODP = 1 * MiB;
constexpr size_t WS_MOD = 3 * MiB;
constexpr size_t WS_ROPE = 4 * MiB;
constexpr size_t WS_POOLWT = 5 * MiB;
constexpr size_t WS_WINT = 6 * MiB;
constexpr size_t WS_WOUTT = 11 * MiB;
constexpr size_t WS_TOKSLOT = 13 * MiB;
constexpr size_t WS_WSLOT = 15 * MiB;
constexpr size_t WS_WGUT = 16 * MiB;
constexpr size_t WS_WDT = 144 * MiB;
constexpr size_t WS_XN = 208 * MiB;
constexpr size_t WS_PROJ = 240 * MiB;
constexpr size_t WS_KVT = 320 * MiB;
constexpr size_t WS_RT = 352 * MiB;
constexpr size_t WS_MIXIN = 368 * MiB;
constexpr size_t WS_X1 = 400 * MiB;
constexpr size_t WS_HN = 464 * MiB;
constexpr size_t WS_ACT = 496 * MiB;
constexpr size_t WS_Y = 640 * MiB;
constexpr size_t WS_QR = 768 * MiB;
constexpr size_t WS_KR = 784 * MiB;
constexpr size_t WS_SG = 800 * MiB;
constexpr size_t WS_OG = 832 * MiB;
constexpr size_t WS_H2F = 864 * MiB;
constexpr size_t WS_LOGITS = 928 * MiB;
constexpr size_t WS_PP = 930 * MiB;
constexpr size_t WS_RW3 = WS_MODP;
constexpr size_t WS_RBIAS = 3 * MiB + 512 * 1024;
constexpr size_t WS_END = 946 * MiB;
constexpr int CW_CNT = 64;
constexpr int CW_PSTART = 128;

#define MFMA16(a, b, c) __builtin_amdgcn_mfma_f32_16x16x32_bf16(a, b, c, 0, 0, 0)
typedef float f32x2_t __attribute__((ext_vector_type(2)));
typedef __bf16 bf16x2_t __attribute__((ext_vector_type(2)));
__device__ __forceinline__ unsigned pk2(float lo, float hi) { const f32x2_t v = {lo, hi}; const bf16x2_t b = __builtin_convertvector(v, bf16x2_t); return __builtin_bit_cast(unsigned, b); }
__device__ __forceinline__ unsigned f2bf(float f) { return pk2(f, 0.f) & 0xffffu; }
__device__ __forceinline__ float bf2f(unsigned h) { return __uint_as_float(h << 16); }
template <int CTRL> __device__ __forceinline__ float dppf(float v) { return __builtin_bit_cast(float, __builtin_amdgcn_update_dpp(0, __builtin_bit_cast(int, v), CTRL, 0xf, 0xf, true)); }
__device__ __forceinline__ float rlane(float v, int l) { return __builtin_bit_cast(float, __builtin_amdgcn_readlane(__builtin_bit_cast(int, v), l)); }
__device__ __forceinline__ float wave_sum(float v) {
    v += dppf<0xB1>(v); v += dppf<0x4E>(v); v += dppf<0x124>(v); v += dppf<0x128>(v);
    return (rlane(v, 0) + rlane(v, 16)) + (rlane(v, 32) + rlane(v, 48));
}
__device__ __forceinline__ float row_max16(float v) { v = fmaxf(v, dppf<0xB1>(v)); v = fmaxf(v, dppf<0x4E>(v)); v = fmaxf(v, dppf<0x124>(v)); v = fmaxf(v, dppf<0x128>(v)); return v; }
__device__ __forceinline__ float silu_f(float v) { return v * __builtin_amdgcn_rcpf(1.f + __builtin_amdgcn_exp2f(-1.4426950408889634f * v)); }
__device__ __forceinline__ float log2_gamma(int h) { return h == 0 ? -0.04580368961312479f : h == 1 ? -0.02272007650008353f : h == 2 ? -0.011315313227834146f : -0.005646563141142062f; }
__device__ __forceinline__ float fexp2(float x) { return __builtin_amdgcn_exp2f(x); }
__device__ __forceinline__ float frsq(float x) { return __builtin_amdgcn_rsqf(x); }

constexpr int NWAVES = 8;
constexpr float WSCALE = 64.f;
constexpr int SCALE_W = 121, SCALE_ONE = 127, SCALE_ACT = 125;
constexpr float ASCALE = 4.f;
constexpr float YSCALE = 16.f;
typedef int i32x8 __attribute__((ext_vector_type(8)));
typedef int i32x4 __attribute__((ext_vector_type(4)));
constexpr int LDS_BYTES = 163840;

constexpr int RING_BYTES = 131072, LDSCTL_OFF = RING_BYTES;
constexpr int L_MISC = LDSCTL_OFF;
constexpr int L_CNT = LDSCTL_OFF + 256;
constexpr int L_PSTART = LDSCTL_OFF + 384;
constexpr int L_NT = LDSCTL_OFF + 640;
constexpr int L_TILES = LDSCTL_OFF + 768;
constexpr int L_ROWTAB = LDSCTL_OFF + 2048;
constexpr int MAX_UNITS = 12;
constexpr int L_BIAS = L_ROWTAB + MAX_UNITS * 1024;
static_assert(L_BIAS + MAX_UNITS * 1024 <= LDS_BYTES, "LDS map");
constexpr int CW_BAR = 4096;

#define TS_SUB(k) do { if (TSPROBE >= 100 && blockIdx.x == TSBLOCK && threadIdx.x == 0) { volatile LAS unsigned long long* tsl = (volatile LAS unsigned long long*)(lds + L_MISC + 128); if ((k) + 100 == TSPROBE && tsl[0] == 0) tsl[0] = __builtin_amdgcn_s_memrealtime(); if ((k) + 99 == TSPROBE && tsl[1] == 0) tsl[1] = __builtin_amdgcn_s_memrealtime(); } } while (0)
template <int MAPMODE, bool F8 = false>
__device__ __forceinline__ void transpose_item(const float* W, int K, int N, bf16_t* WT, LAS float* scr, int item, int lane) {
    const int nblk = N / 32, kb = item / nblk, nb = item % nblk, k0 = 64 * kb, n0 = 32 * nb;
    {
        float v[32];
        const float* wp = W + (size_t)(k0 + (lane >> 5)) * N + n0 + (lane & 31);
#pragma unroll
        for (int i = 0; i < 32; ++i) v[i] = wp[(size_t)(2 * i) * N];
        __builtin_amdgcn_sched_barrier(0);
#pragma unroll
        for (int i = 0; i < 32; ++i) scr[(2 * i + (lane >> 5)) * 33 + (lane & 31)] = v[i];
    }
    asm volatile("s_waitcnt lgkmcnt(0)" ::: "memory");
    const int c = lane & 7;
#pragma unroll
    for (int j = 0; j < 4; ++j) {
        const int nl = (lane >> 3) + 8 * j; const LAS float* s = scr + (8 * c) * 33 + nl;
        const int n = n0 + nl; int row = n;
        if (MAPMODE == 1) { const int a = n >> 1, bj = n & 1; row = 256 * (a >> 7) + 128 * bj + (a & 127); }
        if constexpr (F8) {
            int w0 = __builtin_amdgcn_cvt_pk_fp8_f32(s[0 * 33] * WSCALE, s[1 * 33] * WSCALE, 0, false); w0 = __builtin_amdgcn_cvt_pk_fp8_f32(s[2 * 33] * WSCALE, s[3 * 33] * WSCALE, w0, true);
            int w1 = __builtin_amdgcn_cvt_pk_fp8_f32(s[4 * 33] * WSCALE, s[5 * 33] * WSCALE, 0, false); w1 = __builtin_amdgcn_cvt_pk_fp8_f32(s[6 * 33] * WSCALE, s[7 * 33] * WSCALE, w1, true);
            u32x2 o; o.x = (unsigned)w0; o.y = (unsigned)w1;
            *(u32x2*)((unsigned char*)WT + (size_t)row * K + k0 + 8 * c) = o;
        } else {
            u32x4 o; o.x = pk2(s[0 * 33], s[1 * 33]); o.y = pk2(s[2 * 33], s[3 * 33]); o.z = pk2(s[4 * 33], s[5 * 33]); o.w = pk2(s[6 * 33], s[7 * 33]);
            *(u32x4*)(WT + (size_t)row * K + k0 + 8 * c) = o;
        }
    }
    asm volatile("s_waitcnt lgkmcnt(0)" ::: "memory");
}

struct Args {
    const float* in[19]; float* out; unsigned char* ws; int ph_lo, ph_hi;
};

__device__ __forceinline__ void phase_p0(const Args& a, LAS unsigned char* lds, int vb, int G) {
    const int tid = threadIdx.x, lane = tid & 63, wave = tid >> 6;
    unsigned char* ws = a.ws;
    if (vb < 256) {
        LAS float* cact = (LAS float*)lds;
        LAS float* part = (LAS float*)(lds + 4096);
        const int kc = vb & 7, cc = vb >> 3;
        const float* c = a.in[1];
        for (int i = tid; i < 8 * 128; i += 512) { const int b = i >> 7, k = i & 127; cact[i] = silu_f(c[b * D_ + kc * 128 + k]); }
        __syncthreads();
        const int cg = tid % 48, ks = tid / 48;
        if (ks < 10) {
            f32x4 acc[8];
#pragma unroll
            for (int b = 0; b < 8; ++b) acc[b] = (f32x4){0.f, 0.f, 0.f, 0.f};
            const float* w = a.in[2] + (size_t)(kc * 128) * NMOD + cc * 192 + cg * 4;
            f32x4 wv[13];
#pragma unroll
            for (int i = 0; i < 13; ++i) { const int k = ks + 10 * i; wv[i] = (k < 128) ? __builtin_nontemporal_load((const f32x4*)(w + (size_t)k * NMOD)) : (f32x4){0.f, 0.f, 0.f, 0.f}; }
            __builtin_amdgcn_sched_barrier(0);
#pragma unroll
            for (int i = 0; i < 13; ++i) { const int k = ks + 10 * i;
                if (k < 128) {
#pragma unroll
                    for (int b = 0; b < 8; ++b) acc[b] += wv[i] * cact[b * 128 + k]; } }
#pragma unroll
            for (int b = 0; b < 8; ++b) *(LAS f32x4*)(part + (ks * 8 + b) * 192 + cg * 4) = acc[b];
        }
        __syncthreads();
        float* modp = (float*)(ws + WS_MODP);
        for (int i = tid; i < 8 * 192; i += 512) {
            const int b = i / 192, col = i % 192; float s = 0.f;
#pragma unroll
            for (int q = 0; q < 10; ++q) s += part[(q * 8 + b) * 192 + col];
            modp[((size_t)kc * 8 + b) * NMOD + cc * 192 + col] = s;
        }
        __syncthreads();
    }
    {
        float* cosT = (float*)(ws + WS_ROPE); float* sinT = cosT + SEQ * 64;
        for (int i = vb * 512 + tid; i < SEQ * 64; i += G * 512) {
            const int pos = i >> 6, j = i & 63;
            const double inv = (double)(float)exp(-(double)j * (9.210340371976184 / 64.0));
            const double ang = (double)((float)pos * (float)inv);
            const double q = rint(ang * 0.6366197723675814);
            double r = fma(-q, 1.5707963267948966, ang); r = fma(-q, 6.123233995736766e-17, r);
            const double r2 = r * r;
            double s = -1.0 / 39916800.0; s = s * r2 + 1.0 / 362880.0; s = s * r2 - 1.0 / 5040.0; s = s * r2 + 1.0 / 120.0; s = s * r2 - 1.0 / 6.0; s = s * r2 + 1.0; s *= r;
            double co = 1.0 / 479001600.0; co = co * r2 - 1.0 / 3628800.0; co = co * r2 + 1.0 / 40320.0; co = co * r2 - 1.0 / 720.0; co = co * r2 + 1.0 / 24.0; co = co * r2 - 0.5; co = co * r2 + 1.0;
            const int n = ((int)q) & 3;
            const double sv = (n == 0) ? s : (n == 1) ? co : (n == 2) ? -s : -co;
            const double cv = (n == 0) ? co : (n == 1) ? -s : (n == 2) ? -co : s;
            cosT[i] = (float)cv; sinT[i] = (float)sv;
        }
    }
    {
        LAS float* scr = (LAS float*)(lds + wave * 16384);
        const int gw = vb * NWAVES + wave, NGW = G * NWAVES;
        constexpr int I_IN = (D_ / 64) * (INC / 32), I_OUT = (D_ / 64) * (D_ / 32), I_POOL = 4 * 2 * 4;
        constexpr int NITEMS = I_IN + I_OUT + I_POOL;
        for (int it = gw; it < NITEMS; it += NGW) {
            int r = it;
            if (r < I_IN) { transpose_item<0>(a.in[5], D_, INC, (bf16_t*)(ws + WS_WINT), scr, r, lane); continue; } r -= I_IN;
            if (r < I_OUT) { transpose_item<0>(a.in[10], D_, D_, (bf16_t*)(ws + WS_WOUTT), scr, r, lane); continue; } r -= I_OUT;
            { const int g = r / 8; transpose_item<0>(a.in[6] + g * 128 * 128, 128, 128, (bf16_t*)(ws + WS_POOLWT) + g * 128 * 128, scr, r % 8, lane); }
        }
    }
}

constexpr int MOE_ITEMS_GU = (D_ / 64) * (2 * FF / 32), MOE_ITEMS_DN = (FF / 64) * (D_ / 32);
constexpr int MOE_ITEMS = NE * (MOE_ITEMS_GU + MOE_ITEMS_DN), QCHUNKS = MOE_ITEMS / 8 / 8;
static_assert(QCHUNKS * 64 == MOE_ITEMS, "queue geometry");
constexpr int CW_Q = 1024, QGRAB = 4;
static_assert(QCHUNKS % QGRAB == 0, "queue grab");
struct MoeItem { const float* wp; unsigned char* dst; int K, N, k0, n0, mode; bool f8; };
__device__ __forceinline__ MoeItem moe_decode(const Args& a, int r, int lane) {
    MoeItem it; unsigned char* ws = a.ws; int item; const float* W;
    if (r < NE * MOE_ITEMS_GU) { const int e = r / MOE_ITEMS_GU; item = r % MOE_ITEMS_GU; W = a.in[14] + (size_t)e * D_ * 2 * FF; it.K = D_; it.N = 2 * FF; it.mode = 1; it.f8 = GU_F8; it.dst = ws + WS_WGUT + (size_t)e * 2 * FF * D_ * (GU_F8 ? 1 : 2); }
    else { r -= NE * MOE_ITEMS_GU; const int e = r / MOE_ITEMS_DN; item = r % MOE_ITEMS_DN; W = a.in[16] + (size_t)e * FF * D_; it.K = FF; it.N = D_; it.mode = 0; it.f8 = DN_F8; it.dst = ws + WS_WDT + (size_t)e * D_ * FF * (DN_F8 ? 1 : 2); }
    const int nblk = it.N / 32, kb = item / nblk, nb = item % nblk; it.k0 = 64 * kb; it.n0 = 32 * nb;
    it.wp = W + (size_t)(it.k0 + (lane >> 5)) * it.N + it.n0 + (lane & 31);
    return it;
}
__device__ __forceinline__ void moe_load(const MoeItem& it, float (&v)[32]) {
#pragma unroll
    for (int i = 0; i < 32; ++i) v[i] = __builtin_nontemporal_load(it.wp + (size_t)(2 * i) * it.N);
}
__device__ __forceinline__ void moe_finish(const MoeItem& it, const float (&v)[32], LAS float* scr, int lane) {
#pragma unroll
    for (int i = 0; i < 32; ++i) scr[(2 * i + (lane >> 5)) * 33 + (lane & 31)] = v[i];
    asm volatile("s_waitcnt lgkmcnt(0)" ::: "memory");
    const int c = lane & 7;
#pragma unroll
    for (int j = 0; j < 4; ++j) {
        const int nl = (lane >> 3) + 8 * j; const LAS float* s = scr + (8 * c) * 33 + nl;
        const int n = it.n0 + nl; int row = n;
        if (it.mode == 1) { const int aa = n >> 1, bj = n & 1; row = 256 * (aa >> 7) + 128 * bj + (aa & 127); }
        if (it.f8) {
            int w0 = __builtin_amdgcn_cvt_pk_fp8_f32(s[0 * 33] * WSCALE, s[1 * 33] * WSCALE, 0, false); w0 = __builtin_amdgcn_cvt_pk_fp8_f32(s[2 * 33] * WSCALE, s[3 * 33] * WSCALE, w0, true);
            int w1 = __builtin_amdgcn_cvt_pk_fp8_f32(s[4 * 33] * WSCALE, s[5 * 33] * WSCALE, 0, false); w1 = __builtin_amdgcn_cvt_pk_fp8_f32(s[6 * 33] * WSCALE, s[7 * 33] * WSCALE, w1, true);
            u32x2 o; o.x = (unsigned)w0; o.y = (unsigned)w1;
            __builtin_nontemporal_store(o, (u32x2*)(it.dst + (size_t)row * it.K + it.k0 + 8 * c));
        } else {
            u32x4 o; o.x = pk2(s[0 * 33], s[1 * 33]); o.y = pk2(s[2 * 33], s[3 * 33]); o.z = pk2(s[4 * 33], s[5 * 33]); o.w = pk2(s[6 * 33], s[7 * 33]);
            *(u32x4*)((bf16_t*)it.dst + (size_t)row * it.K + it.k0 + 8 * c) = o;
        }
    }
    asm volatile("s_waitcnt lgkmcnt(0)" ::: "memory");
}
__device__ __forceinline__ void conv_chunks(const Args& a, LAS unsigned char* lds, int myq, int maxchunks) {
    const int tid = threadIdx.x, lane = tid & 63, wave = __builtin_amdgcn_readfirstlane(tid >> 6);
    LAS float* scr = (LAS float*)(lds + wave * 16384);
    volatile LAS int* slot = (volatile LAS int*)(lds + L_MISC) + 16;
    unsigned* heads = (unsigned*)(a.ws + WS_CTL) + CW_Q;
    int done = 0;
    static_assert(QGRAB == 4, "the pipelined loop below is written for four chunks per grab");
    for (int qq = 0; qq < 8 && done < maxchunks; ++qq) {
        const int q = (myq + qq) & 7;
        for (;;) {
            if (done >= maxchunks) break;
            if (tid == 0) *slot = (int)__hip_atomic_fetch_add(heads + 64 * q, (unsigned)QGRAB, __ATOMIC_RELAXED, __HIP_MEMORY_SCOPE_AGENT);
            __syncthreads();
            const int c = *slot;
            __syncthreads();
            if (c >= QCHUNKS) break;
            const int r0 = (q * QCHUNKS + c) * 8 + wave;
            float va[32], vb[32];
            MoeItem i0 = moe_decode(a, r0, lane), i1 = moe_decode(a, r0 + 8, lane), i2 = moe_decode(a, r0 + 16, lane), i3 = moe_decode(a, r0 + 24, lane);
            moe_load(i0, va); moe_load(i1, vb); __builtin_amdgcn_sched_barrier(0);
            moe_finish(i0, va, scr, lane); __builtin_amdgcn_sched_barrier(0);
            moe_load(i2, va); __builtin_amdgcn_sched_barrier(0);
            moe_finish(i1, vb, scr, lane); __builtin_amdgcn_sched_barrier(0);
            moe_load(i3, vb); __builtin_amdgcn_sched_barrier(0);
            moe_finish(i2, va, scr, lane); __builtin_amdgcn_sched_barrier(0);
            moe_finish(i3, vb, scr, lane);
            done += QGRAB;
        }
    }
    __syncthreads();
}

__device__ __forceinline__ void phase_p1(const Args& a, LAS unsigned char* lds, int vb, int G) {
    const int tid = threadIdx.x, lane = tid & 63, wave = tid >> 6;
    unsigned char* ws = a.ws;
    const float* modp = (const float*)(ws + WS_MODP); float* mod = (float*)(ws + WS_MOD);
    for (int i = vb * 512 + tid; i < NB * NMOD; i += G * 512) {
        const int col = i % NMOD; float s = a.in[3][col];
#pragma unroll
        for (int q = 0; q < 8; ++q) s += modp[(size_t)q * NB * NMOD + i];
        mod[i] = s;
    }
    const int RPB = T_ / G;
    const int row0 = vb * RPB, b = row0 / SEQ;
    LAS float* shs = (LAS float*)lds;
    LAS float* scs = shs + 1024;
    {
        float pv[4][9];
#pragma unroll
        for (int it = 0; it < 4; ++it) { const int i = tid + 512 * it; pv[it][8] = a.in[3][i];
#pragma unroll
            for (int q = 0; q < 8; ++q) pv[it][q] = modp[(size_t)q * NB * NMOD + (size_t)b * NMOD + i]; }
        __builtin_amdgcn_sched_barrier(0);
#pragma unroll
        for (int it = 0; it < 4; ++it) { const int i = tid + 512 * it; float sv = pv[it][8];
#pragma unroll
            for (int q = 0; q < 8; ++q) sv += pv[it][q];
            if (i < 1024) shs[i] = sv; else scs[i - 1024] = (1.f + sv) * a.in[4][i - 1024]; }
    }
    __syncthreads();
    bf16_t* XN = (bf16_t*)(ws + WS_XN);
    for (int rb = row0 + wave * (RPB / NWAVES); rb < row0 + (wave + 1) * (RPB / NWAVES); rb += 8) {
        f32x4 v[8][4];
#pragma unroll
        for (int q = 0; q < 8; ++q)
#pragma unroll
            for (int j = 0; j < 4; ++j) v[q][j] = __builtin_nontemporal_load((const f32x4*)(a.in[0] + (size_t)(rb + q) * D_) + lane + 64 * j);
        __builtin_amdgcn_sched_barrier(0);
#pragma unroll
        for (int q = 0; q < 8; ++q) {
            float ss = 0.f;
#pragma unroll
            for (int j = 0; j < 4; ++j) ss += (v[q][j].x * v[q][j].x + v[q][j].y * v[q][j].y) + (v[q][j].z * v[q][j].z + v[q][j].w * v[q][j].w);
            const float rs = frsq(wave_sum(ss) * (1.f / D_) + EPS);
            unsigned long long* o8 = (unsigned long long*)(XN + (size_t)(rb + q) * D_) + lane;
#pragma unroll
            for (int j = 0; j < 4; ++j) {
                const int c0 = 4 * lane + 256 * j;
                const f32x4 hv = v[q][j] * rs * *(const LAS f32x4*)(scs + c0) + *(const LAS f32x4*)(shs + c0);
                o8[64 * j] = (unsigned long long)pk2(hv[0], hv[1]) | ((unsigned long long)pk2(hv[2], hv[3]) << 32);
            }
        }
    }
    __syncthreads();
}

namespace pg8 {
constexpr int BM = 256, BK = 64, HALF = 128, HTB = HALF * BK * 2, STAGE_BYTES = 8 * HTB, NXCD = 8, WGM = 8;
__host__ __device__ __forceinline__ int lds_byte(int r, int c) { const int st = (r >> 4) * 2 + (c >> 5), rr = r & 15, cc = c & 31, ob = rr * 64 + cc * 2; return st * 1024 + (ob ^ (((ob >> 9) & 1) << 5)); }
__host__ __device__ __forceinline__ void stage_rc(int b, int& R, int& C) { const int st = b / 1024, sb = b % 1024, swz = sb ^ (((sb >> 9) & 1) << 5); R = (st >> 1) * 16 + swz / 64; C = (st & 1) * 32 + (swz % 64) / 2; }
__host__ __device__ __forceinline__ int perm32(int rho) { const int n = rho >> 4, i = rho & 15; return 8 * (i >> 2) + 4 * n + (i & 3); }

struct Unit { int pm, pn, e, r0; };
struct Gemm { const bf16_t* A; const bf16_t* Bt; int N, K; size_t bstride; int sw, so; };

struct TileOrder {
    int nM, nN, nwg, G, c, wgm;
    __device__ __forceinline__ void init(int nM_, int nN_, int G_, int c_, int wgm_ = WGM) { nM = nM_; nN = nN_; nwg = nM * nN; G = G_; c = c_; wgm = wgm_; }
    __device__ __forceinline__ bool tile(int i, int& pm, int& pn) const {
        const long L = (long)i * G + c; if (L >= nwg) return false;
        int wgid = (int)L; { const int q = nwg / NXCD, r = nwg % NXCD, xcd = wgid % NXCD, off = wgid / NXCD; wgid = (xcd < r ? xcd * (q + 1) : r * (q + 1) + (xcd - r) * q) + off; }
        const int nig = wgm * nN, gid = wgid / nig, fm = gid * wgm, gsz = (nM - fm) < wgm ? (nM - fm) : wgm;
        pm = fm + ((wgid % nig) % gsz); pn = (wgid % nig) / gsz; return true;
    }
};
struct DenseOrder : TileOrder {
    __device__ __forceinline__ bool next(int i, Unit& u) const { int pm, pn; if (!tile(i, pm, pn)) return false; u.pm = pm; u.pn = pn; u.e = 0; u.r0 = pm * BM; return true; }
    __device__ __forceinline__ int arow(int, const Unit& u, int lr) const { return u.r0 + lr; }
};

__device__ __forceinline__ unsigned cvt_pk_bf16(float lo, float hi) { unsigned r; asm volatile("v_cvt_pk_bf16_f32 %0, %1, %2" : "=v"(r) : "v"(lo), "v"(hi)); return r; }

template <class Epi, class Sched, bool ALIGN_EPI, bool F8 = false>
__device__ __forceinline__ void gemm_phase(LAS unsigned char* lds, const Gemm g, const Sched& S, const Epi& E) {
    const int tid = threadIdx.x, wid = __builtin_amdgcn_readfirstlane(tid >> 6), lane = tid & 63, wr = wid >> 2, wc = wid & 3, fr = lane & 15, fq = lane >> 4;
#define PG8_PIECE(i) (PAIR_HALVES ? ((2 * wid + (i)) * 1024 + lane * 16) : (tid * 16 + (i) * 8192))
    const int K = F8 ? g.K / 2 : g.K, nt = K / BK;
    unsigned voffB[2];
#pragma unroll
    for (int i = 0; i < 2; ++i) { int R, C; stage_rc(PG8_PIECE(i), R, C); const int Rb = Epi::PERM ? ((R & ~31) + perm32(R & 31)) : R; voffB[i] = (unsigned)(Rb * K + C) * 2u; }
    const size_t kstep = (size_t)(BK * 2);
    const size_t hstep = (size_t)HALF * K * 2;
    const size_t tstep = 2 * hstep;
    const unsigned ldsw = (unsigned)wid * (PAIR_HALVES ? 2048u : 1024u);
    const int aoff = lds_byte(wr * 64 + fr, fq * 8), boff = lds_byte(wc * 32 + fr, fq * 8);
#define PG8_SA(b, h) (((b) * 2 + (h)) * HTB)
#define PG8_SB(b, h) ((4 + (b) * 2 + (h)) * HTB)
#define PG8_STAGE(bufoff, gbase, voff) do { _Pragma("unroll") for (int _i = 0; _i < 2; ++_i) \
        __builtin_amdgcn_global_load_lds((const unsigned*)((const char*)(gbase) + (voff)[_i]), (LAS unsigned*)(lds + (bufoff) + ldsw + _i * (PAIR_HALVES ? 1024 : 8192)), 16, 0, 0); } while (0)
#define PG8_LDA(dst, b, h) do { _Pragma("unroll") for (int m = 0; m < 4; ++m) _Pragma("unroll") for (int k = 0; k < 2; ++k) dst[m][k] = *(const LAS bf16x8*)(lds + PG8_SA(b, h) + aoff + m * 2048 + k * 1024); } while (0)
#define PG8_LDB(dst, b, h) do { _Pragma("unroll") for (int n = 0; n < 2; ++n) _Pragma("unroll") for (int k = 0; k < 2; ++k) dst[n][k] = *(const LAS bf16x8*)(lds + PG8_SB(b, h) + boff + n * 2048 + k * 1024); } while (0)
#define PG8_CAT(x) __builtin_shufflevector(__builtin_bit_cast(i32x4, x[0]), __builtin_bit_cast(i32x4, x[1]), 0, 1, 2, 3, 4, 5, 6, 7)
#define PG8_MMA(ai, bj, At, Bt) do { __builtin_amdgcn_s_setprio(1); _Pragma("unroll") for (int m = 0; m < 4; ++m) _Pragma("unroll") for (int n = 0; n < 2; ++n) { \
        if constexpr (F8) { asm volatile("v_mfma_scale_f32_16x16x128_f8f6f4 %0, %1, %2, %0, %3, %4 op_sel_hi:[0,0,0]" : "+v"(acc[ai][bj][m][n]) : "v"(PG8_CAT(Bt[n])), "v"(PG8_CAT(At[m])), "v"(f8sw), "v"(f8so)); } \
        else { _Pragma("unroll") for (int k = 0; k < 2; ++k) acc[ai][bj][m][n] = __builtin_amdgcn_mfma_f32_16x16x32_bf16(Bt[n][k], At[m][k], acc[ai][bj][m][n], 0, 0, 0); } } \
        __builtin_amdgcn_s_setprio(0); } while (0)
#define PG8_WAIT_V(n) asm volatile("s_waitcnt vmcnt(" #n ")" ::: "memory")
#define PG8_WAIT_L(n) asm volatile("s_waitcnt lgkmcnt(" #n ")" ::: "memory")
#define PG8_BAR __builtin_amdgcn_s_barrier()
#define PG8_SCHED __builtin_amdgcn_sched_barrier(0)
#define PG8_AOFF(dst, i_, u_) do { _Pragma("unroll") for (int _i = 0; _i < 2; ++_i) { int _R, _C; stage_rc(PG8_PIECE(_i), _R, _C); _Pragma("unroll") for (int _h = 0; _h < 2; ++_h) \
        dst[_h][_i] = ((unsigned)S.arow(i_, u_, _h * HALF + _R) * (unsigned)K + (unsigned)_C) * 2u; } } while (0)
    Unit cur, nxt; int ui = 0;
    if (!S.next(0, cur)) return;
    if constexpr (Epi::TIMED == 1) TS_SUB(50);
    int f8sw = g.sw, f8so = g.so;
    if constexpr (F8) asm volatile("" : "+v"(f8sw), "+v"(f8so));
    f32x4 acc[2][2][4][2];
#pragma unroll
    for (int a = 0; a < 2; ++a)
#pragma unroll
        for (int b = 0; b < 2; ++b)
#pragma unroll
            for (int m = 0; m < 4; ++m)
#pragma unroll
                for (int n = 0; n < 2; ++n) acc[a][b][m][n] = (f32x4){0.f, 0.f, 0.f, 0.f};
    bf16x8 At[4][2], B0[2][2], B1[2][2];
    unsigned voffA[2][2], v2[2][2];
    PG8_AOFF(voffA, 0, cur);
    const char* const cA = (const char*)g.A;
    const char* cB = (const char*)g.Bt + (size_t)cur.e * g.bstride + (size_t)cur.pn * tstep;
    PG8_STAGE(PG8_SB(0, 0), cB, voffB); PG8_STAGE(PG8_SB(0, 1), cB + hstep, voffB); PG8_STAGE(PG8_SA(0, 0), cA, voffA[0]); PG8_STAGE(PG8_SA(0, 1), cA, voffA[1]);
    if (wr == 1) PG8_BAR;
    PG8_WAIT_V(2); PG8_BAR;
    PG8_STAGE(PG8_SB(1, 0), cB + kstep, voffB); PG8_STAGE(PG8_SA(1, 0), cA + kstep, voffA[0]); PG8_STAGE(PG8_SB(1, 1), cB + hstep + kstep, voffB);
    PG8_WAIT_V(6); PG8_BAR;
    for (;;) {
        if constexpr (Epi::TIMED == 2) { if (ui == 2) TS_SUB(60); if (ui == 3) TS_SUB(63); }
        const bool has_next = S.next(ui + 1, nxt);
        const char* nB = has_next ? (const char*)g.Bt + (size_t)nxt.e * g.bstride + (size_t)nxt.pn * tstep : cB;
#pragma unroll 1
        for (int t = 0; t < nt; t += 2) {
            const bool last = (t == nt - 2);
            const char* a1 = cA + (size_t)(t + 1) * kstep;
            const char* a2 = last ? cA : cA + (size_t)(t + 2) * kstep; const char* b2 = last ? nB : cB + (size_t)(t + 2) * kstep;
            const char* a3 = a2 + kstep; const char* b3 = b2 + kstep;
            if (last && has_next) { PG8_AOFF(v2, ui + 1, nxt); }
            else {
#pragma unroll
                for (int h = 0; h < 2; ++h)
#pragma unroll
                    for (int i = 0; i < 2; ++i) v2[h][i] = voffA[h][i];
            }
            PG8_LDB(B0, 0, 0); PG8_LDB(B1, 0, 1); PG8_SCHED; PG8_LDA(At, 0, 0); PG8_STAGE(PG8_SA(1, 1), a1, voffA[1]);
            PG8_WAIT_V(8); PG8_WAIT_L(0); PG8_BAR; PG8_MMA(0, 0, At, B0); PG8_MMA(0, 1, At, B1); PG8_BAR; PG8_SCHED;
            PG8_LDA(At, 0, 1); PG8_STAGE(PG8_SB(0, 0), b2, voffB); PG8_STAGE(PG8_SB(0, 1), b2 + hstep, voffB); PG8_STAGE(PG8_SA(0, 0), a2, v2[0]);
            PG8_WAIT_V(8); PG8_WAIT_L(0); PG8_BAR; PG8_MMA(1, 0, At, B0); PG8_MMA(1, 1, At, B1); PG8_BAR; PG8_SCHED;
            PG8_LDB(B0, 1, 0); PG8_LDB(B1, 1, 1); PG8_SCHED; PG8_LDA(At, 1, 0); PG8_STAGE(PG8_SA(0, 1), a2, v2[1]);
            PG8_WAIT_V(8); PG8_WAIT_L(0); PG8_BAR; PG8_MMA(0, 0, At, B0); PG8_MMA(0, 1, At, B1); PG8_BAR; PG8_SCHED;
            PG8_LDA(At, 1, 1); PG8_STAGE(PG8_SB(1, 0), b3, voffB); PG8_STAGE(PG8_SB(1, 1), b3 + hstep, voffB); PG8_STAGE(PG8_SA(1, 0), a3, v2[0]);
            PG8_WAIT_V(8); PG8_WAIT_L(0); PG8_BAR; PG8_MMA(1, 0, At, B0); PG8_MMA(1, 1, At, B1); PG8_BAR; PG8_SCHED;
        }
        if constexpr (Epi::TIMED == 1) TS_SUB(51);
        if constexpr (Epi::TIMED == 2) { if (ui == 2) TS_SUB(61); }
        if constexpr (ALIGN_EPI) { if (wr == 0) PG8_BAR; }
        if constexpr (F8) asm volatile("s_nop 15\n\ts_nop 15" ::: "memory");
        E(acc, cur, ui, wr, wc, fr, fq);
        if constexpr (Epi::TIMED == 1 && TSPROBE >= 100) { asm volatile("s_waitcnt vmcnt(0)" ::: "memory"); TS_SUB(52); }
        if constexpr (Epi::TIMED == 2) { if (ui == 2) TS_SUB(62); }
        if (!has_next) break;
#pragma unroll
        for (int a = 0; a < 2; ++a)
#pragma unroll
            for (int b = 0; b < 2; ++b)
#pragma unroll
                for (int m = 0; m < 4; ++m)
#pragma unroll
                    for (int n = 0; n < 2; ++n) acc[a][b][m][n] = (f32x4){0.f, 0.f, 0.f, 0.f};
        cur = nxt; cB = nB; ++ui;
#pragma unroll
        for (int h = 0; h < 2; ++h)
#pragma unroll
            for (int i = 0; i < 2; ++i) voffA[h][i] = v2[h][i];
        if constexpr (ALIGN_EPI) { if (wr == 1) PG8_BAR; }
    }
    PG8_WAIT_V(0);
    if constexpr (!ALIGN_EPI) { if (wr == 0) PG8_BAR; }
    PG8_BAR;
#undef PG8_SA
#undef PG8_SB
#undef PG8_STAGE
#undef PG8_LDA
#undef PG8_LDB
#undef PG8_MMA
#undef PG8_CAT
#undef PG8_WAIT_V
#undef PG8_WAIT_L
#undef PG8_BAR
#undef PG8_SCHED
#undef PG8_AOFF
#undef PG8_PIECE
}

struct EpiProj {
    static constexpr bool PERM = true; static constexpr int TIMED = 0;
    bf16_t* O;
    __device__ __forceinline__ void operator()(const f32x4 (&acc)[2][2][4][2], const Unit& u, int, int wr, int wc, int fr, int fq) const {
        const int row0 = u.r0 + wr * 64 + fr, col0 = u.pn * BM + wc * 32 + 8 * fq;
#pragma unroll
        for (int ai = 0; ai < 2; ++ai)
#pragma unroll
            for (int m = 0; m < 4; ++m) { bf16_t* rowp = O + (size_t)(row0 + ai * HALF + m * 16) * INC + col0;
#pragma unroll
                for (int bj = 0; bj < 2; ++bj) { const f32x4 v0 = acc[ai][bj][m][0], v1 = acc[ai][bj][m][1];
                    u32x4 w; w.x = cvt_pk_bf16(v0[0], v0[1]); w.y = cvt_pk_bf16(v0[2], v0[3]); w.z = cvt_pk_bf16(v1[0], v1[1]); w.w = cvt_pk_bf16(v1[2], v1[3]);
                    *(u32x4*)(rowp + bj * HALF) = w; } }
    }
};
struct EpiX1 {
    static constexpr bool PERM = true; static constexpr int TIMED = 1;
    const float* x; const float* mod; bf16_t* X1;
    __device__ __forceinline__ unsigned prefetch(const Unit&, int) const { return 0u; }
    __device__ __forceinline__ void operator()(const f32x4 (&acc)[2][2][4][2], const Unit& u, int, int wr, int wc, int fr, int fq) const {
        const int row0 = u.r0 + wr * 64 + fr, col0 = u.pn * BM + wc * 32 + 8 * fq, b = u.r0 / SEQ;
        f32x4 gv[2][2];
#pragma unroll
        for (int bj = 0; bj < 2; ++bj)
#pragma unroll
            for (int n = 0; n < 2; ++n) gv[bj][n] = *(const f32x4*)(mod + b * NMOD + 2 * D_ + col0 + bj * HALF + 4 * n);
#pragma unroll
        for (int ai = 0; ai < 2; ++ai) {
            f32x4 xv[4][2][2];
#pragma unroll
            for (int m = 0; m < 4; ++m)
#pragma unroll
                for (int bj = 0; bj < 2; ++bj)
#pragma unroll
                    for (int n = 0; n < 2; ++n) xv[m][bj][n] = __builtin_nontemporal_load((const f32x4*)(x + (size_t)(row0 + ai * HALF + m * 16) * D_ + col0 + bj * HALF + 4 * n));
            __builtin_amdgcn_sched_barrier(0);
#pragma unroll
            for (int m = 0; m < 4; ++m)
#pragma unroll
                for (int bj = 0; bj < 2; ++bj) { const f32x4 o0 = xv[m][bj][0] + gv[bj][0] * acc[ai][bj][m][0], o1 = xv[m][bj][1] + gv[bj][1] * acc[ai][bj][m][1];
                    u32x4 w; w.x = cvt_pk_bf16(o0[0], o0[1]); w.y = cvt_pk_bf16(o0[2], o0[3]); w.z = cvt_pk_bf16(o1[0], o1[1]); w.w = cvt_pk_bf16(o1[2], o1[3]);
                    *(u32x4*)(X1 + (size_t)(row0 + ai * HALF + m * 16) * D_ + col0 + bj * HALF) = w; }
            __builtin_amdgcn_sched_barrier(0);
        }
    }
};
}

struct GroupedOrder : pg8::TileOrder {
    LAS const int* tiles; LAS const int* rowtab; LAS const int* pstart; int mode;
    __device__ __forceinline__ bool next(int i, pg8::Unit& u) const { int pm, pn; if (!tile(i, pm, pn)) return false; const int t = tiles[pm]; u.pm = pm; u.pn = pn; u.e = t & 255; u.r0 = (t >> 8) * 256; return true; }
    __device__ __forceinline__ int arow(int i, const pg8::Unit& u, int lr) const { return mode == 0 ? rowtab[i * 256 + lr] : pstart[u.e] + u.r0 + lr; }
};
__device__ __forceinline__ void grouped_prepare(GroupedOrder& S, LAS unsigned char* lds, const unsigned char* ws, int nN, int G, int c, int mode, const float* bias) {
    const int tid = threadIdx.x;
    LAS int* cnt = (LAS int*)(lds + L_CNT); LAS int* pstart = (LAS int*)(lds + L_PSTART); LAS int* tiles = (LAS int*)(lds + L_TILES); LAS int* rowtab = (LAS int*)(lds + L_ROWTAB); LAS int* pNT = (LAS int*)(lds + L_NT);
    const int* gcnt = (const int*)(ws + WS_CTL) + CW_CNT;
    if (tid < NE) cnt[tid] = __hip_atomic_load(gcnt + tid, __ATOMIC_RELAXED, __HIP_MEMORY_SCOPE_AGENT);
    __syncthreads();
    if (tid < 64) {
        const int k = (tid < NE) ? ((cnt[tid] + 255) >> 8) : 0; int inc = k;
#pragma unroll
        for (int o = 1; o < 32; o <<= 1) { const int v = __shfl_up(inc, o); if ((tid & 63) >= o) inc += v; }
        const int first = inc - k;
        if (tid < NE) { pstart[tid] = first * 256; for (int j = 0; j < k; ++j) tiles[first + j] = tid | (j << 8); }
        if (tid == NE - 1) { pstart[NE] = inc * 256; *pNT = inc; }
    }
    __syncthreads();
    S.init(*pNT, nN, G, c, GWGM); S.tiles = tiles; S.rowtab = rowtab; S.pstart = pstart; S.mode = mode;
    const int* tokslot = (const int*)(ws + WS_TOKSLOT);
    int rv[MAX_UNITS];
    LAS float* btab = (LAS float*)(lds + L_BIAS);
#pragma unroll
    for (int i = 0; i < MAX_UNITS; ++i) {
        pg8::Unit u; const bool ok = S.next(i, u); rv[i] = (mode == 0) ? 0 : -1;
        if (ok && tid < 256) { const int rank = u.r0 + tid; if (rank < cnt[u.e]) rv[i] = tokslot[u.e * CAP + rank]; }
        if (ok && tid >= 256) rv[i] = __float_as_int(bias[(size_t)u.e * (nN * 256) + u.pn * 256 + (tid - 256)]);
    }
    __builtin_amdgcn_sched_barrier(0);
#pragma unroll
    for (int i = 0; i < MAX_UNITS; ++i) {
        pg8::Unit u; const bool ok = S.next(i, u);
        if (ok && tid < 256) { const int rank = u.r0 + tid; rowtab[i * 256 + tid] = (rank < cnt[u.e]) ? (mode == 0 ? (rv[i] >> 2) : rv[i]) : (mode == 0 ? 0 : -1); }
        if (ok && tid >= 256) btab[i * 256 + (tid - 256)] = __int_as_float(rv[i]);
    }
    __syncthreads();
}
struct EpiGateUp {
    static constexpr bool PERM = true; static constexpr int TIMED = 2;
    bf16_t* ACT; LAS const float* btab; LAS const int* pstart;
    __device__ __forceinline__ void operator()(const f32x4 (&acc)[2][2][4][2], const pg8::Unit& u, int ui, int wr, int wc, int fr, int fq) const {
        typedef float f32x2 __attribute__((ext_vector_type(2)));
        const int a0 = u.pn * 128 + wc * 32 + 8 * fq;
        const int prow0 = pstart[u.e] + u.r0 + wr * 64 + fr;
        f32x2 bg[4], bl[4];
#pragma unroll
        for (int q = 0; q < 4; ++q) { const f32x4 b = *(const LAS f32x4*)(btab + ui * 256 + 2 * (a0 - u.pn * 128) + 4 * q); bg[q] = (f32x2){b[0], b[2]}; bl[q] = (f32x2){b[1], b[3]}; }
        constexpr float OS = DN_F8 ? ASCALE : 1.f;
#pragma unroll
        for (int ai = 0; ai < 2; ++ai)
#pragma unroll
            for (int m = 0; m < 4; ++m) {
                f32x2 o[4];
#pragma unroll
                for (int n = 0; n < 2; ++n)
#pragma unroll
                    for (int jp = 0; jp < 2; ++jp) {
                        const int q = n * 2 + jp;
                        f32x2 gate = (f32x2){acc[ai][0][m][n][2 * jp], acc[ai][0][m][n][2 * jp + 1]} + bg[q];
                        f32x2 lin = (f32x2){acc[ai][1][m][n][2 * jp], acc[ai][1][m][n][2 * jp + 1]} + bl[q];
                        gate.x = fminf(gate.x, 7.f); gate.y = fminf(gate.y, 7.f);
                        lin.x = __builtin_amdgcn_fmed3f(lin.x, -7.f, 7.f); lin.y = __builtin_amdgcn_fmed3f(lin.y, -7.f, 7.f);
                        const f32x2 t = gate * (-1.702f * 1.4426950408889634f);
                        f32x2 d; d.x = __builtin_amdgcn_exp2f(t.x); d.y = __builtin_amdgcn_exp2f(t.y);
                        d = d + 1.0f;
                        f32x2 r; r.x = __builtin_amdgcn_rcpf(d.x); r.y = __builtin_amdgcn_rcpf(d.y);
                        o[q] = (lin * OS + OS) * (gate * r);
                    }
                if constexpr (DN_F8) {
                    int w0 = __builtin_amdgcn_cvt_pk_fp8_f32(o[0].x, o[0].y, 0, false); w0 = __builtin_amdgcn_cvt_pk_fp8_f32(o[1].x, o[1].y, w0, true);
                    int w1 = __builtin_amdgcn_cvt_pk_fp8_f32(o[2].x, o[2].y, 0, false); w1 = __builtin_amdgcn_cvt_pk_fp8_f32(o[3].x, o[3].y, w1, true);
                    u32x2 w; w.x = (unsigned)w0; w.y = (unsigned)w1;
                    *(u32x2*)((unsigned char*)ACT + (size_t)(prow0 + ai * 128 + m * 16) * FF + a0) = w;
                } else {
                    u32x4 w; w.x = pg8::cvt_pk_bf16(o[0].x, o[0].y); w.y = pg8::cvt_pk_bf16(o[1].x, o[1].y); w.z = pg8::cvt_pk_bf16(o[2].x, o[2].y); w.w = pg8::cvt_pk_bf16(o[3].x, o[3].y);
                    *(u32x4*)(ACT + (size_t)(prow0 + ai * 128 + m * 16) * FF + a0) = w;
                }
            }
    }
};
struct EpiNone { static constexpr bool PERM = true; static constexpr int TIMED = 0; __device__ __forceinline__ void operator()(const f32x4 (&acc)[2][2][4][2], const pg8::Unit&, int, int, int, int, int) const { asm volatile("" :: "v"(acc[0][0][0][0]), "v"(acc[1][1][3][1])); } };
struct EpiDown {
    static constexpr bool PERM = true; static constexpr int TIMED = 0;
    bf16_t* Y; LAS const float* btab; LAS const int* rowtab;
    __device__ __forceinline__ void operator()(const f32x4 (&acc)[2][2][4][2], const pg8::Unit& u, int ui, int wr, int wc, int fr, int fq) const {
        const int col0 = u.pn * 256 + wc * 32 + 8 * fq;
        f32x4 bv[2][2];
#pragma unroll
        for (int bj = 0; bj < 2; ++bj)
#pragma unroll
            for (int n = 0; n < 2; ++n) bv[bj][n] = *(const LAS f32x4*)(btab + ui * 256 + (col0 - u.pn * 256) + bj * 128 + 4 * n);
#pragma unroll
        for (int ai = 0; ai < 2; ++ai)
#pragma unroll
            for (int m = 0; m < 4; ++m) {
                const int slot = rowtab[ui * 256 + ai * 128 + wr * 64 + m * 16 + fr];
                if (slot >= 0) {
#pragma unroll
                    for (int bj = 0; bj < 2; ++bj) { const f32x4 v0 = acc[ai][bj][m][0] + bv[bj][0], v1 = acc[ai][bj][m][1] + bv[bj][1];
                        if constexpr (Y_F8) {
                            int w0 = __builtin_amdgcn_cvt_pk_fp8_f32(v0[0] * YSCALE, v0[1] * YSCALE, 0, false); w0 = __builtin_amdgcn_cvt_pk_fp8_f32(v0[2] * YSCALE, v0[3] * YSCALE, w0, true);
                            int w1 = __builtin_amdgcn_cvt_pk_fp8_f32(v1[0] * YSCALE, v1[1] * YSCALE, 0, false); w1 = __builtin_amdgcn_cvt_pk_fp8_f32(v1[2] * YSCALE, v1[3] * YSCALE, w1, true);
                            u32x2 w; w.x = (unsigned)w0; w.y = (unsigned)w1;
                            *(u32x2*)((unsigned char*)Y + (size_t)slot * D_ + col0 + bj * 128) = w;
                        } else {
                            u32x4 w; w.x = pg8::cvt_pk_bf16(v0[0], v0[1]); w.y = pg8::cvt_pk_bf16(v0[2], v0[3]); w.z = pg8::cvt_pk_bf16(v1[0], v1[1]); w.w = pg8::cvt_pk_bf16(v1[2], v1[3]);
                            *(u32x4*)(Y + (size_t)slot * D_ + col0 + bj * 128) = w;
                        } }
                }
            }
    }
};


#define XB_TMO      128
#define XB_XCNT(j)  (256  + 64 * (j))
#define XB_XSUB(j)  (1280 + 64 * (j))
#define XB_XGEN(j)  (2304 + 64 * (j))
#define XB_TOP      3328
#define XB_TOPGEN   3392
#define XCD_BAR_WORDS 3456
#define XB_SPIN_CAP (1u << 18)
__device__ __forceinline__ unsigned xb_ld(unsigned* p)              { return __hip_atomic_load(p, __ATOMIC_RELAXED, __HIP_MEMORY_SCOPE_AGENT); }
__device__ __forceinline__ unsigned xb_add(unsigned* p, unsigned v) { return __hip_atomic_fetch_add(p, v, __ATOMIC_RELAXED, __HIP_MEMORY_SCOPE_AGENT); }
__device__ __forceinline__ unsigned xb_xcc_id() { return (unsigned)__builtin_amdgcn_s_getreg((3 << 11) | 20) & 0xFu; }
#define XB_SPIN(cond, bar) do { unsigned _sp = 0; while (cond) { __builtin_amdgcn_s_sleep(1); \
    if ((++_sp & 255u) == 0u) { if (xb_ld(&(bar)[XB_TMO])) break; if (_sp > XB_SPIN_CAP) { atomicAdd(&(bar)[XB_TMO], 1u); break; } } } } while (0)
struct XcdBarrier { unsigned* bar; unsigned x; volatile LAS unsigned* st; };
__device__ __forceinline__ XcdBarrier xcd_barrier_post(unsigned* bar, volatile LAS unsigned* st) {
    XcdBarrier b; b.bar = bar; b.x = xb_xcc_id(); b.st = st;
    if (threadIdx.x == 0) (void)xb_add(&bar[XB_XCNT(b.x)], 1u);
    return b;
}
__device__ __forceinline__ void xcd_barrier_complete(unsigned* bar, unsigned x, unsigned& nloc, unsigned& nx) {
    const unsigned G = gridDim.x * gridDim.y * gridDim.z;
    unsigned sum, cnt, mine, sp = 0u;
    for (;;) {
        sum = 0u; cnt = 0u; mine = 0u;
#pragma unroll
        for (unsigned j = 0; j < 16; ++j) { const unsigned c = xb_ld(&bar[XB_XCNT(j)]); sum += c; cnt += (c > 0u) ? 1u : 0u; mine = (j == x) ? c : mine; }
        if (sum == G) break;
        __builtin_amdgcn_s_sleep(1);
        if ((++sp & 255u) == 0u) { if (xb_ld(&bar[XB_TMO])) break; if (sp > XB_SPIN_CAP) { atomicAdd(&bar[XB_TMO], 1u); break; } }
    }
    nloc = mine > 0u ? mine : 1u; nx = cnt > 0u ? cnt : 1u;
}
template <int PENDING = 0>
__device__ __forceinline__ void xcd_barrier(const XcdBarrier& b) {
    asm volatile("s_waitcnt vmcnt(%0)" :: "n"(PENDING) : "memory");
    __syncthreads();
    if (threadIdx.x == 0) {
        unsigned* bar = b.bar;
        __builtin_amdgcn_s_waitcnt(0);
        unsigned nloc = b.st[0], nx = b.st[1];
        if (nloc == 0u) { xcd_barrier_complete(bar, b.x, nloc, nx); b.st[0] = nloc; b.st[1] = nx; }
        const unsigned old = xb_add(&bar[XB_XSUB(b.x)], 1u);
        const unsigned gen = old / nloc;
        if (old + 1u == (gen + 1u) * nloc) {
            __builtin_amdgcn_fence(__ATOMIC_RELEASE, "agent");
            asm volatile("s_waitcnt vmcnt(0)" ::: "memory");
            const unsigned og = xb_add(&bar[XB_TOP], 1u);
            const unsigned tg = og / nx;
            if (og + 1u == (tg + 1u) * nx) xb_add(&bar[XB_TOPGEN], 1u);
            else XB_SPIN(xb_ld(&bar[XB_TOPGEN]) == tg, bar);
            __builtin_amdgcn_fence(__ATOMIC_ACQUIRE, "agent");
            asm volatile("s_waitcnt vmcnt(0)" ::: "memory");
            xb_add(&bar[XB_XGEN(b.x)], 1u);
            asm volatile("s_waitcnt vmcnt(0)" ::: "memory");
        } else {
            XB_SPIN(xb_ld(&bar[XB_XGEN(b.x)]) == gen, bar);
            asm volatile("s_waitcnt vmcnt(0) lgkmcnt(0)\n\tbuffer_inv sc0\n\ts_waitcnt vmcnt(0)" ::: "memory");
        }
    }
    __syncthreads();
}

typedef short s16x4 __attribute__((ext_vector_type(4)));
__device__ __forceinline__ s16x4 ds_tr16(const LAS bf16_t* p) { return __builtin_amdgcn_ds_read_tr16_b64_v4i16((LAS s16x4*)p); }
__device__ __forceinline__ bf16x8 cat4(const s16x4 a, const s16x4 b) { return __builtin_shufflevector(a, b, 0, 1, 2, 3, 4, 5, 6, 7); }
constexpr int TS = 136;
__device__ __forceinline__ void unpack8(const u32x4 w, float (&o)[16], int base) {
#pragma unroll
    for (int m = 0; m < 4; ++m) { o[base + 2 * m] = bf2f(w[m] & 0xffffu); o[base + 2 * m + 1] = bf2f(w[m] >> 16); }
}
__device__ __forceinline__ void load_krot(const bf16_t* PROJ, const float* rope, int t, int pos, int h, int q, float (&o1)[16], float (&o2)[16]) {
    const bf16_t* kp = PROJ + (size_t)t * INC + 1024 + h * 128 + 16 * q;
    const u32x4 r0 = *(const u32x4*)kp, r1 = *(const u32x4*)(kp + 8), r2 = *(const u32x4*)(kp + 64), r3 = *(const u32x4*)(kp + 72);
    const float* cp = rope + pos * 64 + 16 * q; const float* sp = cp + SEQ * 64;
    f32x4 c4[4], s4[4];
#pragma unroll
    for (int i4 = 0; i4 < 4; ++i4) { c4[i4] = *(const f32x4*)(cp + 4 * i4); s4[i4] = *(const f32x4*)(sp + 4 * i4); }
    __builtin_amdgcn_sched_barrier(0);
    float k1[16], k2[16];
    unpack8(r0, k1, 0); unpack8(r1, k1, 8); unpack8(r2, k2, 0); unpack8(r3, k2, 8);
    const float sc = 0.08838834764831845f;
#pragma unroll
    for (int i4 = 0; i4 < 4; ++i4) {
#pragma unroll
        for (int r = 0; r < 4; ++r) { const int i = 4 * i4 + r; o1[i] = (k1[i] * c4[i4][r] - k2[i] * s4[i4][r]) * sc; o2[i] = (k2[i] * c4[i4][r] + k1[i] * s4[i4][r]) * sc; }
    }
}
__device__ __forceinline__ void load_v32(const bf16_t* PROJ, int t, int h, int q, unsigned short (&v)[32]) {
    const bf16_t* vp = PROJ + (size_t)t * INC + 1536 + h * 128 + 32 * q;
#pragma unroll
    for (int c = 0; c < 4; ++c) { const u32x4 w = *(const u32x4*)(vp + 8 * c);
#pragma unroll
        for (int m = 0; m < 4; ++m) { v[8 * c + 2 * m] = (unsigned short)(w[m] & 0xffffu); v[8 * c + 2 * m + 1] = (unsigned short)(w[m] >> 16); } }
}

template <int W> struct PoolRaw { unsigned r[15 + W]; };
template <int W>
__device__ __forceinline__ void pool_issue(const bf16_t* PROJ, int u, PoolRaw<W>& R, int tid) {
    const int chunk = u >> 2, g = u & 3, t0 = chunk * 128, pos0 = t0 % SEQ;
    const int cp = tid & 63, seg = tid >> 6, tb = t0 + 16 * seg, pb = pos0 + 16 * seg;
#pragma unroll
    for (int idx = 0; idx < 15 + W; ++idx) {
        const int dp = idx - (W - 1);
        R.r[idx] = *(const unsigned*)(PROJ + (size_t)(tb + ((pb + dp >= 0) ? dp : -pb)) * INC + g * 128 + 2 * cp);
    }
    __builtin_amdgcn_sched_barrier(0);
}
template <int W>
__device__ __forceinline__ void pool_fill(LAS bf16_t* P, int u, const PoolRaw<W>& R, int tid) {
    const int chunk = u >> 2, t0 = chunk * 128, pos0 = t0 % SEQ;
    const int cp = tid & 63, seg = tid >> 6, pb = pos0 + 16 * seg;
    float v0[15 + W], v1[15 + W];
#pragma unroll
    for (int idx = 0; idx < 15 + W; ++idx) {
        const int dp = idx - (W - 1);
        const unsigned x = (pb + dp >= 0) ? R.r[idx] : 0u;
        v0[idx] = bf2f(x & 0xffffu); v1[idx] = bf2f(x >> 16);
    }
#pragma unroll
    for (int k = 0; k < 16; ++k) {
        float s0 = 0.f, s1 = 0.f;
#pragma unroll
        for (int q = 0; q < W; ++q) { s0 += v0[k + q]; s1 += v1[k + q]; }
        const int pos = pb + k; const float inv = 1.f / (float)((pos + 1 < W) ? pos + 1 : W);
        *(LAS unsigned*)(P + (16 * seg + k) * TS + 2 * cp) = pk2(s0 * inv - v0[k + W - 1], s1 * inv - v1[k + W - 1]);
    }
}
__device__ __forceinline__ void pool_mma(const Args& a, LAS unsigned char* lds, int u, const f32x4 (&pbv)[8], const f32x4 (&psv)[8]) {
    const int tid = threadIdx.x, lane = tid & 63, wave = __builtin_amdgcn_readfirstlane(tid >> 6), fr = lane & 15, fq = lane >> 4;
    const int chunk = u >> 2, g = u & 3, t0 = chunk * 128;
    bf16_t* MIXIN = (bf16_t*)(a.ws + WS_MIXIN);
    LAS bf16_t* P = (LAS bf16_t*)lds; LAS const bf16_t* Wp = P + 128 * TS;
    f32x4 acc[8];
#pragma unroll
    for (int nt = 0; nt < 8; ++nt) acc[nt] = (f32x4){0.f, 0.f, 0.f, 0.f};
#pragma unroll
    for (int ks = 0; ks < 4; ++ks) {
        const bf16x8 af = *(const LAS bf16x8*)(P + (16 * wave + fr) * TS + 32 * ks + 8 * fq);
#pragma unroll
        for (int nt = 0; nt < 8; ++nt) { const bf16x8 bf = *(const LAS bf16x8*)(Wp + (16 * nt + fr) * TS + 32 * ks + 8 * fq); acc[nt] = MFMA16(bf, af, acc[nt]); }
    }
    const int t = t0 + 16 * wave + fr;
#pragma unroll
    for (int nt = 0; nt < 8; ++nt) {
        const int ch = g * 128 + 16 * nt + 4 * fq;
        const f32x4 o = (acc[nt] + pbv[nt]) * psv[nt];
        u32x2 w; w.x = pk2(o[0], o[1]); w.y = pk2(o[2], o[3]);
        *(u32x2*)(MIXIN + (size_t)t * D_ + ch) = w;
    }
}
struct KvRaw { u32x4 kr[4], vr[4]; };
__device__ __forceinline__ void kv_issue(const bf16_t* PROJ, int u, KvRaw& R, int tid) {
    const int bh = u / 15, n = u % 15, b = bh >> 2, h = bh & 3, t0 = b * SEQ + n * 128, j = tid >> 2, q = tid & 3;
    const bf16_t* kp = PROJ + (size_t)(t0 + j) * INC + 1024 + h * 128 + 16 * q;
    R.kr[0] = *(const u32x4*)kp; R.kr[1] = *(const u32x4*)(kp + 8); R.kr[2] = *(const u32x4*)(kp + 64); R.kr[3] = *(const u32x4*)(kp + 72);
    const bf16_t* vp = PROJ + (size_t)(t0 + j) * INC + 1536 + h * 128 + 32 * q;
#pragma unroll
    for (int c = 0; c < 4; ++c) R.vr[c] = *(const u32x4*)(vp + 8 * c);
    __builtin_amdgcn_sched_barrier(0);
}
__device__ __forceinline__ void krot(const u32x4 (&kr)[4], const float* rope, int pos, int q, float mul, float (&o1)[16], float (&o2)[16]) {
    const float* cp = rope + pos * 64 + 16 * q; const float* sp = cp + SEQ * 64;
    f32x4 c4[4], s4[4];
#pragma unroll
    for (int i4 = 0; i4 < 4; ++i4) { c4[i4] = *(const f32x4*)(cp + 4 * i4); s4[i4] = *(const f32x4*)(sp + 4 * i4); }
    float k1[16], k2[16];
    unpack8(kr[0], k1, 0); unpack8(kr[1], k1, 8); unpack8(kr[2], k2, 0); unpack8(kr[3], k2, 8);
#pragma unroll
    for (int i4 = 0; i4 < 4; ++i4)
#pragma unroll
        for (int r = 0; r < 4; ++r) { const int i = 4 * i4 + r; o1[i] = (k1[i] * c4[i4][r] - k2[i] * s4[i4][r]) * mul; o2[i] = (k2[i] * c4[i4][r] + k1[i] * s4[i4][r]) * mul; }
}
__device__ __forceinline__ void store_k32(LAS bf16_t* row, int q, const float (&o1)[16], const float (&o2)[16]) {
    u32x4 w;
    w.x = pk2(o1[0], o1[1]); w.y = pk2(o1[2], o1[3]); w.z = pk2(o1[4], o1[5]); w.w = pk2(o1[6], o1[7]); *(LAS u32x4*)(row + 16 * q) = w;
    w.x = pk2(o1[8], o1[9]); w.y = pk2(o1[10], o1[11]); w.z = pk2(o1[12], o1[13]); w.w = pk2(o1[14], o1[15]); *(LAS u32x4*)(row + 16 * q + 8) = w;
    w.x = pk2(o2[0], o2[1]); w.y = pk2(o2[2], o2[3]); w.z = pk2(o2[4], o2[5]); w.w = pk2(o2[6], o2[7]); *(LAS u32x4*)(row + 64 + 16 * q) = w;
    w.x = pk2(o2[8], o2[9]); w.y = pk2(o2[10], o2[11]); w.z = pk2(o2[12], o2[13]); w.w = pk2(o2[14], o2[15]); *(LAS u32x4*)(row + 64 + 16 * q + 8) = w;
}
__device__ __forceinline__ void kv_stage(const Args& a, LAS unsigned char* lds, int u, const KvRaw& R) {
    const int tid = threadIdx.x, n = u % 15, bh = u / 15, h = bh & 3, pos0 = n * 128, j = tid >> 2, q = tid & 3;
    LAS bf16_t* Kn = (LAS bf16_t*)lds; LAS bf16_t* Vn = Kn + 128 * TS;
    float o1[16], o2[16];
    krot(R.kr, (const float*)(a.ws + WS_ROPE), pos0 + j, q, 0.08838834764831845f * fexp2((float)(127 - j) * log2_gamma(h)), o1, o2);
    store_k32(Kn + j * TS, q, o1, o2);
#pragma unroll
    for (int c = 0; c < 4; ++c) *(LAS u32x4*)(Vn + j * TS + 32 * q + 8 * c) = R.vr[c];
}
__device__ __forceinline__ void kv_mma(const Args& a, LAS unsigned char* lds, int u) {
    const int tid = threadIdx.x, lane = tid & 63, wave = __builtin_amdgcn_readfirstlane(tid >> 6), fr = lane & 15, fq = lane >> 4;
    const int bh = u / 15, n = u % 15;
    float* KVT = (float*)(a.ws + WS_KVT);
    LAS bf16_t* Kn = (LAS bf16_t*)lds; LAS bf16_t* Vn = Kn + 128 * TS;
    f32x4 acc[8];
#pragma unroll
    for (int dt = 0; dt < 8; ++dt) acc[dt] = (f32x4){0.f, 0.f, 0.f, 0.f};
#pragma unroll
    for (int ks = 0; ks < 4; ++ks) {
        const int jr = 32 * ks + 4 * fq + (fr >> 2), cc = 4 * (fr & 3);
        const LAS bf16_t* vq = Vn + jr * TS + 16 * wave + cc;
        const bf16x8 vf = cat4(ds_tr16(vq), ds_tr16(vq + 16 * TS));
#pragma unroll
        for (int dt = 0; dt < 8; ++dt) { const LAS bf16_t* kq = Kn + jr * TS + 16 * dt + cc; acc[dt] = MFMA16(cat4(ds_tr16(kq), ds_tr16(kq + 16 * TS)), vf, acc[dt]); }
    }
    float* op = KVT + ((size_t)(bh * 15 + n) << 14) + (size_t)(16 * wave + fr) * 128 + 4 * fq;
#pragma unroll
    for (int dt = 0; dt < 8; ++dt) *(f32x4*)(op + 16 * dt) = acc[dt];
}
template <int W>
__device__ __forceinline__ void phase3_body(const Args& a, LAS unsigned char* lds, int vb) {
    const int tid = threadIdx.x;
    const bf16_t* PROJ = (const bf16_t*)(a.ws + WS_PROJ);
    LAS bf16_t* P = (LAS bf16_t*)lds;
    const int Pa = vb, Pb = vb + 256, Ka = vb, Kb = vb + 256; const bool hasKb = Kb < 480;
    PoolRaw<W> RA; KvRaw RB;
    pool_issue<W>(PROJ, Pa, RA, tid);
    {
        const int g = vb & 3, d = tid >> 2, c0 = (tid & 3) * 32;
        const bf16_t* wp = (const bf16_t*)(a.ws + WS_POOLWT) + (size_t)(g * 128 + d) * 128 + c0;
        u32x4 wv[4];
#pragma unroll
        for (int c = 0; c < 4; ++c) wv[c] = *(const u32x4*)(wp + 8 * c);
#pragma unroll
        for (int c = 0; c < 4; ++c) *(LAS u32x4*)(P + (128 + d) * TS + c0 + 8 * c) = wv[c];
    }
    f32x4 pbv[8], psv[8];
    { const int g = vb & 3, fq = (tid & 63) >> 4;
#pragma unroll
      for (int nt = 0; nt < 8; ++nt) { pbv[nt] = *(const f32x4*)(a.in[7] + g * 128 + 16 * nt + 4 * fq); psv[nt] = *(const f32x4*)(a.in[8] + g * 128 + 16 * nt + 4 * fq); } }
    pool_fill<W>(P, Pa, RA, tid); pool_issue<W>(PROJ, Pb, RA, tid);
    __syncthreads(); pool_mma(a, lds, Pa, pbv, psv); __syncthreads();
    pool_fill<W>(P, Pb, RA, tid); kv_issue(PROJ, Ka, RB, tid);
    __syncthreads(); pool_mma(a, lds, Pb, pbv, psv); __syncthreads();
    kv_stage(a, lds, Ka, RB); if (hasKb) kv_issue(PROJ, Kb, RB, tid);
    __syncthreads(); kv_mma(a, lds, Ka); __syncthreads();
    if (hasKb) { kv_stage(a, lds, Kb, RB); __syncthreads(); kv_mma(a, lds, Kb); __syncthreads(); }
}
__device__ __forceinline__ void bf16_split3(float w0, float w1, unsigned& h, unsigned& m, unsigned& l) {
    h = pk2(w0, w1); const float r0 = w0 - __uint_as_float(h << 16), r1 = w1 - __uint_as_float(h & 0xffff0000u);
    m = pk2(r0, r1); l = pk2(r0 - __uint_as_float(m << 16), r1 - __uint_as_float(m & 0xffff0000u));
}
__device__ __forceinline__ void phase_scan(const Args& a, int vb, int G) {
    const float* KVT = (const float*)(a.ws + WS_KVT); bf16_t* RT = (bf16_t*)(a.ws + WS_RT);
    const float* mod = (const float*)(a.ws + WS_MOD);
    const int gt = vb * 512 + threadIdx.x, pi2 = gt & 3, plane = (gt >> 2) & 63, pf = gt >> 8, pb = pf >> 6;
    const int pk = 128 * ((pf >> 3) & 7) + 32 * ((pf >> 1) & 3) + 8 * (plane >> 4) + 2 * pi2, pe = 16 * (pf & 1) + (plane & 15);
    const bool prep = (G == 256);
    float pw0 = 0.f, pw1 = 0.f; f32x2_t pg = {0.f, 0.f}, pc = {0.f, 0.f};
    if (prep) { pw0 = a.in[12][pk * NE + pe]; pw1 = a.in[12][(pk + 1) * NE + pe]; pg = *(const f32x2_t*)(a.in[11] + pk); pc = *(const f32x2_t*)(mod + pb * NMOD + 4 * D_ + pk); }
    const bool pbias = prep && threadIdx.x < 64;
    float bm[16], bwv[16], brv = 0.f;
#pragma unroll
    for (int j = 0; j < 16; ++j) { bm[j] = 0.f; bwv[j] = 0.f; }
    if (pbias) {
        brv = a.in[13][vb & 31];
#pragma unroll
        for (int j = 0; j < 16; ++j) { const int k = threadIdx.x + 64 * j; bm[j] = mod[(vb >> 5) * NMOD + 3 * D_ + k]; bwv[j] = a.in[12][k * NE + (vb & 31)]; }
    }
    __builtin_amdgcn_sched_barrier(0);
    for (int i = vb * 512 + threadIdx.x; i < 32 * 4096; i += G * 512) {
        const int bh = i >> 12, ed = (i & 4095) * 4, h = bh & 3;
        const float cd = fexp2(128.f * log2_gamma(h)); f32x4 R = (f32x4){0.f, 0.f, 0.f, 0.f};
        f32x4 kv[15];
#pragma unroll
        for (int n = 0; n < 15; ++n) kv[n] = *(const f32x4*)(KVT + ((size_t)(bh * 15 + n) << 14) + ed);
#pragma unroll
        for (int n = 0; n < 16; ++n) {
            u32x2 w; w.x = pk2(R[0], R[1]); w.y = pk2(R[2], R[3]);
            *(u32x2*)(RT + ((size_t)(bh * 16 + n) << 14) + ed) = w;
            if (n < 15) R = R * cd + kv[n];
        }
    }
    if (prep) {
        const f32x2_t gs = pg * (1.f + pc);
        unsigned h, m, l; bf16_split3(gs[0] * pw0, gs[1] * pw1, h, m, l);
        unsigned* dst = (unsigned*)(a.ws + WS_RW3) + ((size_t)(pf * 3) * 64 + plane) * 4 + pi2;
        dst[0] = h; dst[256] = m; dst[512] = l;
        if (pbias) {
            float sacc = 0.f;
#pragma unroll
            for (int j = 0; j < 16; ++j) sacc += bm[j] * bwv[j];
            sacc = wave_sum(sacc);
            if (threadIdx.x == 0) ((float*)(a.ws + WS_RBIAS))[vb] = sacc + brv;
        }
    }
}
__device__ __forceinline__ bf16x8 pack8(const float (&v)[8]) {
    u32x4 w; w.x = pk2(v[0], v[1]); w.y = pk2(v[2], v[3]); w.z = pk2(v[4], v[5]); w.w = pk2(v[6], v[7]);
    return __builtin_bit_cast(bf16x8, w);
}
struct RetRaw { u32x4 kr[4], vr[4], rr[4], qr[4]; u32x2 gw[8]; };
__device__ __forceinline__ void ret_issue_proj(const Args& a, int u, RetRaw& R) {
    const int tid = threadIdx.x, lane = tid & 63, wave = __builtin_amdgcn_readfirstlane(tid >> 6), fr = lane & 15, fq = lane >> 4;
    const int bh = u >> 4, n = u & 15, b = bh >> 2, h = bh & 3, t0 = b * SEQ + n * 128, j = tid >> 2, q = tid & 3, t = t0 + 16 * wave + fr;
    const bf16_t* PROJ = (const bf16_t*)(a.ws + WS_PROJ);
    const bf16_t* kp = PROJ + (size_t)(t0 + j) * INC + 1024 + h * 128 + 16 * q;
    R.kr[0] = *(const u32x4*)kp; R.kr[1] = *(const u32x4*)(kp + 8); R.kr[2] = *(const u32x4*)(kp + 64); R.kr[3] = *(const u32x4*)(kp + 72);
    const bf16_t* vp = PROJ + (size_t)(t0 + j) * INC + 1536 + h * 128 + 32 * q;
#pragma unroll
    for (int c = 0; c < 4; ++c) R.vr[c] = *(const u32x4*)(vp + 8 * c);
    const bf16_t* qp = PROJ + (size_t)t * INC + 512 + h * 128 + 8 * fq;
#pragma unroll
    for (int c = 0; c < 4; ++c) R.qr[c] = *(const u32x4*)(qp + 32 * c);
#pragma unroll
    for (int et = 0; et < 8; ++et) R.gw[et] = *(const u32x2*)(PROJ + (size_t)t * INC + 2048 + h * 128 + 16 * et + 4 * fq);
    __builtin_amdgcn_sched_barrier(0);
}
__device__ __forceinline__ void ret_issue_rt(const Args& a, int u, RetRaw& R) {
    const int tid = threadIdx.x, bh = u >> 4, n = u & 15, j = tid >> 2, q = tid & 3;
    if (n > 0) { const bf16_t* rp = (const bf16_t*)(a.ws + WS_RT) + ((size_t)(bh * 16 + n) << 14) + j * 128 + 32 * q;
#pragma unroll
        for (int c = 0; c < 4; ++c) R.rr[c] = *(const u32x4*)(rp + 8 * c); }
    __builtin_amdgcn_sched_barrier(0);
}
__device__ __forceinline__ void ret_stage(const Args& a, LAS unsigned char* lds, int u, const RetRaw& R, bf16x8 (&qf)[4]) {
    const int tid = threadIdx.x, lane = tid & 63, wave = __builtin_amdgcn_readfirstlane(tid >> 6), fr = lane & 15, fq = lane >> 4;
    const int n = u & 15, pos0 = n * 128, j = tid >> 2, q = tid & 3, pos = pos0 + 16 * wave + fr;
    const float* rope = (const float*)(a.ws + WS_ROPE);
    LAS bf16_t* Kn = (LAS bf16_t*)lds; LAS bf16_t* Vn = Kn + 128 * TS; LAS bf16_t* Rt = Vn + 128 * TS;
    f32x4 qc[2][2], qs[2][2];
#pragma unroll
    for (int ks = 0; ks < 2; ++ks) { const float* cp = rope + pos * 64 + 32 * ks + 8 * fq; const float* sp = cp + SEQ * 64;
#pragma unroll
        for (int i4 = 0; i4 < 2; ++i4) { qc[ks][i4] = *(const f32x4*)(cp + 4 * i4); qs[ks][i4] = *(const f32x4*)(sp + 4 * i4); } }
    float o1[16], o2[16];
    krot(R.kr, rope, pos0 + j, q, 0.08838834764831845f, o1, o2);
    store_k32(Kn + j * TS, q, o1, o2);
#pragma unroll
    for (int c = 0; c < 4; ++c) *(LAS u32x4*)(Vn + j * TS + 32 * q + 8 * c) = R.vr[c];
    if (n > 0) {
#pragma unroll
        for (int c = 0; c < 4; ++c) *(LAS u32x4*)(Rt + j * TS + 32 * q + 8 * c) = R.rr[c];
    }
    float qa[16], qb[16];
    unpack8(R.qr[0], qa, 0); unpack8(R.qr[1], qa, 8); unpack8(R.qr[2], qb, 0); unpack8(R.qr[3], qb, 8);
#pragma unroll
    for (int ks = 0; ks < 2; ++ks) {
        float y1[8], y2[8];
#pragma unroll
        for (int i4 = 0; i4 < 2; ++i4)
#pragma unroll
            for (int r = 0; r < 4; ++r) { const int i = 4 * i4 + r; const float x1 = qa[8 * ks + i], x2 = qb[8 * ks + i]; y1[i] = x1 * qc[ks][i4][r] - x2 * qs[ks][i4][r]; y2[i] = x2 * qc[ks][i4][r] + x1 * qs[ks][i4][r]; }
        qf[ks] = pack8(y1); qf[ks + 2] = pack8(y2);
    }
}
__device__ __forceinline__ void ret_mma(const Args& a, LAS unsigned char* lds, int u, const bf16x8 (&qf)[4], const u32x2 (&gw)[8], const f32x4 (&gnv)[8]) {
    const int tid = threadIdx.x, lane = tid & 63, wave = __builtin_amdgcn_readfirstlane(tid >> 6), fr = lane & 15, fq = lane >> 4;
    const int bh = u >> 4, n = u & 15, b = bh >> 2, h = bh & 3, t0 = b * SEQ + n * 128, il = 16 * wave + fr, t = t0 + il;
    bf16_t* MIXIN = (bf16_t*)(a.ws + WS_MIXIN);
    LAS bf16_t* Kn = (LAS bf16_t*)lds; LAS bf16_t* Vn = Kn + 128 * TS; LAS bf16_t* Rt = Vn + 128 * TS;
    const float l2g = log2_gamma(h);
    f32x4 acc[8];
#pragma unroll
    for (int et = 0; et < 8; ++et) acc[et] = (f32x4){0.f, 0.f, 0.f, 0.f};
    if (n > 0) {
#pragma unroll
        for (int ks = 0; ks < 4; ++ks)
#pragma unroll
            for (int et = 0; et < 8; ++et) acc[et] = MFMA16(*(const LAS bf16x8*)(Rt + (16 * et + fr) * TS + 32 * ks + 8 * fq), qf[ks], acc[et]);
        const float qd = fexp2((float)(il + 1) * l2g);
#pragma unroll
        for (int et = 0; et < 8; ++et) acc[et] *= qd;
    }
#pragma unroll
    for (int ks2 = 0; ks2 < 4; ++ks2) {
        if (2 * ks2 <= wave) {
            float sv[8];
#pragma unroll
            for (int tt = 0; tt < 2; ++tt) {
                const int jt = 2 * ks2 + tt;
                f32x4 sacc = (f32x4){0.f, 0.f, 0.f, 0.f};
                if (jt <= wave) {
#pragma unroll
                    for (int ks = 0; ks < 4; ++ks) sacc = MFMA16(*(const LAS bf16x8*)(Kn + (16 * jt + fr) * TS + 32 * ks + 8 * fq), qf[ks], sacc);
                }
#pragma unroll
                for (int r = 0; r < 4; ++r) { const int diff = il - (16 * jt + 4 * fq + r); sv[4 * tt + r] = (diff >= 0) ? sacc[r] * fexp2((float)diff * l2g) : 0.f; }
            }
            const bf16x8 sf = pack8(sv);
#pragma unroll
            for (int et = 0; et < 8; ++et) {
                const LAS bf16_t* vq = Vn + (32 * ks2 + 4 * fq + (fr >> 2)) * TS + 16 * et + 4 * (fr & 3);
                acc[et] = MFMA16(cat4(ds_tr16(vq), ds_tr16(vq + 16 * TS)), sf, acc[et]);
            }
        }
    }
    float sm = 0.f;
#pragma unroll
    for (int et = 0; et < 8; ++et) sm += (acc[et][0] + acc[et][1]) + (acc[et][2] + acc[et][3]);
    sm += __shfl_xor(sm, 16); sm += __shfl_xor(sm, 32);
    const float mu = sm * (1.f / 128.f);
    float sq = 0.f;
#pragma unroll
    for (int et = 0; et < 8; ++et) { const f32x4 d = acc[et] - mu; sq += (d[0] * d[0] + d[1] * d[1]) + (d[2] * d[2] + d[3] * d[3]); }
    sq += __shfl_xor(sq, 16); sq += __shfl_xor(sq, 32);
    const float rs = frsq(sq * (1.f / 128.f) + EPS);
#pragma unroll
    for (int et = 0; et < 8; ++et) {
        const int c = h * 128 + 16 * et + 4 * fq;
        const f32x4 gn = gnv[et];
        const float g0 = bf2f(gw[et].x & 0xffffu), g1 = bf2f(gw[et].x >> 16), g2 = bf2f(gw[et].y & 0xffffu), g3 = bf2f(gw[et].y >> 16);
        const f32x4 d = (acc[et] - mu) * rs * gn;
        u32x2 w; w.x = pk2(silu_f(g0) * d[0], silu_f(g1) * d[1]); w.y = pk2(silu_f(g2) * d[2], silu_f(g3) * d[3]);
        *(u32x2*)(MIXIN + (size_t)t * D_ + 512 + c) = w;
    }
}
__device__ __forceinline__ void phase5_body(const Args& a, LAS unsigned char* lds, int vb, RetRaw& R, bool pre) {
    bf16x8 qf[4]; u32x2 gc[8]; f32x4 gnv[8];
    const int u0 = vb, u1 = vb + 256;
    const int fq = (threadIdx.x & 63) >> 4;
    if (!pre) ret_issue_proj(a, u0, R);
    ret_issue_rt(a, u0, R);
#pragma unroll
    for (int et = 0; et < 8; ++et) gnv[et] = *(const f32x4*)(a.in[9] + ((u0 >> 4) & 3) * 128 + 16 * et + 4 * fq);
    ret_stage(a, lds, u0, R, qf);
#pragma unroll
    for (int et = 0; et < 8; ++et) gc[et] = R.gw[et];
    ret_issue_proj(a, u1, R); ret_issue_rt(a, u1, R);
    __syncthreads(); ret_mma(a, lds, u0, qf, gc, gnv); __syncthreads();
    ret_stage(a, lds, u1, R, qf);
#pragma unroll
    for (int et = 0; et < 8; ++et) gc[et] = R.gw[et];
    __syncthreads(); ret_mma(a, lds, u1, qf, gc, gnv); __syncthreads();
}

constexpr int R_PART = 0, R_SSP = 32768, R_BP = R_SSP + 1024, R_GS = R_BP + 1024, R_S0 = R_GS + 4096, R_PE = R_S0 + 4096, R_PW = R_PE + 1024, R_PL = R_PW + 1024, R_HIST = R_PL + 1024, R_BASE = R_HIST + 128;
static_assert(R_BASE + 128 <= RING_BYTES, "router LDS map");
__device__ __forceinline__ void phase_router(const Args& a, LAS unsigned char* lds, int vb, int G) {
    static_assert(GU_F8, "router writes HN as fp8");
    const int tid = threadIdx.x, lane = tid & 63, wave = __builtin_amdgcn_readfirstlane(tid >> 6), fr = lane & 15, fq = lane >> 4;
    unsigned char* ws = a.ws;
    const bf16_t* X1 = (const bf16_t*)(ws + WS_X1); const float* mod = (const float*)(ws + WS_MOD); unsigned char* HN = (unsigned char*)(ws + WS_HN);
    LAS float* part = (LAS float*)(lds + R_PART); LAS float* ssp = (LAS float*)(lds + R_SSP); LAS float* gsL = (LAS float*)(lds + R_GS); LAS float* s0L = (LAS float*)(lds + R_S0);
    LAS int* pe = (LAS int*)(lds + R_PE); LAS float* pw = (LAS float*)(lds + R_PW); LAS int* pl = (LAS int*)(lds + R_PL); LAS int* hist = (LAS int*)(lds + R_HIST); LAS int* base = (LAS int*)(lds + R_BASE);
    const int RPB = T_ / G, row0 = vb * RPB, b = row0 / SEQ, kw = 128 * wave + 8 * fq;
    TS_SUB(20);
    u32x4 xa[4][4];
#pragma unroll
    for (int sb = 0; sb < 4; ++sb)
#pragma unroll
        for (int ks = 0; ks < 4; ++ks) xa[sb][ks] = __builtin_nontemporal_load((const u32x4*)(X1 + (size_t)(row0 + sb * 16 + fr) * D_ + kw + 32 * ks));
    u32x4 bfr[4][2][3];
#pragma unroll
    for (int ks = 0; ks < 4; ++ks)
#pragma unroll
        for (int nt = 0; nt < 2; ++nt)
#pragma unroll
            for (int sp = 0; sp < 3; ++sp) bfr[ks][nt][sp] = *((const u32x4*)(ws + WS_RW3) + (size_t)(((((b * 8 + wave) * 4 + ks) * 2 + nt) * 3 + sp) * 64 + lane));
    {
        const float* sh = mod + b * NMOD + 3 * D_; const float* sc = mod + b * NMOD + 4 * D_;
        const f32x2_t g2 = *(const f32x2_t*)(a.in[11] + 2 * tid), c2 = *(const f32x2_t*)(sc + 2 * tid), h2 = *(const f32x2_t*)(sh + 2 * tid);
        *(LAS f32x2_t*)(gsL + 2 * tid) = g2 * (1.f + c2); *(LAS f32x2_t*)(s0L + 2 * tid) = h2;
    }
    if (tid < NE) hist[tid] = 0;
    const float bias_e = ((const float*)(ws + WS_RBIAS))[b * 32 + (tid & 31)];
    if (TSPROBE >= 100) asm volatile("s_waitcnt vmcnt(0)" ::: "memory");
    TS_SUB(21);
    static_assert(T_ / 256 / 16 == 4, "router: four sub-tiles per workgroup");
#pragma unroll
    for (int sub = 0; sub < 4; ++sub) {
        TS_SUB(10);
        if (sub == 1) TS_SUB(30); if (sub == 2) TS_SUB(31); if (sub == 3) TS_SUB(32);
        const int buf = sub & 1;
        float ssq = 0.f;
#pragma unroll
        for (int ks = 0; ks < 4; ++ks)
#pragma unroll
            for (int i = 0; i < 4; ++i) { const unsigned w = xa[sub][ks][i]; const float x0 = __uint_as_float(w << 16), x1v = __uint_as_float(w & 0xffff0000u); ssq += x0 * x0 + x1v * x1v; }
        ssq += __shfl_xor(ssq, 16); ssq += __shfl_xor(ssq, 32);
        if (fq == 0) ssp[buf * 128 + fr * 8 + wave] = ssq;
        f32x4 lacc[2] = {(f32x4){0.f, 0.f, 0.f, 0.f}, (f32x4){0.f, 0.f, 0.f, 0.f}};
#pragma unroll
        for (int ks = 0; ks < 4; ++ks)
#pragma unroll
            for (int sp = 0; sp < 3; ++sp)
#pragma unroll
                for (int nt = 0; nt < 2; ++nt) lacc[nt] = MFMA16(__builtin_bit_cast(bf16x8, xa[sub][ks]), __builtin_bit_cast(bf16x8, bfr[ks][nt][sp]), lacc[nt]);
#pragma unroll
        for (int nt = 0; nt < 2; ++nt)
#pragma unroll
            for (int r = 0; r < 4; ++r) part[buf * 4096 + (wave * 16 + 4 * fq + r) * 32 + 16 * nt + fr] = lacc[nt][r];
        TS_SUB(11);
        __syncthreads();
        TS_SUB(12);
        {
            const f32x4 q0 = *(const LAS f32x4*)(ssp + buf * 128 + fr * 8), q1 = *(const LAS f32x4*)(ssp + buf * 128 + fr * 8 + 4);
            const float rs = frsq((((q0[0] + q0[1]) + (q0[2] + q0[3])) + ((q1[0] + q1[1]) + (q1[2] + q1[3]))) * (1.f / D_) + EPS);
            unsigned char* hp = HN + (size_t)(row0 + sub * 16 + fr) * D_ + kw;
#pragma unroll
            for (int ks = 0; ks < 4; ++ks) {
                const f32x4 ga = *(const LAS f32x4*)(gsL + kw + 32 * ks), gb = *(const LAS f32x4*)(gsL + kw + 32 * ks + 4), sa = *(const LAS f32x4*)(s0L + kw + 32 * ks), sb = *(const LAS f32x4*)(s0L + kw + 32 * ks + 4);
                const u32x4 w = xa[sub][ks];
                const f32x4 xl = {__uint_as_float(w[0] << 16), __uint_as_float(w[0] & 0xffff0000u), __uint_as_float(w[1] << 16), __uint_as_float(w[1] & 0xffff0000u)};
                const f32x4 xh = {__uint_as_float(w[2] << 16), __uint_as_float(w[2] & 0xffff0000u), __uint_as_float(w[3] << 16), __uint_as_float(w[3] & 0xffff0000u)};
                const f32x4 ha = xl * rs * ga + sa, hb = xh * rs * gb + sb;
                u32x2 o;
                int w8 = __builtin_amdgcn_cvt_pk_fp8_f32(ha[0], ha[1], 0, false); w8 = __builtin_amdgcn_cvt_pk_fp8_f32(ha[2], ha[3], w8, true); o.x = (unsigned)w8;
                w8 = __builtin_amdgcn_cvt_pk_fp8_f32(hb[0], hb[1], 0, false); w8 = __builtin_amdgcn_cvt_pk_fp8_f32(hb[2], hb[3], w8, true); o.y = (unsigned)w8;
                *(u32x2*)(hp + 32 * ks) = o;
            }
        }
        {
            const int tk = tid >> 5, e = tid & 31;
            const f32x4 q0 = *(const LAS f32x4*)(ssp + buf * 128 + tk * 8), q1 = *(const LAS f32x4*)(ssp + buf * 128 + tk * 8 + 4);
            const float rst = frsq((((q0[0] + q0[1]) + (q0[2] + q0[3])) + ((q1[0] + q1[1]) + (q1[2] + q1[3]))) * (1.f / D_) + EPS);
            float raw = 0.f;
#pragma unroll
            for (int w = 0; w < 8; ++w) raw += part[buf * 4096 + (w * 16 + tk) * 32 + e];
            float lg = raw * rst + bias_e;
            float tv[4]; int ti[4];
#pragma unroll
            for (int k = 0; k < 4; ++k) {
                float bv = row_max16(lg); bv = fmaxf(bv, __shfl_xor(bv, 16));
                const unsigned long long bal = __ballot(lg == bv);
                const int bi = __builtin_ctz((lane & 32) ? (unsigned)(bal >> 32) : (unsigned)bal);
                tv[k] = bv; ti[k] = bi; if (e == bi) lg = -INFINITY;
            }
            if (e < 4) {
                float se = 0.f, ex[4];
#pragma unroll
                for (int k = 0; k < 4; ++k) { ex[k] = fexp2((tv[k] - tv[0]) * 1.4426950408889634f); se += ex[k]; }
                const float mine = (e == 0) ? ex[0] : (e == 1) ? ex[1] : (e == 2) ? ex[2] : ex[3];
                const int me = (e == 0) ? ti[0] : (e == 1) ? ti[1] : (e == 2) ? ti[2] : ti[3];
                const int pi = (sub * 16 + tk) * 4 + e; pe[pi] = me; pw[pi] = mine * __builtin_amdgcn_rcpf(se);
            }
        }
        TS_SUB(15);
    }
    __syncthreads();
    TS_SUB(22);
    const int npair = RPB * 4;
    if (tid < npair) pl[tid] = atomicAdd((int*)(hist + pe[tid]), 1);
    __syncthreads();
    if (tid < NE) base[tid] = (int)__hip_atomic_fetch_add((int*)(ws + WS_CTL) + CW_CNT + tid, hist[tid], __ATOMIC_RELAXED, __HIP_MEMORY_SCOPE_AGENT);
    __syncthreads();
    if (tid < npair) {
        const int e = pe[tid], slot = row0 * 4 + tid;
        ((int*)(ws + WS_TOKSLOT))[e * CAP + base[e] + pl[tid]] = slot;
        ((float*)(ws + WS_WSLOT))[slot] = pw[tid];
    }
    __syncthreads();
    TS_SUB(23);
}
__device__ __forceinline__ void phase_final(const Args& a, int vb, int G) {
    const int tid = threadIdx.x, lane = tid & 63, wave = tid >> 6;
    const bf16_t* X1 = (const bf16_t*)(a.ws + WS_X1); const bf16_t* Y = (const bf16_t*)(a.ws + WS_Y); const float* wslot = (const float*)(a.ws + WS_WSLOT); const float* mod = (const float*)(a.ws + WS_MOD);
    const int RPW = T_ / (G * NWAVES);
    const int rbase = (vb * NWAVES + wave) * RPW;
    f32x4 gf[4];
#pragma unroll
    for (int j = 0; j < 4; ++j) gf[j] = *(const f32x4*)(a.in[18] + 4 * lane + 256 * j);
    for (int rp = 0; rp < RPW; rp += 2) {
        u32x2 yv[2][4][4], xv[2][4]; float w[2][4];
#pragma unroll
        for (int q = 0; q < 2; ++q) {
            const int r = rbase + rp + q;
#pragma unroll
            for (int k = 0; k < 4; ++k) w[q][k] = wslot[r * 4 + k];
#pragma unroll
            for (int j = 0; j < 4; ++j) {
                const int c0 = 4 * lane + 256 * j;
                xv[q][j] = __builtin_nontemporal_load((const u32x2*)(X1 + (size_t)r * D_ + c0));
#pragma unroll
                for (int k = 0; k < 4; ++k) {
                    if constexpr (Y_F8) yv[q][j][k].x = __builtin_nontemporal_load((const unsigned*)((const unsigned char*)Y + (size_t)(r * 4 + k) * D_ + c0));
                    else yv[q][j][k] = __builtin_nontemporal_load((const u32x2*)(Y + (size_t)(r * 4 + k) * D_ + c0));
                }
            }
        }
        __builtin_amdgcn_sched_barrier(0);
#pragma unroll
        for (int q = 0; q < 2; ++q) {
            const int r = rbase + rp + q, b = r / SEQ; const float* gt2 = mod + b * NMOD + 5 * D_;
            f32x4 v[4]; float ss = 0.f;
#pragma unroll
            for (int j = 0; j < 4; ++j) {
                const int c0 = 4 * lane + 256 * j;
                f32x4 f = (f32x4){0.f, 0.f, 0.f, 0.f};
#pragma unroll
                for (int k = 0; k < 4; ++k) { const u32x2 y = yv[q][j][k];
                    if constexpr (Y_F8) { const f32x2_t lo = __builtin_amdgcn_cvt_pk_f32_fp8((int)y.x, false), hi = __builtin_amdgcn_cvt_pk_f32_fp8((int)y.x, true);
                        const float wk = w[q][k] * (1.f / YSCALE); f.x += wk * lo.x; f.y += wk * lo.y; f.z += wk * hi.x; f.w += wk * hi.y; }
                    else { f.x += w[q][k] * bf2f(y.x & 0xffffu); f.y += w[q][k] * bf2f(y.x >> 16); f.z += w[q][k] * bf2f(y.y & 0xffffu); f.w += w[q][k] * bf2f(y.y >> 16); } }
                const u32x2 xw = xv[q][j]; const f32x4 x1 = (f32x4){bf2f(xw.x & 0xffffu), bf2f(xw.x >> 16), bf2f(xw.y & 0xffffu), bf2f(xw.y >> 16)};
                v[j] = x1 + *(const f32x4*)(gt2 + c0) * f;
                ss += (v[j].x * v[j].x + v[j].y * v[j].y) + (v[j].z * v[j].z + v[j].w * v[j].w);
            }
            const float rs = frsq(wave_sum(ss) * (1.f / D_) + EPS);
#pragma unroll
            for (int j = 0; j < 4; ++j) __builtin_nontemporal_store(v[j] * rs * gf[j], (f32x4*)(a.out + (size_t)r * D_ + 4 * lane + 256 * j));
        }
    }
}

__global__ void __launch_bounds__(512, 2) mega(Args a) {
    extern __shared__ __attribute__((aligned(16))) unsigned char lds_raw[];
    LAS unsigned char* lds = (LAS unsigned char*)lds_raw;
    const int G = gridDim.x, bx = blockIdx.x;
    const int vb = (G % 8 == 0) ? (bx % 8) * (G / 8) + bx / 8 : bx;
    unsigned char* ws = a.ws;
    for (int u = threadIdx.x; u < (LDS_BYTES - LDSCTL_OFF) / 4; u += 512) ((LAS unsigned*)(lds + LDSCTL_OFF))[u] = 0u;
    __syncthreads();
    const bool multi = (a.ph_hi - a.ph_lo) > 1;
    XcdBarrier bar; bar.bar = (unsigned*)(ws + WS_CTL) + CW_BAR; bar.x = 0; bar.st = nullptr;
    if (multi) bar = xcd_barrier_post((unsigned*)(ws + WS_CTL) + CW_BAR, (volatile LAS unsigned*)(lds + L_MISC) + 8);
#define TS_MARK(k) do { if (TSPROBE >= 0 && bx == 0 && threadIdx.x == 0) { volatile LAS unsigned long long* tsl = (volatile LAS unsigned long long*)(lds + L_MISC + 128); if ((k) == TSPROBE) tsl[0] = __builtin_amdgcn_s_memrealtime(); if ((k) == TSPROBE + 1) tsl[1] = __builtin_amdgcn_s_memrealtime(); } } while (0)
#define SEAM(k) do { if (IN(k) && IN((k) + 1)) xcd_barrier(bar); TS_MARK((k) + 1); } while (0)
    TS_MARK(0);
#define IN(k) (a.ph_lo <= (k) && (k) < a.ph_hi)
    if (IN(0)) phase_p0(a, lds, vb, G);
    SEAM(0);
    if (IN(1)) phase_p1(a, lds, vb, G);
    SEAM(1);
    if (IN(2)) {
        pg8::Gemm g{(const bf16_t*)(ws + WS_XN), (const bf16_t*)(ws + WS_WINT), INC, D_, 0, 127, 127};
        pg8::EpiProj E{(bf16_t*)(ws + WS_PROJ)};
#if P2_SPLIT
        TS_SUB(80);
        if (bx < GEMM_CUS) { pg8::DenseOrder S; S.init(T_ / 256, INC / 256, GEMM_CUS, bx, DWGM); pg8::gemm_phase<pg8::EpiProj, pg8::DenseOrder, true>(lds, g, S, E); }
        TS_SUB(81);
        conv_chunks(a, lds, bx & 7, 1 << 30);
        TS_SUB(82);
#else
        pg8::DenseOrder S; S.init(T_ / 256, INC / 256, G, bx, DWGM);
        conv_chunks(a, lds, bx & 7, (bx >= 128) ? CONV_PRE : 0);
        pg8::gemm_phase<pg8::EpiProj, pg8::DenseOrder, true>(lds, g, S, E);
        conv_chunks(a, lds, bx & 7, 1 << 30);
#endif
    }
    SEAM(2);
    if (IN(3)) { const int g = vb & 3; if (g == 0) phase3_body<2>(a, lds, vb); else if (g == 1) phase3_body<4>(a, lds, vb); else if (g == 2) phase3_body<8>(a, lds, vb); else phase3_body<16>(a, lds, vb); }
    SEAM(3);
    if (IN(4)) phase_scan(a, vb, G);
    SEAM(4);
#if EXTRA_BARRIERS
    if (multi) { for (int xb = 0; xb < EXTRA_BARRIERS; ++xb) xcd_barrier(bar); }
#endif
    if (IN(5)) { RetRaw R5; phase5_body(a, lds, vb, R5, false); }
    SEAM(5);
    if (IN(6)) {
        pg8::Gemm g{(const bf16_t*)(ws + WS_MIXIN), (const bf16_t*)(ws + WS_WOUTT), D_, D_, 0, 127, 127};
        pg8::DenseOrder S; S.init(T_ / 256, D_ / 256, G, bx, DWGM);
        pg8::EpiX1 E{a.in[0], (const float*)(ws + WS_MOD), (bf16_t*)(ws + WS_X1)};
        pg8::gemm_phase<pg8::EpiX1, pg8::DenseOrder, true>(lds, g, S, E);
    }
    SEAM(6);
    if (IN(7)) phase_router(a, lds, vb, G);
    SEAM(7);
    if (IN(8)) {
        GroupedOrder S; grouped_prepare(S, lds, ws, 2 * FF / 256, G, bx, 0, a.in[15]);
        pg8::Gemm g{(const bf16_t*)(ws + WS_HN), (const bf16_t*)(ws + WS_WGUT), 2 * FF, D_, (size_t)2 * FF * D_ * (GU_F8 ? 1 : 2), SCALE_W, SCALE_ONE};
        EpiGateUp E{(bf16_t*)(ws + WS_ACT), (LAS const float*)(lds + L_BIAS), (LAS const int*)(lds + L_PSTART)};
        TS_SUB(70);
        pg8::gemm_phase<EpiGateUp, GroupedOrder, true, GU_F8>(lds, g, S, E);
        TS_SUB(71);
    }
    SEAM(8);
    if (IN(9)) {
        GroupedOrder S; grouped_prepare(S, lds, ws, D_ / 256, G, bx, 1, a.in[17]);
        pg8::Gemm g{(const bf16_t*)(ws + WS_ACT), (const bf16_t*)(ws + WS_WDT), D_, FF, (size_t)D_ * FF * (DN_F8 ? 1 : 2), SCALE_W, SCALE_ACT};
        EpiDown E{(bf16_t*)(ws + WS_Y), (LAS const float*)(lds + L_BIAS), (LAS const int*)(lds + L_ROWTAB)};
        TS_SUB(72);
        pg8::gemm_phase<EpiDown, GroupedOrder, true, DN_F8>(lds, g, S, E);
        TS_SUB(73);
    }
    SEAM(9);
    if (IN(10)) phase_final(a, vb, G);
    TS_MARK(11);
    if (TSPROBE >= 0 && bx == ((TSPROBE >= 100) ? TSBLOCK : 0) && threadIdx.x == 0) { volatile LAS unsigned long long* tsl = (volatile LAS unsigned long long*)(lds + L_MISC + 128); const unsigned long long d = (tsl[1] - tsl[0]) * 10ull, t0 = __builtin_amdgcn_s_memrealtime(); while (__builtin_amdgcn_s_memrealtime() - t0 < d) __builtin_amdgcn_s_sleep(8); }
#if REPEAT_MASK & 1572864
    if (IN(19)) { pg8::Gemm g{(const bf16_t*)(ws + WS_XN), (const bf16_t*)(ws + WS_WINT), INC, D_, 0, 127, 127}; pg8::DenseOrder S; S.init(T_ / 256, INC / 256, G, bx); EpiNone E; pg8::gemm_phase<EpiNone, pg8::DenseOrder, true>(lds, g, S, E); }
    if (IN(20)) { pg8::Gemm g{(const bf16_t*)(ws + WS_XN), (const bf16_t*)(ws + WS_WINT), INC, 2 * D_, 0, 127, 127}; pg8::DenseOrder S; S.init(T_ / 256, INC / 256, G, bx); EpiNone E; pg8::gemm_phase<EpiNone, pg8::DenseOrder, true, true>(lds, g, S, E); }
#endif
#if REPEAT_MASK & 196608
    if (IN(16)) { if (bx >= 128) conv_chunks(a, lds, bx & 7, 1 << 30); }
    if (IN(17)) { conv_chunks(a, lds, bx & 7, 1 << 30); }
#endif
#if REPEAT_MASK & 6144
    if (IN(11)) {
        GroupedOrder S; grouped_prepare(S, lds, ws, 2 * FF / 256, G, bx, 0, a.in[15]);
        pg8::Gemm g{(const bf16_t*)(ws + WS_HN), (const bf16_t*)(ws + WS_WGUT), 2 * FF, D_, (size_t)2 * FF * D_ * (GU_F8 ? 1 : 2), SCALE_W, SCALE_ONE};
        EpiNone E;
        pg8::gemm_phase<EpiNone, GroupedOrder, true, GU_F8>(lds, g, S, E);
    }
    if (IN(12)) {
        GroupedOrder S; grouped_prepare(S, lds, ws, D_ / 256, G, bx, 1, a.in[17]);
        pg8::Gemm g{(const bf16_t*)(ws + WS_ACT), (const bf16_t*)(ws + WS_WDT), D_, FF, (size_t)D_ * FF * (DN_F8 ? 1 : 2), SCALE_W, SCALE_ACT};
        EpiNone E;
        pg8::gemm_phase<EpiNone, GroupedOrder, true, DN_F8>(lds, g, S, E);
    }
#endif
#undef SEAM
#undef IN
}

extern "C" void kernel_launch(void* const* d_in, const int* in_sizes, int n_in, void* d_out, int out_size, void* d_ws, size_t ws_size, hipStream_t stream) {
    static int grid = 0;
    if (grid == 0) {
        if (n_in != 19 || in_sizes[0] != T_ * D_ || out_size != T_ * D_ || ws_size < WS_END) { fprintf(stderr, "kernel_launch: unexpected shapes / workspace (n_in %d, ws %zu)\n", n_in, ws_size); grid = -1; return; }
        int dev = 0, cus = 0, per_cu = 0;
        if (hipGetDevice(&dev) != hipSuccess || hipDeviceGetAttribute(&cus, hipDeviceAttributeMultiprocessorCount, dev) != hipSuccess) { grid = -1; return; }
        if (hipFuncSetAttribute((const void*)mega, hipFuncAttributeMaxDynamicSharedMemorySize, LDS_BYTES) != hipSuccess) { fprintf(stderr, "hipFuncSetAttribute failed\n"); grid = -1; return; }
        if (hipOccupancyMaxActiveBlocksPerMultiprocessor(&per_cu, (const void*)mega, 512, LDS_BYTES) != hipSuccess || per_cu < 1) { fprintf(stderr, "occupancy query: %d\n", per_cu); }
        (void)hipGetLastError();
        grid = cus;
        if (grid != 256) fprintf(stderr, "kernel_launch: grid %d (expected 256)\n", grid);
    }
    if (grid < 0) return;
    unsigned char* ws = (unsigned char*)d_ws;
    (void)hipMemsetAsync(ws + WS_CTL, 0, CTL_ZERO_BYTES, stream);
    Args a{};
    for (int i = 0; i < 19; ++i) a.in[i] = (const float*)d_in[i];
    a.out = (float*)d_out; a.ws = ws;
#define MEGA(lo, hi) do { a.ph_lo = (lo); a.ph_hi = (hi); hipLaunchKernelGGL(mega, dim3(grid), dim3(512), LDS_BYTES, stream, a); \
    if ((hi) - (lo) == 1 && (lo) != 7 && ((REPEAT_MASK >> (lo)) & 1)) { hipLaunchKernelGGL(mega, dim3(grid), dim3(512), LDS_BYTES, stream, a); hipLaunchKernelGGL(mega, dim3(grid), dim3(512), LDS_BYTES, stream, a); } } while (0)
#if ONE_LAUNCH
    MEGA(0, 11);
#else
    for (int ph = 0; ph < 11; ++ph) {
        MEGA(ph, ph + 1);
        if (ph == 2 && ((REPEAT_MASK >> 15) & 1)) {
            (void)hipMemsetAsync(ws + WS_CTL + 4096, 0, 4096, stream); a.ph_lo = 2; a.ph_hi = 3; hipLaunchKernelGGL(mega, dim3(grid), dim3(512), LDS_BYTES, stream, a);
            (void)hipMemsetAsync(ws + WS_CTL + 4096, 0, 4096, stream); hipLaunchKernelGGL(mega, dim3(grid), dim3(512), LDS_BYTES, stream, a);
        }
        if (ph == 7 && ((REPEAT_MASK >> 7) & 1)) {
            (void)hipMemsetAsync(ws + WS_CTL, 0, 4096, stream); a.ph_lo = 7; a.ph_hi = 8; hipLaunchKernelGGL(mega, dim3(grid), dim3(512), LDS_BYTES, stream, a);
            (void)hipMemsetAsync(ws + WS_CTL, 0, 4096, stream); hipLaunchKernelGGL(mega, dim3(grid), dim3(512), LDS_BYTES, stream, a);
        }
    }
#if REPEAT_MASK & 524288
    MEGA(19, 20);
#endif
#if REPEAT_MASK & 1048576
    MEGA(20, 21);
#endif
#if REPEAT_MASK & 262144
    for (int z = 0; z < 20; ++z) MEGA(30, 31);
#endif
#if REPEAT_MASK & 65536
    (void)hipMemsetAsync(ws + WS_CTL + 4096, 0, 4096, stream); MEGA(16, 17);
#endif
#if REPEAT_MASK & 131072
    (void)hipMemsetAsync(ws + WS_CTL + 4096, 0, 4096, stream); MEGA(17, 18);
#endif
#if REPEAT_MASK & 2048
    MEGA(11, 12);
#endif
#if REPEAT_MASK & 4096
    MEGA(12, 13);
#endif
#if REPEAT_MASK & 8192
    MEGA(13, 14);
#endif
#if REPEAT_MASK & 16384
    MEGA(14, 15);
#endif
#endif
}
```
